# Optimizing an MI355X kernel written in HIP

```python
import math
import jax, jax.numpy as jnp
from jax import lax
import numpy as np

D_MODEL = 1024
BATCH = 8
SEQ = 8192
DEPTH = 4

CTX_LEN = 256
GRID_W = 64
EPS = 1e-6
NEG_INF = -1e30

GLA_HEADS = 6
GLA_DK = 32
GLA_DV = 64
GLA_LOWRANK = 16
GLA_TAU = 16.0
GLA_CHUNK = 16
ROPE_BASE = 10000.0
SC_WIDTH = 256
SC_GROUPS = 4
NA_HEADS = 6
NA_DH = 64
NA_WIN_ROWS = 8
NA_WIN_COLS = 16
FFN_DIM = 2816

GLA_QK = GLA_HEADS * GLA_DK
GLA_V = GLA_HEADS * GLA_DV
NA_W = NA_HEADS * NA_DH
MIX_WIDTH = GLA_V + SC_WIDTH + NA_W
IN_SPLIT = (GLA_QK, GLA_QK, GLA_V, GLA_LOWRANK, GLA_LOWRANK, GLA_V,
            SC_WIDTH, SC_WIDTH, SC_WIDTH, NA_W, NA_W, NA_W)
IN_WIDTH = 2 * GLA_QK + 2 * GLA_V + 2 * GLA_LOWRANK + 3 * SC_WIDTH + 3 * NA_W

kernel_name = "hybrid_gla_shortconv_natten_dit"


def rmsnorm(t, g):
    tf = t.astype(jnp.float32)
    y = tf * lax.rsqrt(jnp.mean(tf * tf, axis=-1, keepdims=True) + EPS)
    return (y * g.astype(jnp.float32)).astype(t.dtype)


def modulate(t, shift, scale):
    return t * (1 + scale) + shift


def split_cols(u):
    parts, start = [], 0
    for size in IN_SPLIT:
        parts.append(u[..., start:start + size])
        start += size
    return parts


def dwconv3(t, w, b):
    tp = jnp.pad(t, ((0, 0), (1, 1), (0, 0)))
    return tp[:, :-2] * w[0] + tp[:, 1:-1] * w[1] + tp[:, 2:] * w[2] + b


def axial_rope(n_tokens, dim):
    t = jnp.arange(n_tokens)
    n_freq = dim // 4
    inv_freq = ROPE_BASE ** (-jnp.arange(n_freq, dtype=jnp.float32) / n_freq)
    row = (t // GRID_W).astype(jnp.float32)[:, None] * inv_freq
    col = (t % GRID_W).astype(jnp.float32)[:, None] * inv_freq
    ang = jnp.concatenate([row, col], axis=-1)
    return jnp.cos(ang)[None, :, None, :], jnp.sin(ang)[None, :, None, :]


def apply_rope(t, cos, sin):
    t1, t2 = t[..., 0::2], t[..., 1::2]
    return jnp.stack([t1 * cos - t2 * sin, t1 * sin + t2 * cos], axis=-1).reshape(t.shape)


def gla_chunked(q, k, v, g, s0):
    bsz, n_tok, h, dk = q.shape
    dv = v.shape[-1]
    n_chunks = n_tok // GLA_CHUNK
    rs = lambda t: t.reshape(bsz, n_chunks, GLA_CHUNK, h, t.shape[-1])
    q, k, v, g = rs(q), rs(k), rs(v), rs(g)
    b = jnp.cumsum(g, axis=2)
    b_last = b[:, :, -1:]
    q_dec = q * jnp.exp(b)
    k_inv = k * jnp.exp(-b)
    k_end = k * jnp.exp(b_last - b)
    causal = jnp.tril(jnp.ones((GLA_CHUNK, GLA_CHUNK), dtype=bool))
    a = jnp.einsum('bnihk,bnjhk->bnhij', q_dec, k_inv)
    a = jnp.where(causal, a, 0.0)
    o_intra = jnp.einsum('bnhij,bnjhv->bnihv', a, v)

    def step(s, xs):
        qd, ke, vv, dec = xs
        o = jnp.einsum('bihk,bhkv->bihv', qd, s)
        s = s * dec[..., None] + jnp.einsum('bjhk,bjhv->bhkv', ke, vv)
        return s, o

    xs = (jnp.moveaxis(q_dec, 1, 0), jnp.moveaxis(k_end, 1, 0), jnp.moveaxis(v, 1, 0),
          jnp.moveaxis(jnp.exp(b_last[:, :, 0]), 1, 0))
    s_final, o_inter = lax.scan(step, s0, xs)
    o = o_intra + jnp.moveaxis(o_inter, 0, 1)
    return o.reshape(bsz, n_tok, h, dv), s_final


def gla_prep(q, k, v, glr_f, glr_b, wg2_fw, bg_fw, wg2_bw, bg_bw, rope):
    bsz, n_tok, _ = q.shape
    heads = lambda t, d: t.astype(jnp.float32).reshape(bsz, n_tok, GLA_HEADS, d)
    q = heads(q, GLA_DK) * (GLA_DK ** -0.5)
    k = heads(k, GLA_DK)
    v = heads(v, GLA_DV)
    if rope is not None:
        q = apply_rope(q, rope[0], rope[1])
        k = apply_rope(k, rope[0], rope[1])
    g_f = heads(jax.nn.log_sigmoid((glr_f @ wg2_fw + bg_fw).astype(jnp.float32)), GLA_DK) / GLA_TAU
    g_b = heads(jax.nn.log_sigmoid((glr_b @ wg2_bw + bg_bw).astype(jnp.float32)), GLA_DK) / GLA_TAU
    return q, k, v, g_f, g_b


def gla_output(o, r, norm_g):
    of = o * lax.rsqrt(jnp.mean(o * o, axis=-1, keepdims=True) + EPS) * norm_g.astype(jnp.float32)
    bsz, n_tok = o.shape[:2]
    return (of.reshape(bsz, n_tok, GLA_V) * jax.nn.silu(r.astype(jnp.float32))).astype(r.dtype)


def gla_mixer(lat, cpar, rope, wg2_fw, bg_fw, wg2_bw, bg_bw, norm_g, need_ctx_out):
    flip = lambda t: jnp.flip(t, axis=1)
    qc, kc, vc, gfc, gbc = gla_prep(*cpar[:5], wg2_fw, bg_fw, wg2_bw, bg_bw, None)
    ql, kl, vl, gfl, gbl = gla_prep(*lat[:5], wg2_fw, bg_fw, wg2_bw, bg_bw, rope)
    s0 = jnp.zeros((qc.shape[0], GLA_HEADS, GLA_DK, GLA_DV), jnp.float32)
    oc_f, sc_f = gla_chunked(qc, kc, vc, gfc, s0)
    oc_b, sc_b = gla_chunked(flip(qc), flip(kc), flip(vc), flip(gbc), s0)
    ol_f, _ = gla_chunked(ql, kl, vl, gfl, sc_f)
    ol_b, _ = gla_chunked(flip(ql), flip(kl), flip(vl), flip(gbl), sc_b)
    out_lat = gla_output(ol_f + flip(ol_b), lat[5], norm_g)
    out_ctx = gla_output(oc_f + flip(oc_b), cpar[5], norm_g) if need_ctx_out else None
    return out_lat, out_ctx


def short_conv(b_gate, c_gate, xh, w, bias):
    return b_gate * dwconv3(c_gate * xh, w, bias)


def neighbourhood_attention(q, k, v, k_ctx, v_ctx, rpb):
    bsz, n_tok, _ = q.shape
    rows = n_tok // GRID_W
    kh = min(NA_WIN_ROWS, rows)
    kw = NA_WIN_COLS
    grid = lambda t: t.reshape(bsz, rows, GRID_W, NA_HEADS, NA_DH)
    qg = grid(q.astype(jnp.float32) * (NA_DH ** -0.5))
    kg, vg = grid(k), grid(v)
    kc = k_ctx.reshape(bsz, -1, NA_HEADS, NA_DH).astype(jnp.float32)
    vc = v_ctx.reshape(bsz, -1, NA_HEADS, NA_DH).astype(jnp.float32)
    col = jnp.arange(GRID_W)
    col_start = jnp.clip(col - kw // 2, 0, GRID_W - kw)
    col_mask = (col[None, :] >= col_start[:, None]) & (col[None, :] < col_start[:, None] + kw)
    dc_idx = jnp.clip(col[None, :] - col[:, None] + NA_WIN_COLS - 1, 0, 2 * NA_WIN_COLS - 2)
    rpb_cols = jnp.take(rpb.astype(jnp.float32), dc_idx, axis=2)

    def row_block(r):
        rs = jnp.clip(r - kh // 2, 0, rows - kh)
        q_r = lax.dynamic_index_in_dim(qg, r, axis=1, keepdims=False)
        k_band = lax.dynamic_slice_in_dim(kg, rs, kh, axis=1).astype(jnp.float32)
        v_band = lax.dynamic_slice_in_dim(vg, rs, kh, axis=1).astype(jnp.float32)
        dr_idx = rs + jnp.arange(kh) - r + NA_WIN_ROWS - 1
        bias = jnp.take(rpb_cols, dr_idx, axis=1)
        s_loc = jnp.einsum('bqhd,bikhd->bhqik', q_r, k_band) + jnp.transpose(bias, (0, 2, 1, 3))[None]
        s_loc = jnp.where(col_mask[None, None, :, None, :], s_loc, NEG_INF)
        s_ctx = jnp.einsum('bqhd,bchd->bhqc', q_r, kc)
        s = jnp.concatenate([s_loc.reshape(bsz, NA_HEADS, GRID_W, kh * GRID_W), s_ctx], axis=-1)
        p = jax.nn.softmax(s, axis=-1)
        p_loc = p[..., :kh * GRID_W].reshape(bsz, NA_HEADS, GRID_W, kh, GRID_W)
        p_ctx = p[..., kh * GRID_W:]
        o = jnp.einsum('bhqik,bikhd->bqhd', p_loc, v_band) + jnp.einsum('bhqc,bchd->bqhd', p_ctx, vc)
        return o.astype(q.dtype)

    out = lax.map(row_block, jnp.arange(rows))
    return jnp.moveaxis(out, 0, 1).reshape(bsz, n_tok, NA_W)


def context_attention(q, k, v):
    bsz, n_tok, _ = q.shape
    hs = lambda t: t.astype(jnp.float32).reshape(bsz, n_tok, NA_HEADS, NA_DH)
    s = jnp.einsum('bqhd,bkhd->bhqk', hs(q) * (NA_DH ** -0.5), hs(k))
    o = jnp.einsum('bhqk,bkhd->bqhd', jax.nn.softmax(s, axis=-1), hs(v))
    return o.reshape(bsz, n_tok, NA_W).astype(q.dtype)


def conv_ffn(h, w_up, cw, cb, w_down):
    u = dwconv3(h @ w_up, cw, cb)
    a, b = jnp.split(u, 2, axis=-1)
    return (jax.nn.silu(a) * b) @ w_down


def setup_inputs(seed: int = 0) -> dict:
    key = jax.random.key(seed)
    ks = jax.random.split(key, 24)
    nrm = lambda k, shape, s: jax.random.normal(k, shape, jnp.float32) * s
    return {
        "x": nrm(ks[0], (BATCH, SEQ, D_MODEL), 1.0),
        "c": nrm(ks[1], (BATCH, D_MODEL), 1.0),
        "ctx": nrm(ks[2], (BATCH, CTX_LEN, D_MODEL), 1.0),
        "c_ctx": nrm(ks[3], (D_MODEL,), 1.0),
        "w_ada": nrm(ks[4], (DEPTH, D_MODEL, 6 * D_MODEL), 0.5 * D_MODEL ** -0.5),
        "b_ada": nrm(ks[5], (DEPTH, 6 * D_MODEL), 0.02),
        "norm_mix_g": 1.0 + nrm(ks[6], (DEPTH, D_MODEL), 0.05),
        "norm_ffn_g": 1.0 + nrm(ks[7], (DEPTH, D_MODEL), 0.05),
        "w_in": nrm(ks[8], (DEPTH, D_MODEL, IN_WIDTH), D_MODEL ** -0.5),
        "gla_wg2_fw": nrm(ks[9], (DEPTH, GLA_LOWRANK, GLA_QK), GLA_LOWRANK ** -0.5),
        "gla_bg_fw": nrm(ks[10], (DEPTH, GLA_QK), 0.02),
        "gla_wg2_bw": nrm(ks[11], (DEPTH, GLA_LOWRANK, GLA_QK), GLA_LOWRANK ** -0.5),
        "gla_bg_bw": nrm(ks[12], (DEPTH, GLA_QK), 0.02),
        "gla_norm_g": 1.0 + nrm(ks[13], (DEPTH, GLA_DV), 0.05),
        "sc_conv_w": nrm(ks[14], (DEPTH, 3, SC_WIDTH), 3 ** -0.5),
        "sc_conv_b": nrm(ks[15], (DEPTH, SC_WIDTH), 0.02),
        "na_rpb": nrm(ks[16], (DEPTH, NA_HEADS, 2 * NA_WIN_ROWS - 1, 2 * NA_WIN_COLS - 1), 0.02),
        "w_out": nrm(ks[17], (DEPTH, MIX_WIDTH, D_MODEL), MIX_WIDTH ** -0.5),
        "ffn_w_up": nrm(ks[18], (DEPTH, D_MODEL, 2 * FFN_DIM), D_MODEL ** -0.5),
        "ffn_conv_w": nrm(ks[19], (DEPTH, 3, 2 * FFN_DIM), 3 ** -0.5),
        "ffn_conv_b": nrm(ks[20], (DEPTH, 2 * FFN_DIM), 0.02),
        "ffn_w_down": nrm(ks[21], (DEPTH, FFN_DIM, D_MODEL), FFN_DIM ** -0.5),
        "final_norm_g": 1.0 + nrm(ks[22], (D_MODEL,), 0.05),
    }


def reference(x, c, ctx, c_ctx, w_ada, b_ada, norm_mix_g, norm_ffn_g, w_in, gla_wg2_fw, gla_bg_fw,
              gla_wg2_bw, gla_bg_bw, gla_norm_g, sc_conv_w, sc_conv_b, na_rpb, w_out, ffn_w_up,
              ffn_conv_w, ffn_conv_b, ffn_w_down, final_norm_g):
    n_lat = x.shape[1]
    rope = axial_rope(n_lat, GLA_DK)
    xc = ctx
    for layer in range(DEPTH):
        update_ctx = layer < DEPTH - 1
        mod = jax.nn.silu(c) @ w_ada[layer] + b_ada[layer]
        sh1, sc1, g1, sh2, sc2, g2 = jnp.split(mod[:, None, :], 6, axis=-1)
        modc = jax.nn.silu(c_ctx) @ w_ada[layer] + b_ada[layer]
        sh1c, sc1c, g1c, sh2c, sc2c, g2c = jnp.split(modc, 6, axis=-1)

        u = modulate(rmsnorm(x, norm_mix_g[layer]), sh1, sc1) @ w_in[layer]
        uc = modulate(rmsnorm(xc, norm_mix_g[layer]), sh1c, sc1c) @ w_in[layer]
        lat = split_cols(u)
        cpar = split_cols(uc)
        gla_lat, gla_ctx = gla_mixer(lat[:6], cpar[:6], rope, gla_wg2_fw[layer], gla_bg_fw[layer],
                                     gla_wg2_bw[layer], gla_bg_bw[layer], gla_norm_g[layer], update_ctx)
        sc_lat = short_conv(lat[6], lat[7], lat[8], sc_conv_w[layer], sc_conv_b[layer])
        na_lat = neighbourhood_attention(lat[9], lat[10], lat[11], cpar[10], cpar[11], na_rpb[layer])
        x = x + g1 * (jnp.concatenate([gla_lat, sc_lat, na_lat], axis=-1) @ w_out[layer])
        h = modulate(rmsnorm(x, norm_ffn_g[layer]), sh2, sc2)
        x = x + g2 * conv_ffn(h, ffn_w_up[layer], ffn_conv_w[layer], ffn_conv_b[layer], ffn_w_down[layer])

        if update_ctx:
            sc_ctx = short_conv(cpar[6], cpar[7], cpar[8], sc_conv_w[layer], sc_conv_b[layer])
            na_ctx = context_attention(cpar[9], cpar[10], cpar[11])
            xc = xc + g1c * (jnp.concatenate([gla_ctx, sc_ctx, na_ctx], axis=-1) @ w_out[layer])
            hc = modulate(rmsnorm(xc, norm_ffn_g[layer]), sh2c, sc2c)
            xc = xc + g2c * conv_ffn(hc, ffn_w_up[layer], ffn_conv_w[layer], ffn_conv_b[layer],
                                     ffn_w_down[layer])
    return rmsnorm(x, final_norm_g)
```

```cpp
#include <hip/hip_runtime.h>
#include <hip/hip_cooperative_groups.h>
#include <cstdio>
#include <cstdint>
namespace cg = cooperative_groups;
__device__ __forceinline__ int otid() { int t = threadIdx.x; asm volatile("" : "+v"(t)); return t; }
namespace pg8 {
#define PG8_LAS __attribute__((address_space(3)))
typedef unsigned short bf16_t;
typedef short bf16x8 __attribute__((ext_vector_type(8)));
typedef float f32x4 __attribute__((ext_vector_type(4)));
typedef unsigned u32x4 __attribute__((ext_vector_type(4)));
constexpr int BM = 256, BK = 64, HALF = 128, HTB = HALF * BK * 2  , STAGE_BYTES = 8 * HTB, NXCD = 8, WGM = 8;

__host__ __device__ __forceinline__ int lds_byte(int r, int c) { const int st = (r >> 4) * 2 + (c >> 5), rr = r & 15, cc = c & 31, ob = rr * 64 + cc * 2; return st * 1024 + (ob ^ (((ob >> 9) & 1) << 5)); }
__host__ __device__ __forceinline__ void stage_rc(int b, int& R, int& C) { const int st = b / 1024, sb = b % 1024, swz = sb ^ (((sb >> 9) & 1) << 5); R = (st >> 1) * 16 + swz / 64; C = (st & 1) * 32 + (swz % 64) / 2; }
__host__ __device__ __forceinline__ int perm32(int rho) { const int n = rho >> 4, i = rho & 15; return 8 * (i >> 2) + 4 * n + (i & 3); }

struct Unit { int pm, pn; };
struct Gemm { const bf16_t* A; const bf16_t* Bt; int M, N, K; };

struct StaticOrder {
    int nM, nN, nwg, G, c;
    __host__ __device__ void init(int M, int N, int G_, int c_) { nM = M / BM; nN = N / BM; nwg = nM * nN; G = G_; c = c_; }
    __host__ __device__ bool next(int i, Unit& u) const {
        const long L = (long)i * G + c; if (L >= nwg) return false;
        int wgid = (int)L; { const int q = nwg / NXCD, r = nwg % NXCD, xcd = wgid % NXCD, off = wgid / NXCD; wgid = (xcd < r ? xcd * (q + 1) : r * (q + 1) + (xcd - r) * q) + off; }
        const int nig = WGM * nN, gid = wgid / nig, fm = gid * WGM, gsz = (nM - fm) < WGM ? (nM - fm) : WGM;
        u.pm = fm + ((wgid % nig) % gsz); u.pn = (wgid % nig) / gsz; return true;
    }
    __device__ __forceinline__ void a_ready(const Unit&) const {}
    __device__ __forceinline__ void done(const Unit&) const {}
};

typedef float f32x2v_ __attribute__((ext_vector_type(2)));
typedef __bf16 bf16x2v_ __attribute__((ext_vector_type(2)));
__device__ __forceinline__ unsigned cvt_pk_bf16(float lo, float hi) { f32x2v_ v = {lo, hi}; bf16x2v_ b = __builtin_convertvector(v, bf16x2v_); return __builtin_bit_cast(unsigned, b); }
template <class Epi, class Sched, bool ALIGN_EPI = false, bool SP2 = false>
__device__ __forceinline__ void gemm_phase(PG8_LAS unsigned char* lds, const Gemm g, const Sched& S, const Epi& E) {
    const int tid = otid(), wid = __builtin_amdgcn_readfirstlane(tid >> 6), lane = tid & 63, wr = wid >> 2, wc = wid & 3, fr = lane & 15, fq = lane >> 4;
    const int K = g.K, nt = K / BK;
    unsigned voffA[2], voffB[2];
#pragma unroll
    for (int i = 0; i < 2; ++i) { int R, C; stage_rc(tid * 16 + i * 8192, R, C); const int Rb = Epi::PERM ? ((R & ~31) + perm32(R & 31)) : R;
        voffA[i] = (unsigned)(R * K + C) * 2u; voffB[i] = (unsigned)(Rb * K + C) * 2u; }
    const size_t kstep = (size_t)(BK * 2);
    const size_t hstep = (size_t)HALF * K * 2;
    const size_t tstep = 2 * hstep;
    const unsigned ldsw = (unsigned)wid * 1024u;
    const int aoff = lds_byte(wr * 64 + fr, fq * 8), boff = lds_byte(wc * 32 + fr, fq * 8);
#define PG8_SA(b, h) (((b) * 2 + (h)) * HTB)
#define PG8_SB(b, h) ((4 + (b) * 2 + (h)) * HTB)
#define PG8_STAGE(bufoff, gbase, voff) do { _Pragma("unroll") for (int _i = 0; _i < 2; ++_i) \
        __builtin_amdgcn_global_load_lds((const unsigned*)((const char*)(gbase) + (voff)[_i]), (PG8_LAS unsigned*)(lds + (bufoff) + ldsw + _i * 8192), 16, 0, 0); } while (0)
#define PG8_LDA(dst, b, h) do { _Pragma("unroll") for (int m = 0; m < 4; ++m) _Pragma("unroll") for (int k = 0; k < 2; ++k) dst[m][k] = *(const PG8_LAS bf16x8*)(lds + PG8_SA(b, h) + aoff + m * 2048 + k * 1024); } while (0)
#define PG8_LDB(dst, b, h) do { _Pragma("unroll") for (int n = 0; n < 2; ++n) _Pragma("unroll") for (int k = 0; k < 2; ++k) dst[n][k] = *(const PG8_LAS bf16x8*)(lds + PG8_SB(b, h) + boff + n * 2048 + k * 1024); } while (0)
#define PG8_MMA(ai, bj, At, Bt) do { __builtin_amdgcn_s_setprio(1); _Pragma("unroll") for (int m = 0; m < 4; ++m) _Pragma("unroll") for (int n = 0; n < 2; ++n) _Pragma("unroll") for (int k = 0; k < 2; ++k) \
        acc[ai][bj][m][n] = __builtin_amdgcn_mfma_f32_16x16x32_bf16(Bt[n][k], At[m][k], acc[ai][bj][m][n], 0, 0, 0); __builtin_amdgcn_s_setprio(0); } while (0)
#define PG8_WAIT_V(n) asm volatile("s_waitcnt vmcnt(" #n ")" ::: "memory")
#define PG8_WAIT_L(n) asm volatile("s_waitcnt lgkmcnt(" #n ")" ::: "memory")
#define PG8_BAR __builtin_amdgcn_s_barrier()
#define PG8_SCHED __builtin_amdgcn_sched_barrier(0)
    Unit cur, nxt; int ui = 0;
    if (!S.next(0, cur)) return;
    f32x4 acc[2][2][4][2];
#pragma unroll
    for (int a = 0; a < 2; ++a)
#pragma unroll
        for (int b = 0; b < 2; ++b)
#pragma unroll
            for (int m = 0; m < 4; ++m)
#pragma unroll
                for (int n = 0; n < 2; ++n) acc[a][b][m][n] = (f32x4){0.f, 0.f, 0.f, 0.f};
    bf16x8 At[4][2], B0[2][2], B1[2][2];
    const char* cA = (const char*)g.A + (size_t)cur.pm * tstep; const char* cB = (const char*)g.Bt + (size_t)cur.pn * tstep;
    S.a_ready(cur);
    if constexpr (SP2) {
        PG8_STAGE(PG8_SB(0, 0), cB, voffB); PG8_STAGE(PG8_SB(0, 1), cB + hstep, voffB); PG8_STAGE(PG8_SA(0, 0), cA, voffA); PG8_STAGE(PG8_SA(0, 1), cA + hstep, voffA);
        if (wr == 1) PG8_BAR;
        PG8_WAIT_V(2); PG8_BAR;
        PG8_STAGE(PG8_SB(1, 0), cB + kstep, voffB); PG8_STAGE(PG8_SA(1, 0), cA + kstep, voffA); PG8_STAGE(PG8_SB(1, 1), cB + hstep + kstep, voffB);
        PG8_WAIT_V(6); PG8_BAR;
    } else {
        PG8_STAGE(PG8_SB(0, 0), cB, voffB); PG8_STAGE(PG8_SA(0, 0), cA, voffA); PG8_STAGE(PG8_SB(0, 1), cB + hstep, voffB); PG8_STAGE(PG8_SA(0, 1), cA + hstep, voffA);
        if (wr == 1) PG8_BAR;
        PG8_WAIT_V(4); PG8_BAR;
        PG8_STAGE(PG8_SB(1, 0), cB + kstep, voffB); PG8_STAGE(PG8_SA(1, 0), cA + kstep, voffA); PG8_STAGE(PG8_SB(1, 1), cB + hstep + kstep, voffB);
        PG8_WAIT_V(6); PG8_BAR;
    }
    for (;;) {
        const bool has_next = S.next(ui + 1, nxt);
        const char* nA = has_next ? (const char*)g.A + (size_t)nxt.pm * tstep : cA; const char* nB = has_next ? (const char*)g.Bt + (size_t)nxt.pn * tstep : cB;
        for (int t = 0; t < nt; t += 2) {
            const bool last = (t == nt - 2);
            const char* a1 = cA + (size_t)(t + 1) * kstep;
            const char* a2 = last ? nA : cA + (size_t)(t + 2) * kstep; const char* b2 = last ? nB : cB + (size_t)(t + 2) * kstep;
            const char* a3 = a2 + kstep; const char* b3 = b2 + kstep;
            if (last && has_next) S.a_ready(nxt);
            if constexpr (SP2) {
            PG8_LDB(B0, 0, 0); PG8_LDB(B1, 0, 1); PG8_SCHED; PG8_LDA(At, 0, 0); PG8_STAGE(PG8_SA(1, 1), a1 + hstep, voffA);
            PG8_WAIT_V(8); PG8_WAIT_L(0); PG8_BAR; PG8_MMA(0, 0, At, B0); PG8_MMA(0, 1, At, B1); PG8_BAR; PG8_SCHED;
            PG8_LDA(At, 0, 1); PG8_STAGE(PG8_SB(0, 0), b2, voffB); PG8_STAGE(PG8_SB(0, 1), b2 + hstep, voffB); PG8_STAGE(PG8_SA(0, 0), a2, voffA);
            PG8_WAIT_V(8); PG8_WAIT_L(0); PG8_BAR; PG8_MMA(1, 0, At, B0); PG8_MMA(1, 1, At, B1); PG8_BAR; PG8_SCHED;
            PG8_LDB(B0, 1, 0); PG8_LDB(B1, 1, 1); PG8_SCHED; PG8_LDA(At, 1, 0); PG8_STAGE(PG8_SA(0, 1), a2 + hstep, voffA);
            PG8_WAIT_V(8); PG8_WAIT_L(0); PG8_BAR; PG8_MMA(0, 0, At, B0); PG8_MMA(0, 1, At, B1); PG8_BAR; PG8_SCHED;
            PG8_LDA(At, 1, 1); PG8_STAGE(PG8_SB(1, 0), b3, voffB); PG8_STAGE(PG8_SB(1, 1), b3 + hstep, voffB); PG8_STAGE(PG8_SA(1, 0), a3, voffA);
            PG8_WAIT_V(8); PG8_WAIT_L(0); PG8_BAR; PG8_MMA(1, 0, At, B0); PG8_MMA(1, 1, At, B1); PG8_BAR; PG8_SCHED;
            } else {
            PG8_LDB(B0, 0, 0); PG8_SCHED; PG8_LDA(At, 0, 0); PG8_STAGE(PG8_SA(1, 1), a1 + hstep, voffA);
            PG8_WAIT_L(8); PG8_BAR; PG8_WAIT_L(0); PG8_MMA(0, 0, At, B0); PG8_BAR; PG8_SCHED;
            PG8_LDB(B1, 0, 1); PG8_STAGE(PG8_SB(0, 0), b2, voffB);
            PG8_BAR; PG8_WAIT_L(0); PG8_MMA(0, 1, At, B1); PG8_BAR;
            PG8_LDA(At, 0, 1); PG8_STAGE(PG8_SA(0, 0), a2, voffA);
            PG8_BAR; PG8_WAIT_L(0); PG8_MMA(1, 0, At, B0); PG8_BAR; PG8_SCHED;
            PG8_STAGE(PG8_SB(0, 1), b2 + hstep, voffB);
            PG8_WAIT_V(6); PG8_BAR; PG8_MMA(1, 1, At, B1); PG8_BAR;
            PG8_LDB(B0, 1, 0); PG8_SCHED; PG8_LDA(At, 1, 0); PG8_STAGE(PG8_SA(0, 1), a2 + hstep, voffA);
            PG8_WAIT_L(8); PG8_BAR; PG8_WAIT_L(0); PG8_MMA(0, 0, At, B0); PG8_BAR; PG8_SCHED;
            PG8_LDB(B1, 1, 1); PG8_STAGE(PG8_SB(1, 0), b3, voffB);
            PG8_BAR; PG8_WAIT_L(0); PG8_MMA(0, 1, At, B1); PG8_BAR;
            PG8_LDA(At, 1, 1); PG8_STAGE(PG8_SA(1, 0), a3, voffA);
            PG8_BAR; PG8_WAIT_L(0); PG8_MMA(1, 0, At, B0); PG8_BAR; PG8_SCHED;
            PG8_STAGE(PG8_SB(1, 1), b3 + hstep, voffB);
            PG8_WAIT_V(6); PG8_BAR; PG8_MMA(1, 1, At, B1); PG8_BAR;
            }
        }
        if constexpr (ALIGN_EPI) { if (wr == 0) PG8_BAR; }
        if constexpr (!Epi::AFTER_DRAIN) { E(acc, cur, wr, wc, fr, fq); S.done(cur); }
        if (!has_next) break;
#pragma unroll
        for (int a = 0; a < 2; ++a)
#pragma unroll
            for (int b = 0; b < 2; ++b)
#pragma unroll
                for (int m = 0; m < 4; ++m)
#pragma unroll
                    for (int n = 0; n < 2; ++n) acc[a][b][m][n] = (f32x4){0.f, 0.f, 0.f, 0.f};
        cur = nxt; cA = nA; cB = nB; ++ui;
        if constexpr (ALIGN_EPI) { if (wr == 1) PG8_BAR; }
    }
    PG8_WAIT_V(0);
    if constexpr (!ALIGN_EPI) { if (wr == 0) PG8_BAR; }
    PG8_BAR;
    if constexpr (Epi::AFTER_DRAIN) { E.fused(acc, cur, wr, wc, fr, fq, lds, wid, lane); S.done(cur); }
#undef PG8_SA
#undef PG8_SB
#undef PG8_STAGE
#undef PG8_LDA
#undef PG8_LDB
#undef PG8_MMA
#undef PG8_WAIT_V
#undef PG8_WAIT_L
#undef PG8_BAR
#undef PG8_SCHED
}
}

typedef unsigned short bf16_t;
typedef short bf16x8 __attribute__((ext_vector_type(8)));
typedef float f32x4 __attribute__((ext_vector_type(4)));
typedef unsigned u32x4 __attribute__((ext_vector_type(4)));
typedef unsigned u32x2 __attribute__((ext_vector_type(2)));
#define LAS __attribute__((address_space(3)))

constexpr int DM = 1024, NBAT = 8, SEQ = 8192, DEPTH = 4, CTXL = 256;
constexpr int TL = NBAT * SEQ, TC = NBAT * CTXL, TT = TL + TC;
constexpr int INW = 3104, INP = 3328;
constexpr int Q0 = 0, K0 = 192, V0 = 384, GF0 = 768, GB0 = 784, R0 = 800, SB0 = 1184, SC0 = 1440, SX0 = 1696, NQ0 = 1952, NK0 = 2336, NV0 = 2720;
constexpr int FFN = 2816, FF2 = 5632;
constexpr int MODW = 6 * DM;
constexpr int NCH = 132;
constexpr int VTW = SEQ + CTXL;
constexpr int HALF0 = 32768;

constexpr size_t WS_WIN = 0;
constexpr size_t WS_WOUT = WS_WIN + (size_t)DEPTH * INP * DM * 2;
constexpr size_t WS_WUP = WS_WOUT + (size_t)DEPTH * DM * DM * 2;
constexpr size_t WS_WDN = WS_WUP + (size_t)DEPTH * FF2 * DM * 2;
constexpr size_t WS_MOD = WS_WDN + (size_t)DEPTH * DM * FFN * 2;
constexpr size_t WS_ROPE = WS_MOD + (size_t)DEPTH * 9 * MODW * 4;
constexpr size_t WS_XC = WS_ROPE + (size_t)SEQ * 32 * 4;
constexpr size_t WS_H = WS_XC + (size_t)TC * DM * 4;
constexpr size_t WS_BIG = WS_H + (size_t)TT * DM * 2;
constexpr size_t WS_U = WS_BIG;
constexpr size_t WS_VT = WS_U + (size_t)TT * INP * 2;
constexpr size_t WS_VTG = WS_VT + (size_t)48 * 64 * VTW * 2;
constexpr size_t WS_SL = WS_VTG + (size_t)48 * 64 * VTW * 2;
constexpr size_t WS_DEC = WS_SL + (size_t)96 * NCH * 2048 * 4;
constexpr size_t WS_OG = WS_DEC + (size_t)96 * NCH * 32 * 4;
constexpr size_t WS_END1 = WS_OG + (size_t)TT * 384 * 4;
constexpr size_t WS_FU = WS_BIG;
constexpr size_t WS_ACT = WS_FU + (size_t)34816 * FF2 * 2;
constexpr size_t WS_END2 = WS_ACT + (size_t)34816 * FFN * 2;
constexpr size_t WS_CTL = ((WS_END1 > WS_END2 ? WS_END1 : WS_END2) + 4095) / 4096 * 4096;
constexpr size_t WS_GSV = WS_CTL + 16384;
constexpr size_t WS_BIAS = WS_GSV + (size_t)DEPTH * 2 * 9 * DM * 4;
constexpr size_t WS_STAT = WS_BIAS + (size_t)DEPTH * 2 * 9 * FF2 * 4;
constexpr size_t WS_NEED = WS_STAT + (size_t)2 * TT * 16 * 4 + 4096;
constexpr size_t WS_H2 = (WS_END2 + 4095) / 4096 * 4096;
static_assert(WS_H2 + (size_t)TT * DM * 2 <= WS_CTL, "H2 overlay must end before the control words");
constexpr int LDS_BYTES = 131072;
#define GSYNC_CG() do { asm volatile("s_waitcnt vmcnt(0)" ::: "memory"); grid.sync(); } while (0)
#define XB_TMO      128
#define XB_XCNT(j)  (256  + 64 * (j))
#define XB_XSUB(j)  (1280 + 64 * (j))
#define XB_XGEN(j)  (2304 + 64 * (j))
#define XB_TOP      3328
#define XB_TOPGEN   3392
#define XCD_BAR_WORDS 3456
#define XB_SPIN_CAP (1u << 18)
__device__ __forceinline__ unsigned xb_ld(unsigned* p)              { return __hip_atomic_load(p, __ATOMIC_RELAXED, __HIP_MEMORY_SCOPE_AGENT); }
__device__ __forceinline__ unsigned xb_add(unsigned* p, unsigned v) { return __hip_atomic_fetch_add(p, v, __ATOMIC_RELAXED, __HIP_MEMORY_SCOPE_AGENT); }
__device__ __forceinline__ unsigned xb_xcc_id() { return (unsigned)__builtin_amdgcn_s_getreg((3 << 11) | 20) & 0xFu; }
#define XB_SPIN(cond, bar) do { unsigned _sp = 0; while (cond) { __builtin_amdgcn_s_sleep(1); \
    if ((++_sp & 255u) == 0u) { if (xb_ld(&(bar)[XB_TMO])) break; if (_sp > XB_SPIN_CAP) { atomicAdd(&(bar)[XB_TMO], 1u); break; } } } } while (0)
struct XcdBarrier { unsigned* bar; unsigned x; volatile LAS unsigned* st; };
__device__ __forceinline__ XcdBarrier xcd_barrier_post(unsigned* bar, volatile LAS unsigned* st) {
    XcdBarrier b; b.bar = bar; b.x = xb_xcc_id(); b.st = st;
    if (threadIdx.x == 0) (void)xb_add(&bar[XB_XCNT(b.x)], 1u);
    return b;
}
__device__ __forceinline__ void xcd_barrier_complete(unsigned* bar, unsigned x, unsigned& nloc, unsigned& nx) {
    const unsigned G = gridDim.x * gridDim.y * gridDim.z;
    unsigned sum, cnt, mine, sp = 0u;
    for (;;) {
        sum = 0u; cnt = 0u; mine = 0u;
#pragma unroll
        for (unsigned j = 0; j < 16; ++j) { const unsigned c = xb_ld(&bar[XB_XCNT(j)]); sum += c; cnt += (c > 0u) ? 1u : 0u; mine = (j == x) ? c : mine; }
        if (sum == G) break;
        __builtin_amdgcn_s_sleep(1);
        if ((++sp & 255u) == 0u) { if (xb_ld(&bar[XB_TMO])) break; if (sp > XB_SPIN_CAP) { atomicAdd(&bar[XB_TMO], 1u); break; } }
    }
    nloc = mine > 0u ? mine : 1u; nx = cnt > 0u ? cnt : 1u;
}
__device__ __forceinline__ void xcd_barrier(const XcdBarrier& b) {
    asm volatile("s_waitcnt vmcnt(0)" ::: "memory");
    __syncthreads();
    if (threadIdx.x == 0) {
        unsigned* bar = b.bar;
        __builtin_amdgcn_s_waitcnt(0);
        unsigned nloc = b.st[0], nx = b.st[1];
        if (nloc == 0u) { xcd_barrier_complete(bar, b.x, nloc, nx); b.st[0] = nloc; b.st[1] = nx; }
        const unsigned old = xb_add(&bar[XB_XSUB(b.x)], 1u);
        const unsigned gen = old / nloc;
        if (old + 1u == (gen + 1u) * nloc) {
            __builtin_amdgcn_fence(__ATOMIC_RELEASE, "agent");
            asm volatile("s_waitcnt vmcnt(0)" ::: "memory");
            const unsigned og = xb_add(&bar[XB_TOP], 1u);
            const unsigned tg = og / nx;
            if (og + 1u == (tg + 1u) * nx) xb_add(&bar[XB_TOPGEN], 1u);
            else XB_SPIN(xb_ld(&bar[XB_TOPGEN]) == tg, bar);
            __builtin_amdgcn_fence(__ATOMIC_ACQUIRE, "agent");
            xb_add(&bar[XB_XGEN(b.x)], 1u);
            asm volatile("s_waitcnt vmcnt(0)" ::: "memory");
        } else {
            XB_SPIN(xb_ld(&bar[XB_XGEN(b.x)]) == gen, bar);
            __builtin_amdgcn_fence(__ATOMIC_ACQUIRE, "agent");
            asm volatile("s_waitcnt vmcnt(0)" ::: "memory");
        }
    }
    __syncthreads();
}
#define GSYNC() xcd_barrier(xb)
#ifndef REP_GLA
#define REP_GLA 1
#endif
#ifndef REP_NA
#define REP_NA 1
#endif
#ifndef REP_CG
#define REP_CG 1
#endif
#ifndef REP_GEMM
#define REP_GEMM 1
#endif
#ifndef REP_NORM
#define REP_NORM 1
#endif
#ifndef REP_VT
#define REP_VT 1
#endif

struct Params {
    const float* in[23];
    float* out;
    unsigned char* ws;
};


typedef const Params __attribute__((address_space(4)))* ParamsK;
__device__ __forceinline__ ParamsK getpk() { ParamsK q = (ParamsK)__builtin_amdgcn_kernarg_segment_ptr(); asm volatile("" : "+s"(q)); return q; }
template <class T> __device__ __forceinline__ T* asglobal(T* q) {
#if defined(__HIP_DEVICE_COMPILE__)
    __builtin_assume(!__builtin_amdgcn_is_shared((const void*)q)); __builtin_assume(!__builtin_amdgcn_is_private((const void*)q));
#endif
    return q; }
#define IN(i) asglobal(p->in[i])
#define WSP asglobal(p->ws)
#define OUTP asglobal(p->out)
__device__ __forceinline__ float bf2f(bf16_t v) { return __uint_as_float(((unsigned)v) << 16); }
__device__ __forceinline__ float bflo(unsigned w) { return __uint_as_float(w << 16); }
__device__ __forceinline__ float bfhi(unsigned w) { return __uint_as_float(w & 0xffff0000u); }
__device__ __forceinline__ unsigned pk2(float lo, float hi) { return pg8::cvt_pk_bf16(lo, hi); }
__device__ __forceinline__ float wave_sum(float v) {
#pragma unroll
    for (int o = 1; o < 64; o <<= 1) v += __shfl_xor(v, o);
    return v;
}
__device__ __forceinline__ float silu_f(float v) { return v * __builtin_amdgcn_rcpf(1.f + __expf(-v)); }
#define LDS_WAIT() asm volatile("s_waitcnt lgkmcnt(0)" ::: "memory")

struct EpiStore {
    static constexpr bool PERM = true, AFTER_DRAIN = false;
    bf16_t* O; int ldc;
    __device__ __forceinline__ void operator()(const f32x4 (&acc)[2][2][4][2], const pg8::Unit& u, int wr, int wc, int fr, int fq) const {
        const int row0 = u.pm * 256 + wr * 64 + fr, col0 = u.pn * 256 + wc * 32 + 8 * fq;
#pragma unroll
        for (int ai = 0; ai < 2; ++ai)
#pragma unroll
            for (int m = 0; m < 4; ++m) { bf16_t* rowp = O + (size_t)(row0 + ai * 128 + m * 16) * ldc + col0;
#pragma unroll
                for (int bj = 0; bj < 2; ++bj) { const f32x4 v0 = acc[ai][bj][m][0], v1 = acc[ai][bj][m][1];
                    u32x4 w; w.x = pk2(v0[0], v0[1]); w.y = pk2(v0[2], v0[3]); w.z = pk2(v1[0], v1[1]); w.w = pk2(v1[2], v1[3]);
                    *(u32x4*)(rowp + bj * 128) = w; } }
    }
};
struct EpiResid {
    static constexpr bool PERM = true, AFTER_DRAIN = false;
    const float* rin_l; const float* rin_c; float* rout_l; float* rout_c; const float* gate; int rowbase;
    __device__ __forceinline__ void operator()(const f32x4 (&acc)[2][2][4][2], const pg8::Unit& u, int wr, int wc, int fr, int fq) const {
#pragma unroll
        for (int ai = 0; ai < 2; ++ai)
#pragma unroll
            for (int m = 0; m < 4; ++m) {
                const int R = rowbase + u.pm * 256 + ai * 128 + wr * 64 + m * 16 + fr;
                const bool islat = R < TL; const int mrow = islat ? (R >> 13) : 8;
                const float* src = islat ? rin_l + (size_t)R * DM : rin_c + (size_t)(R - TL) * DM;
                float* dst = islat ? rout_l + (size_t)R * DM : rout_c + (size_t)(R - TL) * DM;
                const float* gp = gate + (size_t)mrow * MODW;
#pragma unroll
                for (int bj = 0; bj < 2; ++bj)
#pragma unroll
                    for (int n = 0; n < 2; ++n) { const int c = u.pn * 256 + bj * 128 + wc * 32 + 8 * fq + 4 * n;
                        const f32x4 g4 = *(const f32x4*)(gp + c), x4 = *(const f32x4*)(src + c);
                        *(f32x4*)(dst + c) = x4 + g4 * acc[ai][bj][m][n]; } }
    }
};

struct EpiStoreN {
    static constexpr bool PERM = true, AFTER_DRAIN = false;
    bf16_t* O; int ldc; const float* stat; const float* bias; int rowbase;
    __device__ __forceinline__ void operator()(const f32x4 (&acc)[2][2][4][2], const pg8::Unit& u, int wr, int wc, int fr, int fq) const {
        const int row0 = u.pm * 256 + wr * 64 + fr, col0 = u.pn * 256 + wc * 32 + 8 * fq;
        const int Rt = rowbase + u.pm * 256;
        const float* bp = bias + (size_t)(Rt < TL ? (Rt >> 13) : 8) * FF2 + col0;
        f32x4 bv[2][2];
#pragma unroll
        for (int bj = 0; bj < 2; ++bj) { bv[bj][0] = *(const f32x4*)(bp + bj * 128); bv[bj][1] = *(const f32x4*)(bp + bj * 128 + 4); }
#pragma unroll
        for (int ai = 0; ai < 2; ++ai)
#pragma unroll
            for (int m = 0; m < 4; ++m) { const int r = row0 + ai * 128 + m * 16, Rg = rowbase + r;
                const f32x4 q = *(const f32x4*)(stat + (size_t)Rg * 16 + fq * 4);
                float ssq = (q[0] + q[1]) + (q[2] + q[3]); ssq += __shfl_xor(ssq, 16); ssq += __shfl_xor(ssq, 32);
                const float rstd = rsqrtf(ssq * (1.f / DM) + 1e-6f);
                bf16_t* rowp = O + (size_t)r * ldc + col0;
#pragma unroll
                for (int bj = 0; bj < 2; ++bj) { const f32x4 v0 = acc[ai][bj][m][0] * rstd + bv[bj][0], v1 = acc[ai][bj][m][1] * rstd + bv[bj][1];
                    u32x4 w; w.x = pk2(v0[0], v0[1]); w.y = pk2(v0[2], v0[3]); w.z = pk2(v1[0], v1[1]); w.w = pk2(v1[2], v1[3]);
                    *(u32x4*)(rowp + bj * 128) = w; } }
    }
};
struct EpiResidN {
    static constexpr bool PERM = true, AFTER_DRAIN = false;
    const float* rin_l; const float* rin_c; float* rout_l; float* rout_c; const float* gate; int rowbase;
    bf16_t* Hn; const float* gs; float* stat;
    __device__ __forceinline__ void operator()(const f32x4 (&acc)[2][2][4][2], const pg8::Unit& u, int wr, int wc, int fr, int fq) const {
        const int Rt = rowbase + u.pm * 256; const bool islat = Rt < TL; const int mrow = islat ? (Rt >> 13) : 8;
        const float* gp = gate + (size_t)mrow * MODW; const float* gsp = gs + (size_t)mrow * DM;
        f32x4 gv[2][2], sv[2][2];
#pragma unroll
        for (int bj = 0; bj < 2; ++bj) { const int c = u.pn * 256 + bj * 128 + wc * 32 + 8 * fq;
            gv[bj][0] = *(const f32x4*)(gp + c); gv[bj][1] = *(const f32x4*)(gp + c + 4); sv[bj][0] = *(const f32x4*)(gsp + c); sv[bj][1] = *(const f32x4*)(gsp + c + 4); }
#pragma unroll
        for (int ai = 0; ai < 2; ++ai)
#pragma unroll
            for (int m = 0; m < 4; ++m) {
                const int R = rowbase + u.pm * 256 + ai * 128 + wr * 64 + m * 16 + fr;
                const float* src = islat ? rin_l + (size_t)R * DM : rin_c + (size_t)(R - TL) * DM;
                float* dst = islat ? rout_l + (size_t)R * DM : rout_c + (size_t)(R - TL) * DM;
                float ss = 0.f;
#pragma unroll
                for (int bj = 0; bj < 2; ++bj) { const int c = u.pn * 256 + bj * 128 + wc * 32 + 8 * fq;
                    const f32x4 xa = *(const f32x4*)(src + c) + gv[bj][0] * acc[ai][bj][m][0];
                    const f32x4 xb = *(const f32x4*)(src + c + 4) + gv[bj][1] * acc[ai][bj][m][1];
                    *(f32x4*)(dst + c) = xa; *(f32x4*)(dst + c + 4) = xb;
                    ss += (xa[0] * xa[0] + xa[1] * xa[1]) + (xa[2] * xa[2] + xa[3] * xa[3]) + (xb[0] * xb[0] + xb[1] * xb[1]) + (xb[2] * xb[2] + xb[3] * xb[3]);
                    const f32x4 ya = xa * sv[bj][0], yb = xb * sv[bj][1];
                    u32x4 w; w.x = pk2(ya[0], ya[1]); w.y = pk2(ya[2], ya[3]); w.z = pk2(yb[0], yb[1]); w.w = pk2(yb[2], yb[3]);
                    *(u32x4*)(Hn + (size_t)R * DM + c) = w; }
                ss += __shfl_xor(ss, 16); ss += __shfl_xor(ss, 32);
                if (fq == 0) stat[(size_t)R * 16 + u.pn * 4 + wc] = ss;
            }
    }
};

__device__ __forceinline__ const void* uni_ptr(const void* q) { const unsigned long long a = (unsigned long long)q; const unsigned lo = __builtin_amdgcn_readfirstlane((unsigned)a), hi = __builtin_amdgcn_readfirstlane((unsigned)(a >> 32)); return (const void*)(((unsigned long long)hi << 32) | lo); }
template <class Epi>
__device__ __forceinline__ void run_gemm(unsigned char* smem, const bf16_t* A, const bf16_t* Bt, int M, int N, int K, const Epi& E) {
    pg8::Gemm g; g.A = (const bf16_t*)uni_ptr(A); g.Bt = (const bf16_t*)uni_ptr(Bt); g.M = M; g.N = N; g.K = K;
    pg8::StaticOrder S; S.init(M, N, (int)gridDim.x, (int)blockIdx.x);
    pg8::gemm_phase<Epi, pg8::StaticOrder, true, true>((PG8_LAS unsigned char*)smem, g, S, E);
    __syncthreads();
}

__device__ __forceinline__ void ada_phase(ParamsK p, unsigned char* smem) {
    float* sc = (float*)smem;
    float* red = sc + 9 * 1024;
    const int tid = otid();
    const float* cvec = IN(1); const float* cctx = IN(3); const float* w_ada = IN(4); const float* b_ada = IN(5);
    float* mod = (float*)(WSP + WS_MOD);
    for (int i = tid; i < 9 * 1024; i += 512) { const int r = i >> 10, k = i & 1023; const float v = r < 8 ? cvec[r * 1024 + k] : cctx[k]; sc[i] = v / (1.f + expf(-v)); }
    __syncthreads();
    for (int task = blockIdx.x; task < DEPTH * 96; task += gridDim.x) {
        const int l = task / 96, cb = (task % 96) * 64, cl = tid & 63, ks = tid >> 6;
        const float* w = w_ada + (size_t)l * DM * MODW + cb + cl;
        float acc[9];
#pragma unroll
        for (int r = 0; r < 9; ++r) acc[r] = 0.f;
#pragma unroll 16
        for (int kk = 0; kk < 128; ++kk) { const int k = ks * 128 + kk; const float wv = w[(size_t)k * MODW];
#pragma unroll
            for (int r = 0; r < 9; ++r) acc[r] += sc[r * 1024 + k] * wv; }
#pragma unroll
        for (int r = 0; r < 9; ++r) red[(ks * 9 + r) * 64 + cl] = acc[r];
        __syncthreads();
        for (int o = tid; o < 576; o += 512) { const int r = o >> 6, cc = o & 63; float s = 0.f;
#pragma unroll
            for (int k8 = 0; k8 < 8; ++k8) s += red[(k8 * 9 + r) * 64 + cc];
            mod[(size_t)(l * 9 + r) * MODW + cb + cc] = s + b_ada[l * MODW + cb + cc]; }
        __syncthreads();
    }
}
__device__ __forceinline__ void transpose_item(const float* W, int K, int N, bf16_t* WT, float* scr, int item, int lane) {
    const int nblk = N / 32, kb = item / nblk, nb = item % nblk, k0 = 64 * kb, n0 = 32 * nb;
    float tv[32];
#pragma unroll
    for (int i = 0; i < 32; ++i) { const int kk = 2 * i + (lane >> 5); tv[i] = W[(size_t)(k0 + kk) * N + n0 + (lane & 31)]; }
#pragma unroll
    for (int i = 0; i < 32; ++i) { const int kk = 2 * i + (lane >> 5); scr[kk * 33 + (lane & 31)] = tv[i]; }
    LDS_WAIT();
    const int c = lane & 7;
#pragma unroll
    for (int j = 0; j < 4; ++j) { const int n = (lane >> 3) + 8 * j; const float* s = scr + (8 * c) * 33 + n;
        u32x4 o; o.x = pk2(s[0 * 33], s[1 * 33]); o.y = pk2(s[2 * 33], s[3 * 33]); o.z = pk2(s[4 * 33], s[5 * 33]); o.w = pk2(s[6 * 33], s[7 * 33]);
        *(u32x4*)(WT + (size_t)(n0 + n) * K + k0 + 8 * c) = o; }
    LDS_WAIT();
}
__device__ __forceinline__ void weights_phase(ParamsK p, unsigned char* smem) {
    const int tid = otid(), lane = tid & 63, wave = __builtin_amdgcn_readfirstlane(tid >> 6);
    float* scr = (float*)(smem + wave * 16384);
    const int gw = blockIdx.x * 8 + wave, NGW = gridDim.x * 8;
    constexpr int I_IN = 16 * (INW / 32), I_OUT = 16 * 32, I_UP = 16 * (FF2 / 32), I_DN = (FFN / 64) * 32, I_L = I_IN + I_OUT + I_UP + I_DN;
    for (int it = gw; it < DEPTH * I_L; it += NGW) {
        const int l = it / I_L; int r = it % I_L;
        if (r < I_IN) { transpose_item(IN(8) + (size_t)l * DM * INW, DM, INW, (bf16_t*)(WSP + WS_WIN) + (size_t)l * INP * DM, scr, r, lane); continue; } r -= I_IN;
        if (r < I_OUT) { transpose_item(IN(17) + (size_t)l * DM * DM, DM, DM, (bf16_t*)(WSP + WS_WOUT) + (size_t)l * DM * DM, scr, r, lane); continue; } r -= I_OUT;
        if (r < I_UP) { transpose_item(IN(18) + (size_t)l * DM * FF2, DM, FF2, (bf16_t*)(WSP + WS_WUP) + (size_t)l * FF2 * DM, scr, r, lane); continue; } r -= I_UP;
        transpose_item(IN(21) + (size_t)l * FFN * DM, FFN, DM, (bf16_t*)(WSP + WS_WDN) + (size_t)l * DM * FFN, scr, r, lane);
    }
    const int gt = blockIdx.x * 512 + tid, NGT = gridDim.x * 512;
    constexpr int PADV = (INP - INW) * DM / 8;
    for (int i = gt; i < DEPTH * PADV; i += NGT) { const int l = i / PADV, r = i % PADV;
        *(u32x4*)((bf16_t*)(WSP + WS_WIN) + (size_t)l * INP * DM + (size_t)INW * DM + (size_t)r * 8) = (u32x4){0u, 0u, 0u, 0u}; }
    float* rope = (float*)(WSP + WS_ROPE);
    for (int i = gt; i < SEQ * 16; i += NGT) { const int tok = i >> 4, j = i & 15, f = j & 7;
        const float invf = f == 0 ? 1.0f : f == 1 ? 0.31622776601683794f : f == 2 ? 0.1f : f == 3 ? 0.031622776601683794f : f == 4 ? 0.01f : f == 5 ? 0.0031622776601683794f : f == 6 ? 0.001f : 0.00031622776601683794f;
        const float pos = (float)(j < 8 ? (tok >> 6) : (tok & 63)); const float ang = pos * invf;
        const double a = (double)ang; const double kq = rint(a * 0.15915494309189535); const float rr = (float)(a - kq * 6.283185307179586);
        rope[tok * 32 + j] = cosf(rr); rope[tok * 32 + 16 + j] = sinf(rr); }
}

__device__ __forceinline__ void norm_phase(const float* xl, const float* xc, const float* g, const float* shift, const float* scale, bf16_t* H, int nrows) {
    const int tid = otid(), lane = tid & 63, wave = __builtin_amdgcn_readfirstlane(tid >> 6);
    const int gw = blockIdx.x * 8 + wave, NGW = gridDim.x * 8;
    for (int row0 = gw; row0 < nrows; row0 += 2 * NGW) {
        const int row1 = row0 + NGW; const bool has1 = row1 < nrows; const int rowb = has1 ? row1 : row0;
        const float* srcA = row0 < TL ? xl + (size_t)row0 * DM : xc + (size_t)(row0 - TL) * DM;
        const float* srcB = rowb < TL ? xl + (size_t)rowb * DM : xc + (size_t)(rowb - TL) * DM;
        f32x4 va[4], vb[4]; float sa = 0.f, sb = 0.f;
#pragma unroll
        for (int j = 0; j < 4; ++j) { va[j] = *(const f32x4*)(srcA + lane * 4 + 256 * j); vb[j] = *(const f32x4*)(srcB + lane * 4 + 256 * j); }
#pragma unroll
        for (int j = 0; j < 4; ++j) { sa += (va[j][0] * va[j][0] + va[j][1] * va[j][1]) + (va[j][2] * va[j][2] + va[j][3] * va[j][3]);
            sb += (vb[j][0] * vb[j][0] + vb[j][1] * vb[j][1]) + (vb[j][2] * vb[j][2] + vb[j][3] * vb[j][3]); }
#pragma unroll
        for (int o = 1; o < 64; o <<= 1) { sa += __shfl_xor(sa, o); sb += __shfl_xor(sb, o); }
        const float rstdA = rsqrtf(sa * (1.f / DM) + 1e-6f), rstdB = rsqrtf(sb * (1.f / DM) + 1e-6f);
        const int mA = row0 < TL ? (row0 >> 13) : 8, mB = rowb < TL ? (rowb >> 13) : 8;
#pragma unroll
        for (int j = 0; j < 4; ++j) { const int c = lane * 4 + 256 * j;
            const f32x4 g4 = *(const f32x4*)(g + c);
            { const f32x4 s4 = *(const f32x4*)(scale + (size_t)mA * MODW + c), h4 = *(const f32x4*)(shift + (size_t)mA * MODW + c);
              const f32x4 y = (va[j] * rstdA * g4) * (s4 + 1.f) + h4;
              u32x2 w; w.x = pk2(y[0], y[1]); w.y = pk2(y[2], y[3]); *(u32x2*)(H + (size_t)row0 * DM + c) = w; }
            if (has1) { const f32x4 s4 = *(const f32x4*)(scale + (size_t)mB * MODW + c), h4 = *(const f32x4*)(shift + (size_t)mB * MODW + c);
              const f32x4 y = (vb[j] * rstdB * g4) * (s4 + 1.f) + h4;
              u32x2 w; w.x = pk2(y[0], y[1]); w.y = pk2(y[2], y[3]); *(u32x2*)(H + (size_t)row1 * DM + c) = w; }
        }
    }
}
__device__ __forceinline__ void final_norm_phase(float* x, const float* g) {
    const int tid = otid(), lane = tid & 63, wave = __builtin_amdgcn_readfirstlane(tid >> 6);
    const int gw = blockIdx.x * 8 + wave, NGW = gridDim.x * 8;
    for (int row = gw; row < TL; row += NGW) {
        float* src = x + (size_t)row * DM;
        f32x4 v[4]; float ss = 0.f;
#pragma unroll
        for (int j = 0; j < 4; ++j) { v[j] = *(const f32x4*)(src + lane * 4 + 256 * j); ss += (v[j][0] * v[j][0] + v[j][1] * v[j][1]) + (v[j][2] * v[j][2] + v[j][3] * v[j][3]); }
        const float rstd = rsqrtf(wave_sum(ss) * (1.f / DM) + 1e-6f);
#pragma unroll
        for (int j = 0; j < 4; ++j) { const int c = lane * 4 + 256 * j; const f32x4 g4 = *(const f32x4*)(g + c); *(f32x4*)(src + c) = v[j] * rstd * g4; }
    }
}

typedef short bf16x4 __attribute__((ext_vector_type(4)));
constexpr int GS = 36;
__device__ __forceinline__ bf16x4 as_bf16x4(u32x2 w) { union { u32x2 u; bf16x4 b; } c; c.u = w; return c.b; }
__device__ __forceinline__ bf16x8 as_bf16x8(u32x4 w) { union { u32x4 u; bf16x8 b; } c; c.u = w; return c.b; }
__device__ __forceinline__ void unpack8(const u32x4 w, float (&f)[8]) {
#pragma unroll
    for (int i = 0; i < 4; ++i) { f[2 * i] = bflo(w[i]); f[2 * i + 1] = bfhi(w[i]); }
}
struct GlaRaw { u32x4 kraw, qraw; f32x4 cs, sn; u32x2 graw; };
template <bool NEEDQ>
__device__ __forceinline__ void gla_stage_load(const bf16_t* U, const float* rope, int row0, int tpos0, int h, int dir, int lane, GlaRaw& R) {
    const int tok = lane >> 2, qr = lane & 3;
    const bf16_t* ur = U + (size_t)(row0 + tok) * INP + h * 32 + qr * 8;
    R.kraw = *(const u32x4*)(ur + K0);
    if (NEEDQ) R.qraw = *(const u32x4*)(ur + Q0);
    if (tpos0 >= 0) { const float* rp = rope + (size_t)(tpos0 + tok) * 32 + qr * 4; R.cs = *(const f32x4*)rp; R.sn = *(const f32x4*)(rp + 16); }
    R.graw = *(const u32x2*)(U + (size_t)(row0 + tok) * INP + (dir ? GB0 : GF0) + qr * 4);
}
template <bool NEEDQ>
__device__ __forceinline__ void gla_stage16(const GlaRaw& R, float* qs, float* ks, float* Bs, float* Be, int tpos0, int dir, const float (&wg)[16], float bgk, int lane) {
    {
        const int tok = lane >> 2, qr = lane & 3;
        float kk[8], qq[8];
        unpack8(R.kraw, kk);
        if (NEEDQ) { unpack8(R.qraw, qq);
#pragma unroll
            for (int i = 0; i < 8; ++i) qq[i] *= 0.17677669529663687f; }
        if (tpos0 >= 0) { const f32x4 cs = R.cs, sn = R.sn;
#pragma unroll
            for (int i = 0; i < 4; ++i) { const float a = kk[2 * i] * cs[i] - kk[2 * i + 1] * sn[i], b2 = kk[2 * i] * sn[i] + kk[2 * i + 1] * cs[i]; kk[2 * i] = a; kk[2 * i + 1] = b2;
                if (NEEDQ) { const float c2 = qq[2 * i] * cs[i] - qq[2 * i + 1] * sn[i], d2 = qq[2 * i] * sn[i] + qq[2 * i + 1] * cs[i]; qq[2 * i] = c2; qq[2 * i + 1] = d2; } } }
        *(f32x4*)(ks + tok * GS + qr * 8) = (f32x4){kk[0], kk[1], kk[2], kk[3]}; *(f32x4*)(ks + tok * GS + qr * 8 + 4) = (f32x4){kk[4], kk[5], kk[6], kk[7]};
        if (NEEDQ) { *(f32x4*)(qs + tok * GS + qr * 8) = (f32x4){qq[0], qq[1], qq[2], qq[3]}; *(f32x4*)(qs + tok * GS + qr * 8 + 4) = (f32x4){qq[4], qq[5], qq[6], qq[7]}; }
    }
    bf16_t* Gs = (bf16_t*)(Be + 64);
    *(u32x2*)(Gs + lane * 4) = R.graw;
    LDS_WAIT();
    {
        const int k = lane & 31, hf = lane >> 5;
        float g[8];
#pragma unroll
        for (int i = 0; i < 8; ++i) {
            const u32x4 ga = *(const u32x4*)(Gs + (hf * 8 + i) * 16), gb = *(const u32x4*)(Gs + (hf * 8 + i) * 16 + 8);
            float x = bgk;
#pragma unroll
            for (int j = 0; j < 4; ++j) { x += bflo(ga[j]) * wg[2 * j] + bfhi(ga[j]) * wg[2 * j + 1]; }
#pragma unroll
            for (int j = 0; j < 4; ++j) { x += bflo(gb[j]) * wg[8 + 2 * j] + bfhi(gb[j]) * wg[8 + 2 * j + 1]; }
            g[i] = (fminf(x, 0.f) - __logf(1.f + __expf(-fabsf(x)))) * 0.0625f;
        }
        if (dir == 0) {
#pragma unroll
            for (int i = 1; i < 8; ++i) g[i] += g[i - 1];
            const float other = __shfl_xor(g[7], 32);
            if (hf == 1) {
#pragma unroll
                for (int i = 0; i < 8; ++i) g[i] += other;
                Be[k] = g[7]; }
        } else {
#pragma unroll
            for (int i = 6; i >= 0; --i) g[i] += g[i + 1];
            const float other = __shfl_xor(g[0], 32);
            if (hf == 0) {
#pragma unroll
                for (int i = 0; i < 8; ++i) g[i] += other;
                Be[k] = g[0]; }
        }
#pragma unroll
        for (int i = 0; i < 8; ++i) Bs[(hf * 8 + i) * GS + k] = g[i];
    }
    LDS_WAIT();
}
__device__ __forceinline__ void gla_load_gatew(ParamsK p, int l, int h, int dir, int lane, float (&wg)[16], float& bgk) {
    const int k = lane & 31;
    const float* w = (dir ? IN(11) : IN(9)) + (size_t)l * 16 * 192 + h * 32 + k;
#pragma unroll
    for (int i = 0; i < 16; ++i) wg[i] = w[i * 192];
    bgk = ((dir ? IN(12) : IN(10)) + (size_t)l * 192 + h * 32)[k];
}
__device__ __forceinline__ void gla_task(int task, int& bh, int& b, int& h, int& tc, int& rowb, int& vtb, int& tpb) {
    tc = task % NCH; bh = task / NCH; h = bh % 6; b = bh / 6;
    if (tc < 4) { rowb = TL + b * CTXL + tc * 64; vtb = SEQ + tc * 64; tpb = -1; }
    else { rowb = b * SEQ + (tc - 4) * 64; vtb = (tc - 4) * 64; tpb = (tc - 4) * 64; }
}
__device__ __forceinline__ void gla_state_ops(const float* ks, const float* Bs, const float* Be, int fr, int fq, bf16x4 (&ke)[2], f32x4 (&dec)[2]) {
#pragma unroll
    for (int kb = 0; kb < 2; ++kb) { const int kidx = kb * 16 + fr; const float be = Be[kidx]; float e[4];
#pragma unroll
        for (int j = 0; j < 4; ++j) e[j] = ks[(fq * 4 + j) * GS + kidx] * __expf(be - Bs[(fq * 4 + j) * GS + kidx]);
        u32x2 w; w.x = pk2(e[0], e[1]); w.y = pk2(e[2], e[3]); ke[kb] = as_bf16x4(w);
        const f32x4 bv = *(const f32x4*)(Be + kb * 16 + fq * 4);
        dec[kb] = (f32x4){__expf(bv[0]), __expf(bv[1]), __expf(bv[2]), __expf(bv[3])}; }
}
__device__ __forceinline__ void gla_step1(ParamsK p, int l, unsigned char* smem) {
    const int tid = otid(), lane = tid & 63, wave = __builtin_amdgcn_readfirstlane(tid >> 6), fr = lane & 15, fq = lane >> 4;
    float* qs = (float*)(smem + wave * 16384); float* ks = qs + 16 * GS; float* Bs = ks + 16 * GS; float* Be = Bs + 16 * GS;
    const bf16_t* U = (const bf16_t*)(WSP + WS_U); const float* rope = (const float*)(WSP + WS_ROPE); const bf16_t* VTG = (const bf16_t*)(WSP + WS_VTG);
    float* SL = (float*)(WSP + WS_SL); float* DEC = (float*)(WSP + WS_DEC);
    const int gw = wave * gridDim.x + blockIdx.x, NGW = gridDim.x * 8;
    for (int task = gw; task < 48 * NCH; task += NGW) {
        int bh, b, h, tc, rowb, vtb, tpb; gla_task(task, bh, b, h, tc, rowb, vtb, tpb);
        for (int dir = 0; dir < 2; ++dir) {
            const int c = dir == 0 ? tc : (tc < 4 ? 3 - tc : 135 - tc);
            float wg[16], bgk; gla_load_gatew(p, l, h, dir, lane, wg, bgk);
            f32x4 S[2][4];
#pragma unroll
            for (int kb = 0; kb < 2; ++kb)
#pragma unroll
                for (int db = 0; db < 4; ++db) S[kb][db] = (f32x4){0.f, 0.f, 0.f, 0.f};
            float bsum = 0.f;
            GlaRaw raw; { const int sc0 = dir ? 3 : 0; gla_stage_load<false>(U, rope, rowb + sc0 * 16, tpb < 0 ? -1 : tpb + sc0 * 16, h, dir, lane, raw); }
            for (int si = 0; si < 4; ++si) {
                const int sc = dir ? 3 - si : si;
                bf16x4 vt[4];
#pragma unroll
                for (int db = 0; db < 4; ++db) vt[db] = as_bf16x4(*(const u32x2*)(VTG + (size_t)(bh * 64 + db * 16 + fr) * VTW + vtb + sc * 16 + fq * 4));
                gla_stage16<false>(raw, qs, ks, Bs, Be, tpb, dir, wg, bgk, lane);
                if (si < 3) { const int scn = dir ? 2 - si : si + 1; gla_stage_load<false>(U, rope, rowb + scn * 16, tpb < 0 ? -1 : tpb + scn * 16, h, dir, lane, raw); }
                bf16x4 ke[2]; f32x4 dec[2]; gla_state_ops(ks, Bs, Be, fr, fq, ke, dec);
                bsum += Be[lane & 31];
#pragma unroll
                for (int kb = 0; kb < 2; ++kb)
#pragma unroll
                    for (int db = 0; db < 4; ++db) S[kb][db] = __builtin_amdgcn_mfma_f32_16x16x16bf16_1k(ke[kb], vt[db], S[kb][db] * dec[kb], 0, 0, 0);
                LDS_WAIT();
            }
            float* so = SL + ((size_t)(bh * 2 + dir) * NCH + c) * 2048;
#pragma unroll
            for (int kb = 0; kb < 2; ++kb)
#pragma unroll
                for (int db = 0; db < 4; ++db)
#pragma unroll
                    for (int j = 0; j < 4; ++j) so[(kb * 16 + fq * 4 + j) * 64 + db * 16 + fr] = S[kb][db][j];
            if (lane < 32) DEC[((size_t)(bh * 2 + dir) * NCH + c) * 32 + lane] = __expf(bsum);
        }
    }
}
__device__ __forceinline__ void gla_step2(ParamsK p) {
    float* SL = (float*)(WSP + WS_SL); const float* DEC = (const float*)(WSP + WS_DEC);
    const int gt = blockIdx.x * 512 + otid(), NGT = gridDim.x * 512;
    for (int e = gt; e < 96 * 2048; e += NGT) {
        const int bhd = e >> 11, kd = e & 2047, k = kd >> 6;
        float* sp = SL + (size_t)bhd * NCH * 2048 + kd; const float* dp = DEC + (size_t)bhd * NCH * 32 + k;
        float s = 0.f;
        for (int c0 = 0; c0 < NCH; c0 += 12) {
            float loc[12], dd[12];
#pragma unroll
            for (int j = 0; j < 12; ++j) { loc[j] = sp[(size_t)(c0 + j) * 2048]; dd[j] = dp[(c0 + j) * 32]; }
#pragma unroll
            for (int j = 0; j < 12; ++j) { sp[(size_t)(c0 + j) * 2048] = s; s = dd[j] * s + loc[j]; }
        }
    }
}
__device__ __forceinline__ void gla_step3(ParamsK p, int l, unsigned char* smem) {
    const int tid = otid(), lane = tid & 63, wave = __builtin_amdgcn_readfirstlane(tid >> 6), fr = lane & 15, fq = lane >> 4;
    float* qs = (float*)(smem + wave * 16384); float* ks = qs + 16 * GS; float* Bs = ks + 16 * GS; float* Be = Bs + 16 * GS;
    const bf16_t* U = (const bf16_t*)(WSP + WS_U); const float* rope = (const float*)(WSP + WS_ROPE); const bf16_t* VTG = (const bf16_t*)(WSP + WS_VTG);
    const float* SL = (const float*)(WSP + WS_SL); float* OG = (float*)(WSP + WS_OG);
    bf16_t* MIX = (bf16_t*)(WSP + WS_H);
    const float* ngp = IN(13) + l * 64;
    const int gw = wave * gridDim.x + blockIdx.x, NGW = gridDim.x * 8;
    for (int task = gw; task < 48 * NCH; task += NGW) {
        int bh, b, h, tc, rowb, vtb, tpb; gla_task(task, bh, b, h, tc, rowb, vtb, tpb);
        for (int dir = 0; dir < 2; ++dir) {
            const int c = dir == 0 ? tc : (tc < 4 ? 3 - tc : 135 - tc);
            float wg[16], bgk; gla_load_gatew(p, l, h, dir, lane, wg, bgk);
            f32x4 S[2][4];
            const float* si_ = SL + ((size_t)(bh * 2 + dir) * NCH + c) * 2048;
#pragma unroll
            for (int kb = 0; kb < 2; ++kb)
#pragma unroll
                for (int db = 0; db < 4; ++db)
#pragma unroll
                    for (int j = 0; j < 4; ++j) S[kb][db][j] = si_[(kb * 16 + fq * 4 + j) * 64 + db * 16 + fr];
            GlaRaw raw; { const int sc0 = dir ? 3 : 0; gla_stage_load<true>(U, rope, rowb + sc0 * 16, tpb < 0 ? -1 : tpb + sc0 * 16, h, dir, lane, raw); }
            for (int si = 0; si < 4; ++si) {
                const int sc = dir ? 3 - si : si;
                const int row = rowb + sc * 16 + fr;
                bf16x4 vt[4];
#pragma unroll
                for (int db = 0; db < 4; ++db) vt[db] = as_bf16x4(*(const u32x2*)(VTG + (size_t)(bh * 64 + db * 16 + fr) * VTW + vtb + sc * 16 + fq * 4));
                f32x4 og[4]; u32x2 rgw[4];
                if (dir == 1) {
#pragma unroll
                    for (int db = 0; db < 4; ++db) { og[db] = *(const f32x4*)(OG + (size_t)row * 384 + h * 64 + db * 16 + fq * 4);
                        rgw[db] = *(const u32x2*)(U + (size_t)row * INP + R0 + h * 64 + db * 16 + fq * 4); }
                }
                gla_stage16<true>(raw, qs, ks, Bs, Be, tpb, dir, wg, bgk, lane);
                if (si < 3) { const int scn = dir ? 2 - si : si + 1; gla_stage_load<true>(U, rope, rowb + scn * 16, tpb < 0 ? -1 : tpb + scn * 16, h, dir, lane, raw); }
                const f32x4 ba = *(const f32x4*)(Bs + fr * GS + fq * 4), bb = *(const f32x4*)(Bs + fr * GS + 16 + fq * 4);
                const f32x4 qa = *(const f32x4*)(qs + fr * GS + fq * 4), qb = *(const f32x4*)(qs + fr * GS + 16 + fq * 4);
                const f32x4 ka = *(const f32x4*)(ks + fr * GS + fq * 4), kc = *(const f32x4*)(ks + fr * GS + 16 + fq * 4);
                u32x4 qw, kw;
                qw.x = pk2(qa[0] * __expf(ba[0]), qa[1] * __expf(ba[1])); qw.y = pk2(qa[2] * __expf(ba[2]), qa[3] * __expf(ba[3]));
                qw.z = pk2(qb[0] * __expf(bb[0]), qb[1] * __expf(bb[1])); qw.w = pk2(qb[2] * __expf(bb[2]), qb[3] * __expf(bb[3]));
                kw.x = pk2(ka[0] * __expf(-ba[0]), ka[1] * __expf(-ba[1])); kw.y = pk2(ka[2] * __expf(-ba[2]), ka[3] * __expf(-ba[3]));
                kw.z = pk2(kc[0] * __expf(-bb[0]), kc[1] * __expf(-bb[1])); kw.w = pk2(kc[2] * __expf(-bb[2]), kc[3] * __expf(-bb[3]));
                const bf16x8 Qd = as_bf16x8(qw), Kd = as_bf16x8(kw);
                bf16x4 ke[2]; f32x4 dec[2]; gla_state_ops(ks, Bs, Be, fr, fq, ke, dec);
                f32x4 AT = __builtin_amdgcn_mfma_f32_16x16x32_bf16(Kd, Qd, (f32x4){0.f, 0.f, 0.f, 0.f}, 0, 0, 0);
#pragma unroll
                for (int j = 0; j < 4; ++j) { const int pp = fq * 4 + j; const bool keep = dir == 0 ? (pp <= fr) : (pp >= fr); AT[j] = keep ? AT[j] : 0.f; }
                u32x2 aw; aw.x = pk2(AT[0], AT[1]); aw.y = pk2(AT[2], AT[3]);
                const bf16x4 atb = as_bf16x4(aw);
                f32x4 O[4];
#pragma unroll
                for (int db = 0; db < 4; ++db) {
                    const f32x4 Oa = __builtin_amdgcn_mfma_f32_16x16x16bf16_1k(vt[db], atb, (f32x4){0.f, 0.f, 0.f, 0.f}, 0, 0, 0);
                    u32x4 sw; sw.x = pk2(S[0][db][0], S[0][db][1]); sw.y = pk2(S[0][db][2], S[0][db][3]); sw.z = pk2(S[1][db][0], S[1][db][1]); sw.w = pk2(S[1][db][2], S[1][db][3]);
                    const f32x4 Ob = __builtin_amdgcn_mfma_f32_16x16x32_bf16(as_bf16x8(sw), Qd, (f32x4){0.f, 0.f, 0.f, 0.f}, 0, 0, 0);
                    O[db] = Oa + Ob;
                }
#pragma unroll
                for (int kb = 0; kb < 2; ++kb)
#pragma unroll
                    for (int db = 0; db < 4; ++db) S[kb][db] = __builtin_amdgcn_mfma_f32_16x16x16bf16_1k(ke[kb], vt[db], S[kb][db] * dec[kb], 0, 0, 0);
                if (dir == 0) {
#pragma unroll
                    for (int db = 0; db < 4; ++db) *(f32x4*)(OG + (size_t)row * 384 + h * 64 + db * 16 + fq * 4) = O[db];
                } else {
                    float ss = 0.f;
#pragma unroll
                    for (int db = 0; db < 4; ++db) { O[db] = O[db] + og[db]; ss += (O[db][0] * O[db][0] + O[db][1] * O[db][1]) + (O[db][2] * O[db][2] + O[db][3] * O[db][3]); }
                    ss += __shfl_xor(ss, 16); ss += __shfl_xor(ss, 32);
                    const float rstd = rsqrtf(ss * (1.f / 64.f) + 1e-6f);
#pragma unroll
                    for (int db = 0; db < 4; ++db) { const f32x4 n4 = *(const f32x4*)(ngp + db * 16 + fq * 4);
                        const float r0 = bflo(rgw[db].x), r1 = bfhi(rgw[db].x), r2 = bflo(rgw[db].y), r3 = bfhi(rgw[db].y);
                        u32x2 w; w.x = pk2(O[db][0] * rstd * n4[0] * silu_f(r0), O[db][1] * rstd * n4[1] * silu_f(r1));
                        w.y = pk2(O[db][2] * rstd * n4[2] * silu_f(r2), O[db][3] * rstd * n4[3] * silu_f(r3));
                        *(u32x2*)(MIX + (size_t)row * DM + h * 64 + db * 16 + fq * 4) = w; }
                }
                LDS_WAIT();
            }
        }
    }
}

__device__ __forceinline__ void prep_phase(ParamsK p) {
    const float* mod = (const float*)(WSP + WS_MOD); float* GSV = (float*)(WSP + WS_GSV); float* BIAS = (float*)(WSP + WS_BIAS);
    const int gt = blockIdx.x * 512 + otid(), NGT = gridDim.x * 512;
    for (int i = gt; i < DEPTH * 2 * 9 * DM; i += NGT) { const int c = i & (DM - 1), r = (i >> 10) % 9, w = (i / (9 * DM)) & 1, l = i / (18 * DM);
        const float g = (w ? IN(7) : IN(6))[l * DM + c], sc = mod[(size_t)(l * 9 + r) * MODW + (w ? 4 : 1) * DM + c];
        GSV[i] = g * (1.f + sc); }
    constexpr int NCOL = INP + FF2;
    for (int t = gt; t < DEPTH * NCOL; t += NGT) { const int l = t / NCOL, cc = t % NCOL, w = cc >= INP, n = w ? cc - INP : cc;
        const bf16_t* wrow = w ? (const bf16_t*)(WSP + WS_WUP) + ((size_t)l * FF2 + n) * DM : (const bf16_t*)(WSP + WS_WIN) + ((size_t)l * INP + n) * DM;
        const float* sh = mod + (size_t)l * 9 * MODW + (w ? 3 : 0) * DM;
        float acc[9];
#pragma unroll
        for (int r = 0; r < 9; ++r) acc[r] = 0.f;
        for (int k = 0; k < DM; k += 8) { float wv[8]; unpack8(*(const u32x4*)(wrow + k), wv);
#pragma unroll
            for (int r = 0; r < 9; ++r) { const f32x4 s0 = *(const f32x4*)(sh + (size_t)r * MODW + k), s1 = *(const f32x4*)(sh + (size_t)r * MODW + k + 4);
                acc[r] += (s0[0] * wv[0] + s0[1] * wv[1]) + (s0[2] * wv[2] + s0[3] * wv[3]) + (s1[0] * wv[4] + s1[1] * wv[5]) + (s1[2] * wv[6] + s1[3] * wv[7]); } }
#pragma unroll
        for (int r = 0; r < 9; ++r) BIAS[((size_t)(l * 2 + w) * 9 + r) * FF2 + n] = acc[r]; }
}
__device__ __forceinline__ void stat_zero_phase(ParamsK p) {
    float* STAT = (float*)(WSP + WS_STAT);
    const int gt = blockIdx.x * 512 + otid(), NGT = gridDim.x * 512;
    for (int i = gt; i < 2 * TT; i += NGT) STAT[i] = 0.f;
}

__device__ __forceinline__ void shortconv_phase(ParamsK p, int l) {
    const bf16_t* U = (const bf16_t*)(WSP + WS_U); bf16_t* MIX = (bf16_t*)(WSP + WS_H);
    const float* cw = IN(14) + (size_t)l * 3 * 256; const float* cbias = IN(15) + (size_t)l * 256;
    const int gt = blockIdx.x * 512 + otid(), NGT = gridDim.x * 512;
    for (int task = gt; task < TT * 32; task += NGT) {
        const int R = task >> 5, c = (task & 31) * 8;
        int pos, L; if (R < TL) { pos = R & (SEQ - 1); L = SEQ; } else { pos = (R - TL) & (CTXL - 1); L = CTXL; }
        const bf16_t* ur = U + (size_t)R * INP;
        float bgt[8], cc[8], xx[8], acc[8];
        unpack8(*(const u32x4*)(ur + SB0 + c), bgt);
        unpack8(*(const u32x4*)(ur + SC0 + c), cc); unpack8(*(const u32x4*)(ur + SX0 + c), xx);
#pragma unroll
        for (int i = 0; i < 8; ++i) acc[i] = cbias[c + i] + cw[256 + c + i] * (cc[i] * xx[i]);
        if (pos > 0) { unpack8(*(const u32x4*)(ur - INP + SC0 + c), cc); unpack8(*(const u32x4*)(ur - INP + SX0 + c), xx);
#pragma unroll
            for (int i = 0; i < 8; ++i) acc[i] += cw[c + i] * (cc[i] * xx[i]); }
        if (pos < L - 1) { unpack8(*(const u32x4*)(ur + INP + SC0 + c), cc); unpack8(*(const u32x4*)(ur + INP + SX0 + c), xx);
#pragma unroll
            for (int i = 0; i < 8; ++i) acc[i] += cw[512 + c + i] * (cc[i] * xx[i]); }
        u32x4 w; w.x = pk2(bgt[0] * acc[0], bgt[1] * acc[1]); w.y = pk2(bgt[2] * acc[2], bgt[3] * acc[3]); w.z = pk2(bgt[4] * acc[4], bgt[5] * acc[5]); w.w = pk2(bgt[6] * acc[6], bgt[7] * acc[7]);
        *(u32x4*)(MIX + (size_t)R * DM + 384 + c) = w;
    }
}

__device__ __forceinline__ void vt_phase(ParamsK p, unsigned char* smem) {
    const bf16_t* U = (const bf16_t*)(WSP + WS_U);
    bf16_t* tile = (bf16_t*)smem;
    constexpr int TS = 72, NITEM = (TT / 64) * 12;
    const int tid = otid();
    const int tok = tid >> 3, d8 = (tid & 7) * 8;
    auto src = [&](int item) { const int tt = item / 12, hs = item % 12; const int col0 = hs < 6 ? NV0 + hs * 64 : V0 + (hs - 6) * 64;
        return U + (size_t)(tt * 64 + tok) * INP + col0 + d8; };
    int item = blockIdx.x;
    u32x4 wn = (u32x4){0u, 0u, 0u, 0u};
    if (item < NITEM) wn = *(const u32x4*)src(item);
    for (; item < NITEM; item += gridDim.x) {
        const u32x4 w = wn;
        if (item + (int)gridDim.x < NITEM) wn = *(const u32x4*)src(item + gridDim.x);
        const int tt = item / 12, hs = item % 12, row0 = tt * 64;
        const int h = hs < 6 ? hs : hs - 6;
        bf16_t* VTx = (bf16_t*)(WSP + (hs < 6 ? WS_VT : WS_VTG));
        int b, sp0; if (row0 < TL) { b = row0 >> 13; sp0 = row0 & (SEQ - 1); } else { b = (row0 - TL) >> 8; sp0 = SEQ + ((row0 - TL) & (CTXL - 1)); }
#pragma unroll
        for (int i = 0; i < 4; ++i) { tile[(d8 + 2 * i) * TS + tok] = (bf16_t)(w[i] & 0xffffu); tile[(d8 + 2 * i + 1) * TS + tok] = (bf16_t)(w[i] >> 16); }
        __syncthreads();
        { const int d = tid >> 3, t8 = (tid & 7) * 8;
          const u32x4 o = *(const u32x4*)(tile + d * TS + t8);
          *(u32x4*)(VTx + (size_t)((b * 6 + h) * 64 + d) * VTW + sp0 + t8) = o; }
        __syncthreads();
    }
}

template <int MODE>
__device__ __forceinline__ void na_chunk(const bf16_t* U, const bf16_t* vt, const float* rpbL, const bf16_t* Kc, const bf16_t* Vc, int b, int r, int h, int rs, int kc0, int qcol, int cs,
                                         const bf16x8 bq0, const bf16x8 bq1, float& m_run, float& l_run, f32x4 (&O)[4], int fr, int fq) {
    f32x4 s[16];
    float mx = -1e30f;
#pragma unroll
    for (int kg = 0; kg < 4; ++kg) {
        bf16x8 ka0[4], ka1[4];
#pragma unroll
        for (int i = 0; i < 4; ++i) { const int kb = kg * 4 + i;
            if (MODE == 2) { const bf16_t* kp = Kc + (kb * 16 + fr) * 72 + fq * 8; ka0[i] = as_bf16x8(*(const u32x4*)kp); ka1[i] = as_bf16x8(*(const u32x4*)(kp + 32)); }
            else { const int krow = MODE == 0 ? (b * SEQ + (rs + (kb >> 1)) * 64 + kc0 + (kb & 1) * 16 + fr) : (TL + b * CTXL + kb * 16 + fr);
                const bf16_t* kp = U + (size_t)krow * INP + NK0 + h * 64 + fq * 8; ka0[i] = as_bf16x8(*(const u32x4*)kp); ka1[i] = as_bf16x8(*(const u32x4*)(kp + 32)); } }
        __builtin_amdgcn_sched_barrier(0);
#pragma unroll
        for (int i = 0; i < 4; ++i) { const int kb = kg * 4 + i;
            f32x4 acc = (f32x4){0.f, 0.f, 0.f, 0.f};
            acc = __builtin_amdgcn_mfma_f32_16x16x32_bf16(ka0[i], bq0, acc, 0, 0, 0);
            acc = __builtin_amdgcn_mfma_f32_16x16x32_bf16(ka1[i], bq1, acc, 0, 0, 0);
            acc = acc * 0.125f;
            if (MODE == 0) {
                const int dr = rs + (kb >> 1) - r + 7;
#pragma unroll
                for (int j = 0; j < 4; ++j) { const int kcol = kc0 + (kb & 1) * 16 + fq * 4 + j; const bool valid = (kcol >= cs) && (kcol < cs + 16);
                    const int dc = min(max(kcol - qcol + 15, 0), 30);
                    acc[j] = valid ? acc[j] + rpbL[(h * 15 + dr) * 31 + dc] : -1e30f; }
            }
            s[kb] = acc;
            mx = fmaxf(mx, fmaxf(fmaxf(acc[0], acc[1]), fmaxf(acc[2], acc[3])));
        }
        __builtin_amdgcn_sched_barrier(0);
    }
    mx = fmaxf(mx, __shfl_xor(mx, 16)); mx = fmaxf(mx, __shfl_xor(mx, 32));
    const float m_new = fmaxf(m_run, mx), alpha = __expf(m_run - m_new);
    float lsum = 0.f; unsigned pkd[16][2];
#pragma unroll
    for (int kb = 0; kb < 16; ++kb) { const float p0 = __expf(s[kb][0] - m_new), p1 = __expf(s[kb][1] - m_new), p2 = __expf(s[kb][2] - m_new), p3 = __expf(s[kb][3] - m_new);
        lsum += (p0 + p1) + (p2 + p3); pkd[kb][0] = pk2(p0, p1); pkd[kb][1] = pk2(p2, p3); }
    lsum += __shfl_xor(lsum, 16); lsum += __shfl_xor(lsum, 32);
    l_run = l_run * alpha + lsum; m_run = m_new;
#pragma unroll
    for (int db = 0; db < 4; ++db) O[db] = O[db] * alpha;
#pragma unroll
    for (int pg = 0; pg < 4; ++pg) {
        u32x2 vlo[2][4], vhi[2][4];
#pragma unroll
        for (int i = 0; i < 2; ++i) { const int pr = pg * 2 + i;
            const int posA = MODE == 0 ? ((rs + pr) * 64 + kc0 + fq * 4) : (SEQ + pr * 32 + fq * 4);
#pragma unroll
            for (int db = 0; db < 4; ++db) {
                if (MODE == 2) { const bf16_t* vp = Vc + (db * 16 + fr) * 264 + pr * 32 + fq * 4; vlo[i][db] = *(const u32x2*)vp; vhi[i][db] = *(const u32x2*)(vp + 16); }
                else { const bf16_t* vp = vt + (size_t)(db * 16) * VTW + posA; vlo[i][db] = *(const u32x2*)vp; vhi[i][db] = *(const u32x2*)(vp + 16); } } }
        __builtin_amdgcn_sched_barrier(0);
#pragma unroll
        for (int i = 0; i < 2; ++i) { const int pr = pg * 2 + i;
            u32x4 bw; bw.x = pkd[2 * pr][0]; bw.y = pkd[2 * pr][1]; bw.z = pkd[2 * pr + 1][0]; bw.w = pkd[2 * pr + 1][1];
            const bf16x8 bp = as_bf16x8(bw);
#pragma unroll
            for (int db = 0; db < 4; ++db) { u32x4 aw; aw.x = vlo[i][db].x; aw.y = vlo[i][db].y; aw.z = vhi[i][db].x; aw.w = vhi[i][db].y;
                O[db] = __builtin_amdgcn_mfma_f32_16x16x32_bf16(as_bf16x8(aw), bp, O[db], 0, 0, 0); } }
        __builtin_amdgcn_sched_barrier(0);
    }
}
template <bool CTXLDS>
__device__ __forceinline__ void na_tile(const bf16_t* U, const bf16_t* VT, bf16_t* MIX, const float* rpbL, const bf16_t* Kc, const bf16_t* Vc, bool lat, int b, int r, int c0, int qrow0, int h, int lane) {
    const int fr = lane & 15, fq = lane >> 4;
    const bf16_t* qp = U + (size_t)(qrow0 + fr) * INP + NQ0 + h * 64 + fq * 8;
    const bf16x8 bq0 = as_bf16x8(*(const u32x4*)qp), bq1 = as_bf16x8(*(const u32x4*)(qp + 32));
    float m_run = -1e30f, l_run = 0.f;
    f32x4 O[4];
#pragma unroll
    for (int db = 0; db < 4; ++db) O[db] = (f32x4){0.f, 0.f, 0.f, 0.f};
    const bf16_t* vt = VT + (size_t)((b * 6 + h) * 64 + fr) * VTW;
    const int rs = min(max(r - 4, 0), 120), kc0 = min(max(c0 - 8, 0), 32);
    const int qcol = c0 + fr, cs = min(max(qcol - 8, 0), 48);
    if (lat) na_chunk<0>(U, vt, rpbL, Kc, Vc, b, r, h, rs, kc0, qcol, cs, bq0, bq1, m_run, l_run, O, fr, fq);
    na_chunk<CTXLDS ? 2 : 1>(U, vt, rpbL, Kc, Vc, b, r, h, rs, kc0, qcol, cs, bq0, bq1, m_run, l_run, O, fr, fq);
    const float inv = 1.f / l_run;
    bf16_t* op = MIX + (size_t)(qrow0 + fr) * DM + 640 + h * 64 + fq * 4;
#pragma unroll
    for (int db = 0; db < 4; ++db) { u32x2 w; w.x = pk2(O[db][0] * inv, O[db][1] * inv); w.y = pk2(O[db][2] * inv, O[db][3] * inv); *(u32x2*)(op + db * 16) = w; }
}
__device__ __forceinline__ void na_phase(ParamsK p, int l, unsigned char* smem, bool with_ctx) {
    const int tid = otid(), lane = tid & 63, wave = __builtin_amdgcn_readfirstlane(tid >> 6);
    float* rpbL = (float*)smem;
    bf16_t* Kc = (bf16_t*)(smem + 12288);
    bf16_t* Vc = (bf16_t*)(smem + 12288 + 36864);
    const float* rpb = IN(16) + (size_t)l * 6 * 15 * 31;
    for (int i = tid; i < 6 * 15 * 31; i += 512) rpbL[i] = rpb[i];
    __syncthreads();
    const bf16_t* U = (const bf16_t*)(WSP + WS_U); const bf16_t* VT = (const bf16_t*)(WSP + WS_VT); bf16_t* MIX = (bf16_t*)(WSP + WS_H);
    const int b = blockIdx.x & 7, lw = (blockIdx.x >> 3) * 8 + wave, nlw = (gridDim.x >> 3) * 8;
    const int NL = (SEQ / 16) * 6, NC = with_ctx ? (CTXL / 16) * 6 : 0;
    if (nlw == 256) {
        for (int round = 0; round < NL / 256; ++round) {
            const int w = lw + 256 * round, cq = w & 3, rr = (w >> 2) & 1, h = (w >> 3) % 6, r = (w / 48) * 2 + rr;
            __syncthreads();
#pragma unroll
            for (int i = 0; i < 4; ++i) { const int idx = i * 512 + tid, key = idx >> 3, part = idx & 7;
                *(u32x4*)(Kc + key * 72 + part * 8) = *(const u32x4*)(U + (size_t)(TL + b * CTXL + key) * INP + NK0 + h * 64 + part * 8); }
#pragma unroll
            for (int i = 0; i < 4; ++i) { const int idx = i * 512 + tid, d = idx >> 5, part = idx & 31;
                *(u32x4*)(Vc + d * 264 + part * 8) = *(const u32x4*)(VT + (size_t)((b * 6 + h) * 64 + d) * VTW + SEQ + part * 8); }
            __syncthreads();
            na_tile<true>(U, VT, MIX, rpbL, Kc, Vc, true, b, r, cq * 16, b * SEQ + r * 64 + cq * 16, h, lane);
        }
        for (int w = NL + lw; w < NL + NC; w += nlw) { const int t2 = w - NL, h = t2 % 6, qt = t2 / 6;
            na_tile<false>(U, VT, MIX, rpbL, Kc, Vc, false, b, 0, 0, TL + b * CTXL + qt * 16, h, lane); }
    } else {
        for (int w = lw; w < NL + NC; w += nlw) {
            if (w < NL) { const int cq = w & 3, h = (w >> 2) % 6, r = w / 24;
                na_tile<false>(U, VT, MIX, rpbL, Kc, Vc, true, b, r, cq * 16, b * SEQ + r * 64 + cq * 16, h, lane); }
            else { const int t2 = w - NL, h = t2 % 6, qt = t2 / 6;
                na_tile<false>(U, VT, MIX, rpbL, Kc, Vc, false, b, 0, 0, TL + b * CTXL + qt * 16, h, lane); }
        }
    }
    __syncthreads();
}

__device__ __forceinline__ void convgate_phase(ParamsK p, int l, int hs, int nrows) {
    constexpr int CG_RUN = 96, CG_LA = 6, NCG = FFN / 8;
    const bf16_t* FU = (const bf16_t*)(WSP + WS_FU); bf16_t* ACT = (bf16_t*)(WSP + WS_ACT);
    const float* cw = IN(19) + (size_t)l * 3 * FF2; const float* cb = IN(20) + (size_t)l * FF2;
    const int gt = blockIdx.x * 512 + otid();
    const int cgi = gt % NCG, sl = gt / NCG, c = cgi * 8;
    const int r0 = sl * CG_RUN;
    if (r0 >= nrows) return;
    const int r1 = min(r0 + CG_RUN, nrows);
    float wa[3][8], wb[3][8], ba[8], bb[8];
#pragma unroll
    for (int j = 0; j < 3; ++j)
#pragma unroll
        for (int i = 0; i < 8; ++i) { wa[j][i] = cw[j * FF2 + c + i]; wb[j][i] = cw[j * FF2 + FFN + c + i]; }
#pragma unroll
    for (int i = 0; i < 8; ++i) { ba[i] = cb[c + i]; bb[i] = cb[FFN + c + i]; }
    const bf16_t* ub = FU + c;
    auto seqpos = [&](int lr, int& pos, int& L) { const int Rg = hs + lr; if (Rg < TL) { pos = Rg & (SEQ - 1); L = SEQ; } else { pos = (Rg - TL) & (CTXL - 1); L = CTXL; } };
    float pa[8], pb[8], ca[8], cbv[8];
    { int pos, L; seqpos(r0, pos, L);
      if (pos > 0) { unpack8(*(const u32x4*)(ub + (size_t)(r0 - 1) * FF2), pa); unpack8(*(const u32x4*)(ub + (size_t)(r0 - 1) * FF2 + FFN), pb); }
      else {
#pragma unroll
          for (int i = 0; i < 8; ++i) { pa[i] = 0.f; pb[i] = 0.f; } }
      unpack8(*(const u32x4*)(ub + (size_t)r0 * FF2), ca); unpack8(*(const u32x4*)(ub + (size_t)r0 * FF2 + FFN), cbv); }
    u32x4 ra[CG_LA], rb[CG_LA];
#pragma unroll
    for (int i = 0; i < CG_LA; ++i) { const int lr = min(r0 + 1 + i, nrows - 1); ra[i] = *(const u32x4*)(ub + (size_t)lr * FF2); rb[i] = *(const u32x4*)(ub + (size_t)lr * FF2 + FFN); }
    for (int t = r0; t < r1; t += CG_LA) {
#pragma unroll
        for (int i = 0; i < CG_LA; ++i) {
            const int row = t + i;
            const u32x4 xa = ra[i], xb = rb[i];
            { const int lr = min(row + 1 + CG_LA, nrows - 1); ra[i] = *(const u32x4*)(ub + (size_t)lr * FF2); rb[i] = *(const u32x4*)(ub + (size_t)lr * FF2 + FFN); }
            int pos, L; seqpos(row, pos, L);
            float na[8], nb[8];
            if (pos < L - 1 && row + 1 < nrows) { unpack8(xa, na); unpack8(xb, nb); }
            else {
#pragma unroll
                for (int k = 0; k < 8; ++k) { na[k] = 0.f; nb[k] = 0.f; } }
            if (row < r1) {
                float o[8];
#pragma unroll
                for (int k = 0; k < 8; ++k) { const float a = wa[0][k] * pa[k] + wa[1][k] * ca[k] + wa[2][k] * na[k] + ba[k];
                    const float g = wb[0][k] * pb[k] + wb[1][k] * cbv[k] + wb[2][k] * nb[k] + bb[k];
                    o[k] = silu_f(a) * g; }
                u32x4 w; w.x = pk2(o[0], o[1]); w.y = pk2(o[2], o[3]); w.z = pk2(o[4], o[5]); w.w = pk2(o[6], o[7]);
                *(u32x4*)(ACT + (size_t)row * FFN + c) = w;
            }
            const bool lastOfSeq = (pos == L - 1);
#pragma unroll
            for (int k = 0; k < 8; ++k) { pa[k] = lastOfSeq ? 0.f : ca[k]; pb[k] = lastOfSeq ? 0.f : cbv[k]; }
            if (lastOfSeq && row + 1 < nrows) { unpack8(xa, ca); unpack8(xb, cbv); }
            else {
#pragma unroll
                for (int k = 0; k < 8; ++k) { ca[k] = na[k]; cbv[k] = nb[k]; } }
        }
    }
}

__global__ void __launch_bounds__(512, 2) fwd_megakernel(Params p_unused) {
    extern __shared__ __attribute__((aligned(16))) unsigned char smem[];
    cg::grid_group grid = cg::this_grid();
    __shared__ uint4 xb_words;
    if (threadIdx.x == 0) xb_words = make_uint4(0u, 0u, 0u, 0u);
    __syncthreads();
    XcdBarrier xb; { ParamsK p = getpk(); xb = xcd_barrier_post((unsigned*)(WSP + WS_CTL), (volatile LAS unsigned*)&xb_words); }
    { ParamsK p = getpk(); ada_phase(p, smem); }
    { ParamsK p = getpk(); weights_phase(p, smem); }
    GSYNC_CG();
    { ParamsK p = getpk(); prep_phase(p); }
    for (int l = 0; l < DEPTH; ++l) {
        const bool upd = l < DEPTH - 1;
        const int Mout = upd ? TT : TL;
        if (l == 0) {
            { ParamsK p = getpk(); const float* ml = (const float*)(WSP + WS_MOD);
              norm_phase(IN(0), IN(2), IN(6), ml, ml + DM, (bf16_t*)(WSP + WS_H), TT); }
            GSYNC();
            { ParamsK p = getpk(); EpiStore E; E.O = (bf16_t*)(WSP + WS_U); E.ldc = INP;
              run_gemm(smem, (const bf16_t*)(WSP + WS_H), (const bf16_t*)(WSP + WS_WIN), TT, INP, DM, E); }
        } else {
            ParamsK p = getpk(); EpiStoreN E; E.O = (bf16_t*)(WSP + WS_U); E.ldc = INP; E.stat = (const float*)(WSP + WS_STAT); E.bias = (const float*)(WSP + WS_BIAS) + (size_t)(l * 2) * 9 * FF2; E.rowbase = 0;
            run_gemm(smem, (const bf16_t*)(WSP + WS_H), (const bf16_t*)(WSP + WS_WIN) + (size_t)l * INP * DM, TT, INP, DM, E);
        }
        GSYNC();
        for (int rep = 0; rep < REP_VT; ++rep) { ParamsK p = getpk(); vt_phase(p, smem); }
        { ParamsK p = getpk(); shortconv_phase(p, l); }
        GSYNC();
        for (int rep = 0; rep < REP_GLA; ++rep) { ParamsK p = getpk(); gla_step1(p, l, smem); }
        __syncthreads();
        for (int rep = 0; rep < REP_NA; ++rep) { ParamsK p = getpk(); na_phase(p, l, smem, upd); }
        GSYNC();
        { ParamsK p = getpk(); gla_step2(p); }
        GSYNC();
        for (int rep = 0; rep < REP_GLA; ++rep) { ParamsK p = getpk(); gla_step3(p, l, smem); }
        GSYNC();
        { ParamsK p = getpk(); const float* ml = (const float*)(WSP + WS_MOD) + (size_t)l * 9 * MODW;
          EpiResidN E; E.rin_l = l == 0 ? IN(0) : OUTP; E.rin_c = l == 0 ? IN(2) : (const float*)(WSP + WS_XC); E.rout_l = OUTP; E.rout_c = (float*)(WSP + WS_XC); E.gate = ml + 2 * DM; E.rowbase = 0;
          E.Hn = (bf16_t*)(WSP + WS_H2); E.gs = (const float*)(WSP + WS_GSV) + (size_t)(l * 2 + 1) * 9 * DM; E.stat = (float*)(WSP + WS_STAT) + (size_t)TT * 16;
          run_gemm(smem, (const bf16_t*)(WSP + WS_H), (const bf16_t*)(WSP + WS_WOUT) + (size_t)l * DM * DM, Mout, DM, DM, E); }
        GSYNC();
        for (int half = 0; half < 2; ++half) {
            const int hs = half * HALF0, nr = half == 0 ? HALF0 : Mout - HALF0;
            { ParamsK p = getpk(); EpiStoreN E; E.O = (bf16_t*)(WSP + WS_FU); E.ldc = FF2; E.stat = (const float*)(WSP + WS_STAT) + (size_t)TT * 16; E.bias = (const float*)(WSP + WS_BIAS) + (size_t)(l * 2 + 1) * 9 * FF2; E.rowbase = hs;
              run_gemm(smem, (const bf16_t*)(WSP + WS_H2) + (size_t)hs * DM, (const bf16_t*)(WSP + WS_WUP) + (size_t)l * FF2 * DM, nr, FF2, DM, E); }
            GSYNC();
            for (int rep = 0; rep < REP_CG; ++rep) { ParamsK p = getpk(); convgate_phase(p, l, hs, nr); }
            GSYNC();
            if (upd) { ParamsK p = getpk(); const float* ml = (const float*)(WSP + WS_MOD) + (size_t)l * 9 * MODW;
              EpiResidN E; E.rin_l = OUTP; E.rin_c = (const float*)(WSP + WS_XC); E.rout_l = OUTP; E.rout_c = (float*)(WSP + WS_XC); E.gate = ml + 5 * DM; E.rowbase = hs;
              E.Hn = (bf16_t*)(WSP + WS_H); E.gs = (const float*)(WSP + WS_GSV) + (size_t)((l + 1) * 2) * 9 * DM; E.stat = (float*)(WSP + WS_STAT);
              run_gemm(smem, (const bf16_t*)(WSP + WS_ACT), (const bf16_t*)(WSP + WS_WDN) + (size_t)l * DM * FFN, nr, DM, FFN, E); }
            else { ParamsK p = getpk(); const float* ml = (const float*)(WSP + WS_MOD) + (size_t)l * 9 * MODW;
              EpiResid E; E.rin_l = OUTP; E.rin_c = (const float*)(WSP + WS_XC); E.rout_l = OUTP; E.rout_c = (float*)(WSP + WS_XC); E.gate = ml + 5 * DM; E.rowbase = hs;
              run_gemm(smem, (const bf16_t*)(WSP + WS_ACT), (const bf16_t*)(WSP + WS_WDN) + (size_t)l * DM * FFN, nr, DM, FFN, E); }
        }
        GSYNC();
    }
    { ParamsK p = getpk(); final_norm_phase(OUTP, IN(22)); }
}

extern "C" void kernel_launch(void* const* d_in, const int* in_sizes, int n_in, void* d_out, int out_size, void* d_ws, size_t ws_size, hipStream_t stream) {
    static int grid_blocks = 0;
    if (grid_blocks == 0) {
        if (n_in != 23 || ws_size < WS_NEED) { fprintf(stderr, "kernel_launch: unexpected n_in %d or ws %zu < %zu\n", n_in, ws_size, (size_t)WS_NEED); grid_blocks = -1; return; }
        int dev = 0, cus = 0, per_cu = 0;
        hipGetDevice(&dev);
        hipDeviceGetAttribute(&cus, hipDeviceAttributeMultiprocessorCount, dev);
        if (hipFuncSetAttribute((const void*)fwd_megakernel, hipFuncAttributeMaxDynamicSharedMemorySize, LDS_BYTES) != hipSuccess) { fprintf(stderr, "kernel_launch: hipFuncSetAttribute failed\n"); }
        if (hipOccupancyMaxActiveBlocksPerMultiprocessor(&per_cu, (const void*)fwd_megakernel, 512, LDS_BYTES) != hipSuccess || per_cu < 1) { fprintf(stderr, "kernel_launch: occupancy query gave %d\n", per_cu); per_cu = 1; }
        (void)hipGetLastError();
        grid_blocks = cus * 1;
        if (grid_blocks <= 0) grid_blocks = 256;
    }
    if (grid_blocks < 0) return;
    if (hipMemsetAsync((char*)d_ws + WS_CTL, 0, 16384, stream) != hipSuccess) { fprintf(stderr, "kernel_launch: hipMemsetAsync of the barrier word failed\n"); return; }
    Params p{};
    for (int i = 0; i < 23; ++i) p.in[i] = (const float*)d_in[i];
    p.out = (float*)d_out; p.ws = (unsigned char*)d_ws;
    void* args[] = {&p};
    hipError_t e = hipLaunchCooperativeKernel((const void*)fwd_megakernel, dim3(grid_blocks), dim3(512), args, LDS_BYTES, stream);
    if (e != hipSuccess) fprintf(stderr, "cooperative launch failed: %s (grid %d)\n", hipGetErrorString(e), grid_blocks);
}
```

```cpp
#include <hip/hip_runtime.h>
#include <hip/hip_cooperative_groups.h>
#include <cstdio>
#include <cstdint>
namespace cg = cooperative_groups;
__device__ __forceinline__ int otid() { int t = threadIdx.x; asm volatile("" : "+v"(t)); return t; }
namespace pg8 {
#define PG8_LAS __attribute__((address_space(3)))
typedef unsigned short bf16_t;
typedef short bf16x8 __attribute__((ext_vector_type(8)));
typedef float f32x4 __attribute__((ext_vector_type(4)));
typedef unsigned u32x4 __attribute__((ext_vector_type(4)));
constexpr int BM = 256, BK = 64, HALF = 128, HTB = HALF * BK * 2  , STAGE_BYTES = 8 * HTB, NXCD = 8, WGM = 8;

__host__ __device__ __forceinline__ int lds_byte(int r, int c) { const int st = (r >> 4) * 2 + (c >> 5), rr = r & 15, cc = c & 31, ob = rr * 64 + cc * 2; return st * 1024 + (ob ^ (((ob >> 9) & 1) << 5)); }
__host__ __device__ __forceinline__ void stage_rc(int b, int& R, int& C) { const int st = b / 1024, sb = b % 1024, swz = sb ^ (((sb >> 9) & 1) << 5); R = (st >> 1) * 16 + swz / 64; C = (st & 1) * 32 + (swz % 64) / 2; }
__host__ __device__ __forceinline__ int perm32(int rho) { const int n = rho >> 4, i = rho & 15; return 8 * (i >> 2) + 4 * n + (i & 3); }

struct Unit { int pm, pn; };
struct Gemm { const bf16_t* A; const bf16_t* Bt; int M, N, K; };

struct StaticOrder {
    int nM, nN, nwg, G, c;
    __host__ __device__ void init(int M, int N, int G_, int c_) { nM = M / BM; nN = N / BM; nwg = nM * nN; G = G_; c = c_; }
    __host__ __device__ bool next(int i, Unit& u) const {
        const long L = (long)i * G + c; if (L >= nwg) return false;
        int wgid = (int)L; { const int q = nwg / NXCD, r = nwg % NXCD, xcd = wgid % NXCD, off = wgid / NXCD; wgid = (xcd < r ? xcd * (q + 1) : r * (q + 1) + (xcd - r) * q) + off; }
        const int nig = WGM * nN, gid = wgid / nig, fm = gid * WGM, gsz = (nM - fm) < WGM ? (nM - fm) : WGM;
        u.pm = fm + ((wgid % nig) % gsz); u.pn = (wgid % nig) / gsz; return true;
    }
    __device__ __forceinline__ void a_ready(const Unit&) const {}
    __device__ __forceinline__ void done(const Unit&) const {}
};

typedef float f32x2v_ __attribute__((ext_vector_type(2)));
typedef __bf16 bf16x2v_ __attribute__((ext_vector_type(2)));
__device__ __forceinline__ unsigned cvt_pk_bf16(float lo, float hi) { f32x2v_ v = {lo, hi}; bf16x2v_ b = __builtin_convertvector(v, bf16x2v_); return __builtin_bit_cast(unsigned, b); }
template <class Epi, class Sched, bool ALIGN_EPI = false, bool SP2 = false>
__device__ __forceinline__ void gemm_phase(PG8_LAS unsigned char* lds, const Gemm g, const Sched& S, const Epi& E) {
    const int tid = otid(), wid = __builtin_amdgcn_readfirstlane(tid >> 6), lane = tid & 63, wr = wid >> 2, wc = wid & 3, fr = lane & 15, fq = lane >> 4;
    const int K = g.K, nt = K / BK;
    unsigned voffA[2], voffB[2];
#pragma unroll
    for (int i = 0; i < 2; ++i) { int R, C; stage_rc(tid * 16 + i * 8192, R, C); const int Rb = Epi::PERM ? ((R & ~31) + perm32(R & 31)) : R;
        voffA[i] = (unsigned)(R * K + C) * 2u; voffB[i] = (unsigned)(Rb * K + C) * 2u; }
    const size_t kstep = (size_t)(BK * 2);
    const size_t hstep = (size_t)HALF * K * 2;
    const size_t tstep = 2 * hstep;
    const unsigned ldsw = (unsigned)wid * 1024u;
    const int aoff = lds_byte(wr * 64 + fr, fq * 8), boff = lds_byte(wc * 32 + fr, fq * 8);
#define PG8_SA(b, h) (((b) * 2 + (h)) * HTB)
#define PG8_SB(b, h) ((4 + (b) * 2 + (h)) * HTB)
#define PG8_STAGE(bufoff, gbase, voff) do { _Pragma("unroll") for (int _i = 0; _i < 2; ++_i) \
        __builtin_amdgcn_global_load_lds((const unsigned*)((const char*)(gbase) + (voff)[_i]), (PG8_LAS unsigned*)(lds + (bufoff) + ldsw + _i * 8192), 16, 0, 0); } while (0)
#define PG8_LDA(dst, b, h) do { _Pragma("unroll") for (int m = 0; m < 4; ++m) _Pragma("unroll") for (int k = 0; k < 2; ++k) dst[m][k] = *(const PG8_LAS bf16x8*)(lds + PG8_SA(b, h) + aoff + m * 2048 + k * 1024); } while (0)
#define PG8_LDB(dst, b, h) do { _Pragma("unroll") for (int n = 0; n < 2; ++n) _Pragma("unroll") for (int k = 0; k < 2; ++k) dst[n][k] = *(const PG8_LAS bf16x8*)(lds + PG8_SB(b, h) + boff + n * 2048 + k * 1024); } while (0)
#define PG8_MMA(ai, bj, At, Bt) do { __builtin_amdgcn_s_setprio(1); _Pragma("unroll") for (int m = 0; m < 4; ++m) _Pragma("unroll") for (int n = 0; n < 2; ++n) _Pragma("unroll") for (int k = 0; k < 2; ++k) \
        acc[ai][bj][m][n] = __builtin_amdgcn_mfma_f32_16x16x32_bf16(Bt[n][k], At[m][k], acc[ai][bj][m][n], 0, 0, 0); __builtin_amdgcn_s_setprio(0); } while (0)
#define PG8_WAIT_V(n) asm volatile("s_waitcnt vmcnt(" #n ")" ::: "memory")
#define PG8_WAIT_L(n) asm volatile("s_waitcnt lgkmcnt(" #n ")" ::: "memory")
#define PG8_BAR __builtin_amdgcn_s_barrier()
#define PG8_SCHED __builtin_amdgcn_sched_barrier(0)
    Unit cur, nxt; int ui = 0;
    if (!S.next(0, cur)) return;
    f32x4 acc[2][2][4][2];
#pragma unroll
    for (int a = 0; a < 2; ++a)
#pragma unroll
        for (int b = 0; b < 2; ++b)
#pragma unroll
            for (int m = 0; m < 4; ++m)
#pragma unroll
                for (int n = 0; n < 2; ++n) acc[a][b][m][n] = (f32x4){0.f, 0.f, 0.f, 0.f};
    bf16x8 At[4][2], B0[2][2], B1[2][2];
    const char* cA = (const char*)g.A + (size_t)cur.pm * tstep; const char* cB = (const char*)g.Bt + (size_t)cur.pn * tstep;
    S.a_ready(cur);
    if constexpr (SP2) {
        PG8_STAGE(PG8_SB(0, 0), cB, voffB); PG8_STAGE(PG8_SB(0, 1), cB + hstep, voffB); PG8_STAGE(PG8_SA(0, 0), cA, voffA); PG8_STAGE(PG8_SA(0, 1), cA + hstep, voffA);
        if (wr == 1) PG8_BAR;
        PG8_WAIT_V(2); PG8_BAR;
        PG8_STAGE(PG8_SB(1, 0), cB + kstep, voffB); PG8_STAGE(PG8_SA(1, 0), cA + kstep, voffA); PG8_STAGE(PG8_SB(1, 1), cB + hstep + kstep, voffB);
        PG8_WAIT_V(6); PG8_BAR;
    } else {
        PG8_STAGE(PG8_SB(0, 0), cB, voffB); PG8_STAGE(PG8_SA(0, 0), cA, voffA); PG8_STAGE(PG8_SB(0, 1), cB + hstep, voffB); PG8_STAGE(PG8_SA(0, 1), cA + hstep, voffA);
        if (wr == 1) PG8_BAR;
        PG8_WAIT_V(4); PG8_BAR;
        PG8_STAGE(PG8_SB(1, 0), cB + kstep, voffB); PG8_STAGE(PG8_SA(1, 0), cA + kstep, voffA); PG8_STAGE(PG8_SB(1, 1), cB + hstep + kstep, voffB);
        PG8_WAIT_V(6); PG8_BAR;
    }
    for (;;) {
        const bool has_next = S.next(ui + 1, nxt);
        const char* nA = has_next ? (const char*)g.A + (size_t)nxt.pm * tstep : cA; const char* nB = has_next ? (const char*)g.Bt + (size_t)nxt.pn * tstep : cB;
        for (int t = 0; t < nt; t += 2) {
            const bool last = (t == nt - 2);
            const char* a1 = cA + (size_t)(t + 1) * kstep;
            const char* a2 = last ? nA : cA + (size_t)(t + 2) * kstep; const char* b2 = last ? nB : cB + (size_t)(t + 2) * kstep;
            const char* a3 = a2 + kstep; const char* b3 = b2 + kstep;
            if (last && has_next) S.a_ready(nxt);
            if constexpr (SP2) {
            PG8_LDB(B0, 0, 0); PG8_LDB(B1, 0, 1); PG8_SCHED; PG8_LDA(At, 0, 0); PG8_STAGE(PG8_SA(1, 1), a1 + hstep, voffA);
            PG8_WAIT_V(8); PG8_WAIT_L(0); PG8_BAR; PG8_MMA(0, 0, At, B0); PG8_MMA(0, 1, At, B1); PG8_BAR; PG8_SCHED;
            PG8_LDA(At, 0, 1); PG8_STAGE(PG8_SB(0, 0), b2, voffB); PG8_STAGE(PG8_SB(0, 1), b2 + hstep, voffB); PG8_STAGE(PG8_SA(0, 0), a2, voffA);
            PG8_WAIT_V(8); PG8_WAIT_L(0); PG8_BAR; PG8_MMA(1, 0, At, B0); PG8_MMA(1, 1, At, B1); PG8_BAR; PG8_SCHED;
            PG8_LDB(B0, 1, 0); PG8_LDB(B1, 1, 1); PG8_SCHED; PG8_LDA(At, 1, 0); PG8_STAGE(PG8_SA(0, 1), a2 + hstep, voffA);
            PG8_WAIT_V(8); PG8_WAIT_L(0); PG8_BAR; PG8_MMA(0, 0, At, B0); PG8_MMA(0, 1, At, B1); PG8_BAR; PG8_SCHED;
            PG8_LDA(At, 1, 1); PG8_STAGE(PG8_SB(1, 0), b3, voffB); PG8_STAGE(PG8_SB(1, 1), b3 + hstep, voffB); PG8_STAGE(PG8_SA(1, 0), a3, voffA);
            PG8_WAIT_V(8); PG8_WAIT_L(0); PG8_BAR; PG8_MMA(1, 0, At, B0); PG8_MMA(1, 1, At, B1); PG8_BAR; PG8_SCHED;
            } else {
            PG8_LDB(B0, 0, 0); PG8_SCHED; PG8_LDA(At, 0, 0); PG8_STAGE(PG8_SA(1, 1), a1 + hstep, voffA);
            PG8_WAIT_L(8); PG8_BAR; PG8_WAIT_L(0); PG8_MMA(0, 0, At, B0); PG8_BAR; PG8_SCHED;
            PG8_LDB(B1, 0, 1); PG8_STAGE(PG8_SB(0, 0), b2, voffB);
            PG8_BAR; PG8_WAIT_L(0); PG8_MMA(0, 1, At, B1); PG8_BAR;
            PG8_LDA(At, 0, 1); PG8_STAGE(PG8_SA(0, 0), a2, voffA);
            PG8_BAR; PG8_WAIT_L(0); PG8_MMA(1, 0, At, B0); PG8_BAR; PG8_SCHED;
            PG8_STAGE(PG8_SB(0, 1), b2 + hstep, voffB);
            PG8_WAIT_V(6); PG8_BAR; PG8_MMA(1, 1, At, B1); PG8_BAR;
            PG8_LDB(B0, 1, 0); PG8_SCHED; PG8_LDA(At, 1, 0); PG8_STAGE(PG8_SA(0, 1), a2 + hstep, voffA);
            PG8_WAIT_L(8); PG8_BAR; PG8_WAIT_L(0); PG8_MMA(0, 0, At, B0); PG8_BAR; PG8_SCHED;
            PG8_LDB(B1, 1, 1); PG8_STAGE(PG8_SB(1, 0), b3, voffB);
            PG8_BAR; PG8_WAIT_L(0); PG8_MMA(0, 1, At, B1); PG8_BAR;
            PG8_LDA(At, 1, 1); PG8_STAGE(PG8_SA(1, 0), a3, voffA);
            PG8_BAR; PG8_WAIT_L(0); PG8_MMA(1, 0, At, B0); PG8_BAR; PG8_SCHED;
            PG8_STAGE(PG8_SB(1, 1), b3 + hstep, voffB);
            PG8_WAIT_V(6); PG8_BAR; PG8_MMA(1, 1, At, B1); PG8_BAR;
            }
        }
        if constexpr (ALIGN_EPI) { if (wr == 0) PG8_BAR; }
        if constexpr (!Epi::AFTER_DRAIN) { E(acc, cur, wr, wc, fr, fq); S.done(cur); }
        if (!has_next) break;
#pragma unroll
        for (int a = 0; a < 2; ++a)
#pragma unroll
            for (int b = 0; b < 2; ++b)
#pragma unroll
                for (int m = 0; m < 4; ++m)
#pragma unroll
                    for (int n = 0; n < 2; ++n) acc[a][b][m][n] = (f32x4){0.f, 0.f, 0.f, 0.f};
        cur = nxt; cA = nA; cB = nB; ++ui;
        if constexpr (ALIGN_EPI) { if (wr == 1) PG8_BAR; }
    }
    PG8_WAIT_V(0);
    if constexpr (!ALIGN_EPI) { if (wr == 0) PG8_BAR; }
    PG8_BAR;
    if constexpr (Epi::AFTER_DRAIN) { E.fused(acc, cur, wr, wc, fr, fq, lds, wid, lane); S.done(cur); }
#undef PG8_SA
#undef PG8_SB
#undef PG8_STAGE
#undef PG8_LDA
#undef PG8_LDB
#undef PG8_MMA
#undef PG8_WAIT_V
#undef PG8_WAIT_L
#undef PG8_BAR
#undef PG8_SCHED
}
}

typedef unsigned short bf16_t;
typedef short bf16x8 __attribute__((ext_vector_type(8)));
typedef float f32x4 __attribute__((ext_vector_type(4)));
typedef unsigned u32x4 __attribute__((ext_vector_type(4)));
typedef unsigned u32x2 __attribute__((ext_vector_type(2)));
#define LAS __attribute__((address_space(3)))

constexpr int DM = 1024, NBAT = 8, SEQ = 8192, DEPTH = 4, CTXL = 256;
constexpr int TL = NBAT * SEQ, TC = NBAT * CTXL, TT = TL + TC;
constexpr int INW = 3104, INP = 3328;
constexpr int Q0 = 0, K0 = 192, V0 = 384, GF0 = 768, GB0 = 784, R0 = 800, SB0 = 1184, SC0 = 1440, SX0 = 1696, NQ0 = 1952, NK0 = 2336, NV0 = 2720;
constexpr int FFN = 2816, FF2 = 5632;
constexpr int MODW = 6 * DM;
constexpr int NCH = 132;
constexpr int VTW = SEQ + CTXL;
constexpr int HALF0 = 32768;

constexpr size_t WS_WIN = 0;
constexpr size_t WS_WOUT = WS_WIN + (size_t)DEPTH * INP * DM * 2;
constexpr size_t WS_WUP = WS_WOUT + (size_t)DEPTH * DM * DM * 2;
constexpr size_t WS_WDN = WS_WUP + (size_t)DEPTH * FF2 * DM * 2;
constexpr size_t WS_MOD = WS_WDN + (size_t)DEPTH * DM * FFN * 2;
constexpr size_t WS_ROPE = WS_MOD + (size_t)DEPTH * 9 * MODW * 4;
constexpr size_t WS_XC = WS_ROPE + (size_t)SEQ * 32 * 4;
constexpr size_t WS_H = WS_XC + (size_t)TC * DM * 4;
constexpr size_t WS_BIG = WS_H + (size_t)TT * DM * 2;
constexpr size_t WS_U = WS_BIG;
constexpr size_t WS_VT = WS_U + (size_t)TT * INP * 2;
constexpr size_t WS_VTG = WS_VT + (size_t)48 * 64 * VTW * 2;
constexpr size_t WS_SL = WS_VTG + (size_t)48 * 64 * VTW * 2;
constexpr size_t WS_DEC = WS_SL + (size_t)96 * NCH * 2048 * 4;
constexpr size_t WS_OG = WS_DEC + (size_t)96 * NCH * 32 * 4;
constexpr size_t WS_END1 = WS_OG + (size_t)TT * 384 * 4;
constexpr size_t WS_FU = WS_BIG;
constexpr size_t WS_ACT = WS_FU + (size_t)34816 * FF2 * 2;
constexpr size_t WS_END2 = WS_ACT + (size_t)34816 * FFN * 2;
constexpr size_t WS_CTL = ((WS_END1 > WS_END2 ? WS_END1 : WS_END2) + 4095) / 4096 * 4096;
constexpr size_t WS_GSV = WS_CTL + 16384;
constexpr size_t WS_BIAS = WS_GSV + (size_t)DEPTH * 2 * 9 * DM * 4;
constexpr size_t WS_STAT = WS_BIAS + (size_t)DEPTH * 2 * 9 * FF2 * 4;
constexpr size_t WS_NEED = WS_STAT + (size_t)2 * TT * 16 * 4 + 4096;
constexpr size_t WS_H2 = (WS_END2 + 4095) / 4096 * 4096;
static_assert(WS_H2 + (size_t)TT * DM * 2 <= WS_CTL, "H2 overlay must end before the control words");
constexpr int LDS_BYTES = 131072;
#define GSYNC_CG() do { asm volatile("s_waitcnt vmcnt(0)" ::: "memory"); grid.sync(); } while (0)
#define XB_TMO      128
#define XB_XCNT(j)  (256  + 64 * (j))
#define XB_XSUB(j)  (1280 + 64 * (j))
#define XB_XGEN(j)  (2304 + 64 * (j))
#define XB_TOP      3328
#define XB_TOPGEN   3392
#define XCD_BAR_WORDS 3456
#define XB_SPIN_CAP (1u << 18)
__device__ __forceinline__ unsigned xb_ld(unsigned* p)              { return __hip_atomic_load(p, __ATOMIC_RELAXED, __HIP_MEMORY_SCOPE_AGENT); }
__device__ __forceinline__ unsigned xb_add(unsigned* p, unsigned v) { return __hip_atomic_fetch_add(p, v, __ATOMIC_RELAXED, __HIP_MEMORY_SCOPE_AGENT); }
__device__ __forceinline__ unsigned xb_xcc_id() { return (unsigned)__builtin_amdgcn_s_getreg((3 << 11) | 20) & 0xFu; }
#define XB_SPIN(cond, bar) do { unsigned _sp = 0; while (cond) { __builtin_amdgcn_s_sleep(1); \
    if ((++_sp & 255u) == 0u) { if (xb_ld(&(bar)[XB_TMO])) break; if (_sp > XB_SPIN_CAP) { atomicAdd(&(bar)[XB_TMO], 1u); break; } } } } while (0)
struct XcdBarrier { unsigned* bar; unsigned x; volatile LAS unsigned* st; };
__device__ __forceinline__ XcdBarrier xcd_barrier_post(unsigned* bar, volatile LAS unsigned* st) {
    XcdBarrier b; b.bar = bar; b.x = xb_xcc_id(); b.st = st;
    if (threadIdx.x == 0) (void)xb_add(&bar[XB_XCNT(b.x)], 1u);
    return b;
}
__device__ __forceinline__ void xcd_barrier_complete(unsigned* bar, unsigned x, unsigned& nloc, unsigned& nx) {
    const unsigned G = gridDim.x * gridDim.y * gridDim.z;
    unsigned sum, cnt, mine, sp = 0u;
    for (;;) {
        sum = 0u; cnt = 0u; mine = 0u;
#pragma unroll
        for (unsigned j = 0; j < 16; ++j) { const unsigned c = xb_ld(&bar[XB_XCNT(j)]); sum += c; cnt += (c > 0u) ? 1u : 0u; mine = (j == x) ? c : mine; }
        if (sum == G) break;
        __builtin_amdgcn_s_sleep(1);
        if ((++sp & 255u) == 0u) { if (xb_ld(&bar[XB_TMO])) break; if (sp > XB_SPIN_CAP) { atomicAdd(&bar[XB_TMO], 1u); break; } }
    }
    nloc = mine > 0u ? mine : 1u; nx = cnt > 0u ? cnt : 1u;
}
__device__ __forceinline__ void xcd_barrier(const XcdBarrier& b) {
    asm volatile("s_waitcnt vmcnt(0)" ::: "memory");
    __syncthreads();
    if (threadIdx.x == 0) {
        unsigned* bar = b.bar;
        __builtin_amdgcn_s_waitcnt(0);
        unsigned nloc = b.st[0], nx = b.st[1];
        if (nloc == 0u) { xcd_barrier_complete(bar, b.x, nloc, nx); b.st[0] = nloc; b.st[1] = nx; }
        const unsigned old = xb_add(&bar[XB_XSUB(b.x)], 1u);
        const unsigned gen = old / nloc;
        if (old + 1u == (gen + 1u) * nloc) {
            __builtin_amdgcn_fence(__ATOMIC_RELEASE, "agent");
            asm volatile("s_waitcnt vmcnt(0)" ::: "memory");
            const unsigned og = xb_add(&bar[XB_TOP], 1u);
            const unsigned tg = og / nx;
            if (og + 1u == (tg + 1u) * nx) xb_add(&bar[XB_TOPGEN], 1u);
            else XB_SPIN(xb_ld(&bar[XB_TOPGEN]) == tg, bar);
            __builtin_amdgcn_fence(__ATOMIC_ACQUIRE, "agent");
            xb_add(&bar[XB_XGEN(b.x)], 1u);
            asm volatile("s_waitcnt vmcnt(0)" ::: "memory");
        } else {
            XB_SPIN(xb_ld(&bar[XB_XGEN(b.x)]) == gen, bar);
            __builtin_amdgcn_fence(__ATOMIC_ACQUIRE, "agent");
            asm volatile("s_waitcnt vmcnt(0)" ::: "memory");
        }
    }
    __syncthreads();
}
#define GSYNC() xcd_barrier(xb)
#ifndef REP_GLA
#define REP_GLA 1
#endif
#ifndef REP_NA
#define REP_NA 1
#endif
#ifndef REP_CG
#define REP_CG 1
#endif
#ifndef REP_GEMM
#define REP_GEMM 1
#endif
#ifndef REP_NORM
#define REP_NORM 1
#endif
#ifndef REP_VT
#define REP_VT 1
#endif

struct Params {
    const float* in[23];
    float* out;
    unsigned char* ws;
};


typedef const Params __attribute__((address_space(4)))* ParamsK;
__device__ __forceinline__ ParamsK getpk() { ParamsK q = (ParamsK)__builtin_amdgcn_kernarg_segment_ptr(); asm volatile("" : "+s"(q)); return q; }
template <class T> __device__ __forceinline__ T* asglobal(T* q) {
#if defined(__HIP_DEVICE_COMPILE__)
    __builtin_assume(!__builtin_amdgcn_is_shared((const void*)q)); __builtin_assume(!__builtin_amdgcn_is_private((const void*)q));
#endif
    return q; }
#define IN(i) asglobal(p->in[i])
#define WSP asglobal(p->ws)
#define OUTP asglobal(p->out)
__device__ __forceinline__ float bf2f(bf16_t v) { return __uint_as_float(((unsigned)v) << 16); }
__device__ __forceinline__ float bflo(unsigned w) { return __uint_as_float(w << 16); }
__device__ __forceinline__ float bfhi(unsigned w) { return __uint_as_float(w & 0xffff0000u); }
__device__ __forceinline__ unsigned pk2(float lo, float hi) { return pg8::cvt_pk_bf16(lo, hi); }
__device__ __forceinline__ float wave_sum(float v) {
#pragma unroll
    for (int o = 1; o < 64; o <<= 1) v += __shfl_xor(v, o);
    return v;
}
__device__ __forceinline__ float silu_f(float v) { return v * __builtin_amdgcn_rcpf(1.f + __expf(-v)); }
#define LDS_WAIT() asm volatile("s_waitcnt lgkmcnt(0)" ::: "memory")

struct EpiStore {
    static constexpr bool PERM = true, AFTER_DRAIN = false;
    bf16_t* O; int ldc;
    __device__ __forceinline__ void operator()(const f32x4 (&acc)[2][2][4][2], const pg8::Unit& u, int wr, int wc, int fr, int fq) const {
        const int row0 = u.pm * 256 + wr * 64 + fr, col0 = u.pn * 256 + wc * 32 + 8 * fq;
#pragma unroll
        for (int ai = 0; ai < 2; ++ai)
#pragma unroll
            for (int m = 0; m < 4; ++m) { bf16_t* rowp = O + (size_t)(row0 + ai * 128 + m * 16) * ldc + col0;
#pragma unroll
                for (int bj = 0; bj < 2; ++bj) { const f32x4 v0 = acc[ai][bj][m][0], v1 = acc[ai][bj][m][1];
                    u32x4 w; w.x = pk2(v0[0], v0[1]); w.y = pk2(v0[2], v0[3]); w.z = pk2(v1[0], v1[1]); w.w = pk2(v1[2], v1[3]);
                    *(u32x4*)(rowp + bj * 128) = w; } }
    }
};
struct EpiResid {
    static constexpr bool PERM = true, AFTER_DRAIN = false;
    const float* rin_l; const float* rin_c; float* rout_l; float* rout_c; const float* gate; int rowbase;
    __device__ __forceinline__ void operator()(const f32x4 (&acc)[2][2][4][2], const pg8::Unit& u, int wr, int wc, int fr, int fq) const {
#pragma unroll
        for (int ai = 0; ai < 2; ++ai)
#pragma unroll
            for (int m = 0; m < 4; ++m) {
                const int R = rowbase + u.pm * 256 + ai * 128 + wr * 64 + m * 16 + fr;
                const bool islat = R < TL; const int mrow = islat ? (R >> 13) : 8;
                const float* src = islat ? rin_l + (size_t)R * DM : rin_c + (size_t)(R - TL) * DM;
                float* dst = islat ? rout_l + (size_t)R * DM : rout_c + (size_t)(R - TL) * DM;
                const float* gp = gate + (size_t)mrow * MODW;
#pragma unroll
                for (int bj = 0; bj < 2; ++bj)
#pragma unroll
                    for (int n = 0; n < 2; ++n) { const int c = u.pn * 256 + bj * 128 + wc * 32 + 8 * fq + 4 * n;
                        const f32x4 g4 = *(const f32x4*)(gp + c), x4 = *(const f32x4*)(src + c);
                        *(f32x4*)(dst + c) = x4 + g4 * acc[ai][bj][m][n]; } }
    }
};

struct EpiStoreN {
    static constexpr bool PERM = true, AFTER_DRAIN = false;
    bf16_t* O; int ldc; const float* stat; const float* bias; int rowbase;
    __device__ __forceinline__ void operator()(const f32x4 (&acc)[2][2][4][2], const pg8::Unit& u, int wr, int wc, int fr, int fq) const {
        const int row0 = u.pm * 256 + wr * 64 + fr, col0 = u.pn * 256 + wc * 32 + 8 * fq;
        const int Rt = rowbase + u.pm * 256;
        const float* bp = bias + (size_t)(Rt < TL ? (Rt >> 13) : 8) * FF2 + col0;
        f32x4 bv[2][2];
#pragma unroll
        for (int bj = 0; bj < 2; ++bj) { bv[bj][0] = *(const f32x4*)(bp + bj * 128); bv[bj][1] = *(const f32x4*)(bp + bj * 128 + 4); }
#pragma unroll
        for (int ai = 0; ai < 2; ++ai)
#pragma unroll
            for (int m = 0; m < 4; ++m) { const int r = row0 + ai * 128 + m * 16, Rg = rowbase + r;
                const f32x4 q = *(const f32x4*)(stat + (size_t)Rg * 16 + fq * 4);
                float ssq = (q[0] + q[1]) + (q[2] + q[3]); ssq += __shfl_xor(ssq, 16); ssq += __shfl_xor(ssq, 32);
                const float rstd = rsqrtf(ssq * (1.f / DM) + 1e-6f);
                bf16_t* rowp = O + (size_t)r * ldc + col0;
#pragma unroll
                for (int bj = 0; bj < 2; ++bj) { const f32x4 v0 = acc[ai][bj][m][0] * rstd + bv[bj][0], v1 = acc[ai][bj][m][1] * rstd + bv[bj][1];
                    u32x4 w; w.x = pk2(v0[0], v0[1]); w.y = pk2(v0[2], v0[3]); w.z = pk2(v1[0], v1[1]); w.w = pk2(v1[2], v1[3]);
                    *(u32x4*)(rowp + bj * 128) = w; } }
    }
};
struct EpiResidN {
    static constexpr bool PERM = true, AFTER_DRAIN = false;
    const float* rin_l; const float* rin_c; float* rout_l; float* rout_c; const float* gate; int rowbase;
    bf16_t* Hn; const float* gs; float* stat;
    __device__ __forceinline__ void operator()(const f32x4 (&acc)[2][2][4][2], const pg8::Unit& u, int wr, int wc, int fr, int fq) const {
        const int Rt = rowbase + u.pm * 256; const bool islat = Rt < TL; const int mrow = islat ? (Rt >> 13) : 8;
        const float* gp = gate + (size_t)mrow * MODW; const float* gsp = gs + (size_t)mrow * DM;
        f32x4 gv[2][2], sv[2][2];
#pragma unroll
        for (int bj = 0; bj < 2; ++bj) { const int c = u.pn * 256 + bj * 128 + wc * 32 + 8 * fq;
            gv[bj][0] = *(const f32x4*)(gp + c); gv[bj][1] = *(const f32x4*)(gp + c + 4); sv[bj][0] = *(const f32x4*)(gsp + c); sv[bj][1] = *(const f32x4*)(gsp + c + 4); }
#pragma unroll
        for (int ai = 0; ai < 2; ++ai)
#pragma unroll
            for (int m = 0; m < 4; ++m) {
                const int R = rowbase + u.pm * 256 + ai * 128 + wr * 64 + m * 16 + fr;
                const float* src = islat ? rin_l + (size_t)R * DM : rin_c + (size_t)(R - TL) * DM;
                float* dst = islat ? rout_l + (size_t)R * DM : rout_c + (size_t)(R - TL) * DM;
                float ss = 0.f;
#pragma unroll
                for (int bj = 0; bj < 2; ++bj) { const int c = u.pn * 256 + bj * 128 + wc * 32 + 8 * fq;
                    const f32x4 xa = *(const f32x4*)(src + c) + gv[bj][0] * acc[ai][bj][m][0];
                    const f32x4 xb = *(const f32x4*)(src + c + 4) + gv[bj][1] * acc[ai][bj][m][1];
                    *(f32x4*)(dst + c) = xa; *(f32x4*)(dst + c + 4) = xb;
                    ss += (xa[0] * xa[0] + xa[1] * xa[1]) + (xa[2] * xa[2] + xa[3] * xa[3]) + (xb[0] * xb[0] + xb[1] * xb[1]) + (xb[2] * xb[2] + xb[3] * xb[3]);
                    const f32x4 ya = xa * sv[bj][0], yb = xb * sv[bj][1];
                    u32x4 w; w.x = pk2(ya[0], ya[1]); w.y = pk2(ya[2], ya[3]); w.z = pk2(yb[0], yb[1]); w.w = pk2(yb[2], yb[3]);
                    *(u32x4*)(Hn + (size_t)R * DM + c) = w; }
                ss += __shfl_xor(ss, 16); ss += __shfl_xor(ss, 32);
                if (fq == 0) stat[(size_t)R * 16 + u.pn * 4 + wc] = ss;
            }
    }
};

__device__ __forceinline__ const void* uni_ptr(const void* q) { const unsigned long long a = (unsigned long long)q; const unsigned lo = __builtin_amdgcn_readfirstlane((unsigned)a), hi = __builtin_amdgcn_readfirstlane((unsigned)(a >> 32)); return (const void*)(((unsigned long long)hi << 32) | lo); }
template <class Epi>
__device__ __forceinline__ void run_gemm(unsigned char* smem, const bf16_t* A, const bf16_t* Bt, int M, int N, int K, const Epi& E, int crot = 0) {
    pg8::Gemm g; g.A = (const bf16_t*)uni_ptr(A); g.Bt = (const bf16_t*)uni_ptr(Bt); g.M = M; g.N = N; g.K = K;
    pg8::StaticOrder S; S.init(M, N, (int)gridDim.x, (int)((blockIdx.x + crot) % gridDim.x));
    pg8::gemm_phase<Epi, pg8::StaticOrder, true, true>((PG8_LAS unsigned char*)smem, g, S, E);
    __syncthreads();
}

__device__ __forceinline__ void ada_phase(ParamsK p, unsigned char* smem) {
    float* sc = (float*)smem;
    float* red = sc + 9 * 1024;
    const int tid = otid();
    const float* cvec = IN(1); const float* cctx = IN(3); const float* w_ada = IN(4); const float* b_ada = IN(5);
    float* mod = (float*)(WSP + WS_MOD);
    for (int i = tid; i < 9 * 1024; i += 512) { const int r = i >> 10, k = i & 1023; const float v = r < 8 ? cvec[r * 1024 + k] : cctx[k]; sc[i] = v / (1.f + expf(-v)); }
    __syncthreads();
    for (int task = blockIdx.x; task < DEPTH * 96; task += gridDim.x) {
        const int l = task / 96, cb = (task % 96) * 64, cl = tid & 63, ks = tid >> 6;
        const float* w = w_ada + (size_t)l * DM * MODW + cb + cl;
        float acc[9];
#pragma unroll
        for (int r = 0; r < 9; ++r) acc[r] = 0.f;
#pragma unroll 16
        for (int kk = 0; kk < 128; ++kk) { const int k = ks * 128 + kk; const float wv = w[(size_t)k * MODW];
#pragma unroll
            for (int r = 0; r < 9; ++r) acc[r] += sc[r * 1024 + k] * wv; }
#pragma unroll
        for (int r = 0; r < 9; ++r) red[(ks * 9 + r) * 64 + cl] = acc[r];
        __syncthreads();
        for (int o = tid; o < 576; o += 512) { const int r = o >> 6, cc = o & 63; float s = 0.f;
#pragma unroll
            for (int k8 = 0; k8 < 8; ++k8) s += red[(k8 * 9 + r) * 64 + cc];
            mod[(size_t)(l * 9 + r) * MODW + cb + cc] = s + b_ada[l * MODW + cb + cc]; }
        __syncthreads();
    }
}
__device__ __forceinline__ void transpose_item(const float* W, int K, int N, bf16_t* WT, float* scr, int item, int lane) {
    const int nblk = N / 32, kb = item / nblk, nb = item % nblk, k0 = 64 * kb, n0 = 32 * nb;
    float tv[32];
#pragma unroll
    for (int i = 0; i < 32; ++i) { const int kk = 2 * i + (lane >> 5); tv[i] = W[(size_t)(k0 + kk) * N + n0 + (lane & 31)]; }
#pragma unroll
    for (int i = 0; i < 32; ++i) { const int kk = 2 * i + (lane >> 5); scr[kk * 33 + (lane & 31)] = tv[i]; }
    LDS_WAIT();
    const int c = lane & 7;
#pragma unroll
    for (int j = 0; j < 4; ++j) { const int n = (lane >> 3) + 8 * j; const float* s = scr + (8 * c) * 33 + n;
        u32x4 o; o.x = pk2(s[0 * 33], s[1 * 33]); o.y = pk2(s[2 * 33], s[3 * 33]); o.z = pk2(s[4 * 33], s[5 * 33]); o.w = pk2(s[6 * 33], s[7 * 33]);
        *(u32x4*)(WT + (size_t)(n0 + n) * K + k0 + 8 * c) = o; }
    LDS_WAIT();
}
__device__ __forceinline__ void weights_phase(ParamsK p, unsigned char* smem) {
    const int tid = otid(), lane = tid & 63, wave = __builtin_amdgcn_readfirstlane(tid >> 6);
    float* scr = (float*)(smem + wave * 16384);
    const int gw = blockIdx.x * 8 + wave, NGW = gridDim.x * 8;
    constexpr int I_IN = 16 * (INW / 32), I_OUT = 16 * 32, I_UP = 16 * (FF2 / 32), I_DN = (FFN / 64) * 32, I_L = I_IN + I_OUT + I_UP + I_DN;
    for (int it = gw; it < DEPTH * I_L; it += NGW) {
        const int l = it / I_L; int r = it % I_L;
        if (r < I_IN) { transpose_item(IN(8) + (size_t)l * DM * INW, DM, INW, (bf16_t*)(WSP + WS_WIN) + (size_t)l * INP * DM, scr, r, lane); continue; } r -= I_IN;
        if (r < I_OUT) { transpose_item(IN(17) + (size_t)l * DM * DM, DM, DM, (bf16_t*)(WSP + WS_WOUT) + (size_t)l * DM * DM, scr, r, lane); continue; } r -= I_OUT;
        if (r < I_UP) { transpose_item(IN(18) + (size_t)l * DM * FF2, DM, FF2, (bf16_t*)(WSP + WS_WUP) + (size_t)l * FF2 * DM, scr, r, lane); continue; } r -= I_UP;
        transpose_item(IN(21) + (size_t)l * FFN * DM, FFN, DM, (bf16_t*)(WSP + WS_WDN) + (size_t)l * DM * FFN, scr, r, lane);
    }
    const int gt = blockIdx.x * 512 + tid, NGT = gridDim.x * 512;
    constexpr int PADV = (INP - INW) * DM / 8;
    for (int i = gt; i < DEPTH * PADV; i += NGT) { const int l = i / PADV, r = i % PADV;
        *(u32x4*)((bf16_t*)(WSP + WS_WIN) + (size_t)l * INP * DM + (size_t)INW * DM + (size_t)r * 8) = (u32x4){0u, 0u, 0u, 0u}; }
    float* rope = (float*)(WSP + WS_ROPE);
    for (int i = gt; i < SEQ * 16; i += NGT) { const int tok = i >> 4, j = i & 15, f = j & 7;
        const float invf = f == 0 ? 1.0f : f == 1 ? 0.31622776601683794f : f == 2 ? 0.1f : f == 3 ? 0.031622776601683794f : f == 4 ? 0.01f : f == 5 ? 0.0031622776601683794f : f == 6 ? 0.001f : 0.00031622776601683794f;
        const float pos = (float)(j < 8 ? (tok >> 6) : (tok & 63)); const float ang = pos * invf;
        const double a = (double)ang; const double kq = rint(a * 0.15915494309189535); const float rr = (float)(a - kq * 6.283185307179586);
        rope[tok * 32 + j] = cosf(rr); rope[tok * 32 + 16 + j] = sinf(rr); }
}

__device__ __forceinline__ void norm_phase(const float* xl, const float* xc, const float* g, const float* shift, const float* scale, bf16_t* H, int nrows) {
    const int tid = otid(), lane = tid & 63, wave = __builtin_amdgcn_readfirstlane(tid >> 6);
    const int gw = blockIdx.x * 8 + wave, NGW = gridDim.x * 8;
    for (int row0 = gw; row0 < nrows; row0 += 2 * NGW) {
        const int row1 = row0 + NGW; const bool has1 = row1 < nrows; const int rowb = has1 ? row1 : row0;
        const float* srcA = row0 < TL ? xl + (size_t)row0 * DM : xc + (size_t)(row0 - TL) * DM;
        const float* srcB = rowb < TL ? xl + (size_t)rowb * DM : xc + (size_t)(rowb - TL) * DM;
        f32x4 va[4], vb[4]; float sa = 0.f, sb = 0.f;
#pragma unroll
        for (int j = 0; j < 4; ++j) { va[j] = *(const f32x4*)(srcA + lane * 4 + 256 * j); vb[j] = *(const f32x4*)(srcB + lane * 4 + 256 * j); }
#pragma unroll
        for (int j = 0; j < 4; ++j) { sa += (va[j][0] * va[j][0] + va[j][1] * va[j][1]) + (va[j][2] * va[j][2] + va[j][3] * va[j][3]);
            sb += (vb[j][0] * vb[j][0] + vb[j][1] * vb[j][1]) + (vb[j][2] * vb[j][2] + vb[j][3] * vb[j][3]); }
#pragma unroll
        for (int o = 1; o < 64; o <<= 1) { sa += __shfl_xor(sa, o); sb += __shfl_xor(sb, o); }
        const float rstdA = rsqrtf(sa * (1.f / DM) + 1e-6f), rstdB = rsqrtf(sb * (1.f / DM) + 1e-6f);
        const int mA = row0 < TL ? (row0 >> 13) : 8, mB = rowb < TL ? (rowb >> 13) : 8;
#pragma unroll
        for (int j = 0; j < 4; ++j) { const int c = lane * 4 + 256 * j;
            const f32x4 g4 = *(const f32x4*)(g + c);
            { const f32x4 s4 = *(const f32x4*)(scale + (size_t)mA * MODW + c), h4 = *(const f32x4*)(shift + (size_t)mA * MODW + c);
              const f32x4 y = (va[j] * rstdA * g4) * (s4 + 1.f) + h4;
              u32x2 w; w.x = pk2(y[0], y[1]); w.y = pk2(y[2], y[3]); *(u32x2*)(H + (size_t)row0 * DM + c) = w; }
            if (has1) { const f32x4 s4 = *(const f32x4*)(scale + (size_t)mB * MODW + c), h4 = *(const f32x4*)(shift + (size_t)mB * MODW + c);
              const f32x4 y = (vb[j] * rstdB * g4) * (s4 + 1.f) + h4;
              u32x2 w; w.x = pk2(y[0], y[1]); w.y = pk2(y[2], y[3]); *(u32x2*)(H + (size_t)row1 * DM + c) = w; }
        }
    }
}
__device__ __forceinline__ void final_norm_phase(float* x, const float* g) {
    const int tid = otid(), lane = tid & 63, wave = __builtin_amdgcn_readfirstlane(tid >> 6);
    const int gw = blockIdx.x * 8 + wave, NGW = gridDim.x * 8;
    for (int row = gw; row < TL; row += NGW) {
        float* src = x + (size_t)row * DM;
        f32x4 v[4]; float ss = 0.f;
#pragma unroll
        for (int j = 0; j < 4; ++j) { v[j] = *(const f32x4*)(src + lane * 4 + 256 * j); ss += (v[j][0] * v[j][0] + v[j][1] * v[j][1]) + (v[j][2] * v[j][2] + v[j][3] * v[j][3]); }
        const float rstd = rsqrtf(wave_sum(ss) * (1.f / DM) + 1e-6f);
#pragma unroll
        for (int j = 0; j < 4; ++j) { const int c = lane * 4 + 256 * j; const f32x4 g4 = *(const f32x4*)(g + c); *(f32x4*)(src + c) = v[j] * rstd * g4; }
    }
}

typedef short bf16x4 __attribute__((ext_vector_type(4)));
constexpr int GS = 36;
__device__ __forceinline__ bf16x4 as_bf16x4(u32x2 w) { union { u32x2 u; bf16x4 b; } c; c.u = w; return c.b; }
__device__ __forceinline__ bf16x8 as_bf16x8(u32x4 w) { union { u32x4 u; bf16x8 b; } c; c.u = w; return c.b; }
__device__ __forceinline__ void unpack8(const u32x4 w, float (&f)[8]) {
#pragma unroll
    for (int i = 0; i < 4; ++i) { f[2 * i] = bflo(w[i]); f[2 * i + 1] = bfhi(w[i]); }
}
struct GlaRaw { u32x4 kraw, qraw; f32x4 cs, sn; u32x2 graw; };
template <bool NEEDQ>
__device__ __forceinline__ void gla_stage_load(const bf16_t* U, const float* rope, int row0, int tpos0, int h, int dir, int lane, GlaRaw& R) {
    const int tok = lane >> 2, qr = lane & 3;
    const bf16_t* ur = U + (size_t)(row0 + tok) * INP + h * 32 + qr * 8;
    R.kraw = *(const u32x4*)(ur + K0);
    if (NEEDQ) R.qraw = *(const u32x4*)(ur + Q0);
    if (tpos0 >= 0) { const float* rp = rope + (size_t)(tpos0 + tok) * 32 + qr * 4; R.cs = *(const f32x4*)rp; R.sn = *(const f32x4*)(rp + 16); }
    R.graw = *(const u32x2*)(U + (size_t)(row0 + tok) * INP + (dir ? GB0 : GF0) + qr * 4);
}
template <bool NEEDQ>
__device__ __forceinline__ void gla_stage16(const GlaRaw& R, float* qs, float* ks, float* Bs, float* Be, int tpos0, int dir, const float (&wg)[16], float bgk, int lane) {
    {
        const int tok = lane >> 2, qr = lane & 3;
        float kk[8], qq[8];
        unpack8(R.kraw, kk);
        if (NEEDQ) { unpack8(R.qraw, qq);
#pragma unroll
            for (int i = 0; i < 8; ++i) qq[i] *= 0.17677669529663687f; }
        if (tpos0 >= 0) { const f32x4 cs = R.cs, sn = R.sn;
#pragma unroll
            for (int i = 0; i < 4; ++i) { const float a = kk[2 * i] * cs[i] - kk[2 * i + 1] * sn[i], b2 = kk[2 * i] * sn[i] + kk[2 * i + 1] * cs[i]; kk[2 * i] = a; kk[2 * i + 1] = b2;
                if (NEEDQ) { const float c2 = qq[2 * i] * cs[i] - qq[2 * i + 1] * sn[i], d2 = qq[2 * i] * sn[i] + qq[2 * i + 1] * cs[i]; qq[2 * i] = c2; qq[2 * i + 1] = d2; } } }
        *(f32x4*)(ks + tok * GS + qr * 8) = (f32x4){kk[0], kk[1], kk[2], kk[3]}; *(f32x4*)(ks + tok * GS + qr * 8 + 4) = (f32x4){kk[4], kk[5], kk[6], kk[7]};
        if (NEEDQ) { *(f32x4*)(qs + tok * GS + qr * 8) = (f32x4){qq[0], qq[1], qq[2], qq[3]}; *(f32x4*)(qs + tok * GS + qr * 8 + 4) = (f32x4){qq[4], qq[5], qq[6], qq[7]}; }
    }
    bf16_t* Gs = (bf16_t*)(Be + 64);
    *(u32x2*)(Gs + lane * 4) = R.graw;
    LDS_WAIT();
    {
        const int k = lane & 31, hf = lane >> 5;
        float g[8];
#pragma unroll
        for (int i = 0; i < 8; ++i) {
            const u32x4 ga = *(const u32x4*)(Gs + (hf * 8 + i) * 16), gb = *(const u32x4*)(Gs + (hf * 8 + i) * 16 + 8);
            float x = bgk;
#pragma unroll
            for (int j = 0; j < 4; ++j) { x += bflo(ga[j]) * wg[2 * j] + bfhi(ga[j]) * wg[2 * j + 1]; }
#pragma unroll
            for (int j = 0; j < 4; ++j) { x += bflo(gb[j]) * wg[8 + 2 * j] + bfhi(gb[j]) * wg[8 + 2 * j + 1]; }
            g[i] = (fminf(x, 0.f) - __logf(1.f + __expf(-fabsf(x)))) * 0.0625f;
        }
        if (dir == 0) {
#pragma unroll
            for (int i = 1; i < 8; ++i) g[i] += g[i - 1];
            const float other = __shfl_xor(g[7], 32);
            if (hf == 1) {
#pragma unroll
                for (int i = 0; i < 8; ++i) g[i] += other;
                Be[k] = g[7]; }
        } else {
#pragma unroll
            for (int i = 6; i >= 0; --i) g[i] += g[i + 1];
            const float other = __shfl_xor(g[0], 32);
            if (hf == 0) {
#pragma unroll
                for (int i = 0; i < 8; ++i) g[i] += other;
                Be[k] = g[0]; }
        }
#pragma unroll
        for (int i = 0; i < 8; ++i) Bs[(hf * 8 + i) * GS + k] = g[i];
    }
    LDS_WAIT();
}
__device__ __forceinline__ void gla_load_gatew(ParamsK p, int l, int h, int dir, int lane, float (&wg)[16], float& bgk) {
    const int k = lane & 31;
    const float* w = (dir ? IN(11) : IN(9)) + (size_t)l * 16 * 192 + h * 32 + k;
#pragma unroll
    for (int i = 0; i < 16; ++i) wg[i] = w[i * 192];
    bgk = ((dir ? IN(12) : IN(10)) + (size_t)l * 192 + h * 32)[k];
}
__device__ __forceinline__ void gla_task(int task, int& bh, int& b, int& h, int& tc, int& rowb, int& vtb, int& tpb) {
    tc = task % NCH; bh = task / NCH; h = bh % 6; b = bh / 6;
    if (tc < 4) { rowb = TL + b * CTXL + tc * 64; vtb = SEQ + tc * 64; tpb = -1; }
    else { rowb = b * SEQ + (tc - 4) * 64; vtb = (tc - 4) * 64; tpb = (tc - 4) * 64; }
}
__device__ __forceinline__ void gla_state_ops(const float* ks, const float* Bs, const float* Be, int fr, int fq, bf16x4 (&ke)[2], f32x4 (&dec)[2]) {
#pragma unroll
    for (int kb = 0; kb < 2; ++kb) { const int kidx = kb * 16 + fr; const float be = Be[kidx]; float e[4];
#pragma unroll
        for (int j = 0; j < 4; ++j) e[j] = ks[(fq * 4 + j) * GS + kidx] * __expf(be - Bs[(fq * 4 + j) * GS + kidx]);
        u32x2 w; w.x = pk2(e[0], e[1]); w.y = pk2(e[2], e[3]); ke[kb] = as_bf16x4(w);
        const f32x4 bv = *(const f32x4*)(Be + kb * 16 + fq * 4);
        dec[kb] = (f32x4){__expf(bv[0]), __expf(bv[1]), __expf(bv[2]), __expf(bv[3])}; }
}
__device__ __forceinline__ void gla_step1(ParamsK p, int l, unsigned char* smem) {
    const int tid = otid(), lane = tid & 63, wave = __builtin_amdgcn_readfirstlane(tid >> 6), fr = lane & 15, fq = lane >> 4;
    float* qs = (float*)(smem + wave * 16384); float* ks = qs + 16 * GS; float* Bs = ks + 16 * GS; float* Be = Bs + 16 * GS;
    const bf16_t* U = (const bf16_t*)(WSP + WS_U); const float* rope = (const float*)(WSP + WS_ROPE); const bf16_t* VTG = (const bf16_t*)(WSP + WS_VTG);
    float* SL = (float*)(WSP + WS_SL); float* DEC = (float*)(WSP + WS_DEC);
    const int gw = wave * gridDim.x + blockIdx.x, NGW = gridDim.x * 8;
    for (int task = gw; task < 48 * NCH; task += NGW) {
        int bh, b, h, tc, rowb, vtb, tpb; gla_task(task, bh, b, h, tc, rowb, vtb, tpb);
        for (int dir = 0; dir < 2; ++dir) {
            const int c = dir == 0 ? tc : (tc < 4 ? 3 - tc : 135 - tc);
            float wg[16], bgk; gla_load_gatew(p, l, h, dir, lane, wg, bgk);
            f32x4 S[2][4];
#pragma unroll
            for (int kb = 0; kb < 2; ++kb)
#pragma unroll
                for (int db = 0; db < 4; ++db) S[kb][db] = (f32x4){0.f, 0.f, 0.f, 0.f};
            float bsum = 0.f;
            GlaRaw raw; { const int sc0 = dir ? 3 : 0; gla_stage_load<false>(U, rope, rowb + sc0 * 16, tpb < 0 ? -1 : tpb + sc0 * 16, h, dir, lane, raw); }
            for (int si = 0; si < 4; ++si) {
                const int sc = dir ? 3 - si : si;
                bf16x4 vt[4];
#pragma unroll
                for (int db = 0; db < 4; ++db) vt[db] = as_bf16x4(*(const u32x2*)(VTG + (size_t)(bh * 64 + db * 16 + fr) * VTW + vtb + sc * 16 + fq * 4));
                gla_stage16<false>(raw, qs, ks, Bs, Be, tpb, dir, wg, bgk, lane);
                if (si < 3) { const int scn = dir ? 2 - si : si + 1; gla_stage_load<false>(U, rope, rowb + scn * 16, tpb < 0 ? -1 : tpb + scn * 16, h, dir, lane, raw); }
                bf16x4 ke[2]; f32x4 dec[2]; gla_state_ops(ks, Bs, Be, fr, fq, ke, dec);
                bsum += Be[lane & 31];
#pragma unroll
                for (int kb = 0; kb < 2; ++kb)
#pragma unroll
                    for (int db = 0; db < 4; ++db) S[kb][db] = __builtin_amdgcn_mfma_f32_16x16x16bf16_1k(ke[kb], vt[db], S[kb][db] * dec[kb], 0, 0, 0);
                LDS_WAIT();
            }
            float* so = SL + ((size_t)(bh * 2 + dir) * NCH + c) * 2048;
#pragma unroll
            for (int kb = 0; kb < 2; ++kb)
#pragma unroll
                for (int db = 0; db < 4; ++db)
#pragma unroll
                    for (int j = 0; j < 4; ++j) so[(kb * 16 + fq * 4 + j) * 64 + db * 16 + fr] = S[kb][db][j];
            if (lane < 32) DEC[((size_t)(bh * 2 + dir) * NCH + c) * 32 + lane] = __expf(bsum);
        }
    }
}
__device__ __forceinline__ void gla_step2(ParamsK p) {
    float* SL = (float*)(WSP + WS_SL); const float* DEC = (const float*)(WSP + WS_DEC);
    const int gt = blockIdx.x * 512 + otid(), NGT = gridDim.x * 512;
    for (int e = gt; e < 96 * 2048; e += NGT) {
        const int bhd = e >> 11, kd = e & 2047, k = kd >> 6;
        float* sp = SL + (size_t)bhd * NCH * 2048 + kd; const float* dp = DEC + (size_t)bhd * NCH * 32 + k;
        float s = 0.f;
        for (int c0 = 0; c0 < NCH; c0 += 12) {
            float loc[12], dd[12];
#pragma unroll
            for (int j = 0; j < 12; ++j) { loc[j] = sp[(size_t)(c0 + j) * 2048]; dd[j] = dp[(c0 + j) * 32]; }
#pragma unroll
            for (int j = 0; j < 12; ++j) { sp[(size_t)(c0 + j) * 2048] = s; s = dd[j] * s + loc[j]; }
        }
    }
}
__device__ __forceinline__ void gla_step3(ParamsK p, int l, unsigned char* smem) {
    const int tid = otid(), lane = tid & 63, wave = __builtin_amdgcn_readfirstlane(tid >> 6), fr = lane & 15, fq = lane >> 4;
    float* qs = (float*)(smem + wave * 16384); float* ks = qs + 16 * GS; float* Bs = ks + 16 * GS; float* Be = Bs + 16 * GS;
    const bf16_t* U = (const bf16_t*)(WSP + WS_U); const float* rope = (const float*)(WSP + WS_ROPE); const bf16_t* VTG = (const bf16_t*)(WSP + WS_VTG);
    const float* SL = (const float*)(WSP + WS_SL); float* OG = (float*)(WSP + WS_OG);
    bf16_t* MIX = (bf16_t*)(WSP + WS_H);
    const float* ngp = IN(13) + l * 64;
    const int gw = wave * gridDim.x + blockIdx.x, NGW = gridDim.x * 8;
    for (int task = gw; task < 48 * NCH; task += NGW) {
        int bh, b, h, tc, rowb, vtb, tpb; gla_task(task, bh, b, h, tc, rowb, vtb, tpb);
        for (int dir = 0; dir < 2; ++dir) {
            const int c = dir == 0 ? tc : (tc < 4 ? 3 - tc : 135 - tc);
            float wg[16], bgk; gla_load_gatew(p, l, h, dir, lane, wg, bgk);
            f32x4 S[2][4];
            const float* si_ = SL + ((size_t)(bh * 2 + dir) * NCH + c) * 2048;
#pragma unroll
            for (int kb = 0; kb < 2; ++kb)
#pragma unroll
                for (int db = 0; db < 4; ++db)
#pragma unroll
                    for (int j = 0; j < 4; ++j) S[kb][db][j] = si_[(kb * 16 + fq * 4 + j) * 64 + db * 16 + fr];
            GlaRaw raw; { const int sc0 = dir ? 3 : 0; gla_stage_load<true>(U, rope, rowb + sc0 * 16, tpb < 0 ? -1 : tpb + sc0 * 16, h, dir, lane, raw); }
            for (int si = 0; si < 4; ++si) {
                const int sc = dir ? 3 - si : si;
                const int row = rowb + sc * 16 + fr;
                bf16x4 vt[4];
#pragma unroll
                for (int db = 0; db < 4; ++db) vt[db] = as_bf16x4(*(const u32x2*)(VTG + (size_t)(bh * 64 + db * 16 + fr) * VTW + vtb + sc * 16 + fq * 4));
                f32x4 og[4]; u32x2 rgw[4];
                if (dir == 1) {
#pragma unroll
                    for (int db = 0; db < 4; ++db) { og[db] = *(const f32x4*)(OG + (size_t)row * 384 + h * 64 + db * 16 + fq * 4);
                        rgw[db] = *(const u32x2*)(U + (size_t)row * INP + R0 + h * 64 + db * 16 + fq * 4); }
                }
                gla_stage16<true>(raw, qs, ks, Bs, Be, tpb, dir, wg, bgk, lane);
                if (si < 3) { const int scn = dir ? 2 - si : si + 1; gla_stage_load<true>(U, rope, rowb + scn * 16, tpb < 0 ? -1 : tpb + scn * 16, h, dir, lane, raw); }
                const f32x4 ba = *(const f32x4*)(Bs + fr * GS + fq * 4), bb = *(const f32x4*)(Bs + fr * GS + 16 + fq * 4);
                const f32x4 qa = *(const f32x4*)(qs + fr * GS + fq * 4), qb = *(const f32x4*)(qs + fr * GS + 16 + fq * 4);
                const f32x4 ka = *(const f32x4*)(ks + fr * GS + fq * 4), kc = *(const f32x4*)(ks + fr * GS + 16 + fq * 4);
                u32x4 qw, kw;
                qw.x = pk2(qa[0] * __expf(ba[0]), qa[1] * __expf(ba[1])); qw.y = pk2(qa[2] * __expf(ba[2]), qa[3] * __expf(ba[3]));
                qw.z = pk2(qb[0] * __expf(bb[0]), qb[1] * __expf(bb[1])); qw.w = pk2(qb[2] * __expf(bb[2]), qb[3] * __expf(bb[3]));
                kw.x = pk2(ka[0] * __expf(-ba[0]), ka[1] * __expf(-ba[1])); kw.y = pk2(ka[2] * __expf(-ba[2]), ka[3] * __expf(-ba[3]));
                kw.z = pk2(kc[0] * __expf(-bb[0]), kc[1] * __expf(-bb[1])); kw.w = pk2(kc[2] * __expf(-bb[2]), kc[3] * __expf(-bb[3]));
                const bf16x8 Qd = as_bf16x8(qw), Kd = as_bf16x8(kw);
                bf16x4 ke[2]; f32x4 dec[2]; gla_state_ops(ks, Bs, Be, fr, fq, ke, dec);
                f32x4 AT = __builtin_amdgcn_mfma_f32_16x16x32_bf16(Kd, Qd, (f32x4){0.f, 0.f, 0.f, 0.f}, 0, 0, 0);
#pragma unroll
                for (int j = 0; j < 4; ++j) { const int pp = fq * 4 + j; const bool keep = dir == 0 ? (pp <= fr) : (pp >= fr); AT[j] = keep ? AT[j] : 0.f; }
                u32x2 aw; aw.x = pk2(AT[0], AT[1]); aw.y = pk2(AT[2], AT[3]);
                const bf16x4 atb = as_bf16x4(aw);
                f32x4 O[4];
#pragma unroll
                for (int db = 0; db < 4; ++db) {
                    const f32x4 Oa = __builtin_amdgcn_mfma_f32_16x16x16bf16_1k(vt[db], atb, (f32x4){0.f, 0.f, 0.f, 0.f}, 0, 0, 0);
                    u32x4 sw; sw.x = pk2(S[0][db][0], S[0][db][1]); sw.y = pk2(S[0][db][2], S[0][db][3]); sw.z = pk2(S[1][db][0], S[1][db][1]); sw.w = pk2(S[1][db][2], S[1][db][3]);
                    const f32x4 Ob = __builtin_amdgcn_mfma_f32_16x16x32_bf16(as_bf16x8(sw), Qd, (f32x4){0.f, 0.f, 0.f, 0.f}, 0, 0, 0);
                    O[db] = Oa + Ob;
                }
#pragma unroll
                for (int kb = 0; kb < 2; ++kb)
#pragma unroll
                    for (int db = 0; db < 4; ++db) S[kb][db] = __builtin_amdgcn_mfma_f32_16x16x16bf16_1k(ke[kb], vt[db], S[kb][db] * dec[kb], 0, 0, 0);
                if (dir == 0) {
#pragma unroll
                    for (int db = 0; db < 4; ++db) *(f32x4*)(OG + (size_t)row * 384 + h * 64 + db * 16 + fq * 4) = O[db];
                } else {
                    float ss = 0.f;
#pragma unroll
                    for (int db = 0; db < 4; ++db) { O[db] = O[db] + og[db]; ss += (O[db][0] * O[db][0] + O[db][1] * O[db][1]) + (O[db][2] * O[db][2] + O[db][3] * O[db][3]); }
                    ss += __shfl_xor(ss, 16); ss += __shfl_xor(ss, 32);
                    const float rstd = rsqrtf(ss * (1.f / 64.f) + 1e-6f);
#pragma unroll
                    for (int db = 0; db < 4; ++db) { const f32x4 n4 = *(const f32x4*)(ngp + db * 16 + fq * 4);
                        const float r0 = bflo(rgw[db].x), r1 = bfhi(rgw[db].x), r2 = bflo(rgw[db].y), r3 = bfhi(rgw[db].y);
                        u32x2 w; w.x = pk2(O[db][0] * rstd * n4[0] * silu_f(r0), O[db][1] * rstd * n4[1] * silu_f(r1));
                        w.y = pk2(O[db][2] * rstd * n4[2] * silu_f(r2), O[db][3] * rstd * n4[3] * silu_f(r3));
                        *(u32x2*)(MIX + (size_t)row * DM + h * 64 + db * 16 + fq * 4) = w; }
                }
                LDS_WAIT();
            }
        }
    }
}

__device__ __forceinline__ void prep_phase(ParamsK p) {
    const float* mod = (const float*)(WSP + WS_MOD); float* GSV = (float*)(WSP + WS_GSV); float* BIAS = (float*)(WSP + WS_BIAS);
    const int gt = blockIdx.x * 512 + otid(), NGT = gridDim.x * 512;
    for (int i = gt; i < DEPTH * 2 * 9 * DM; i += NGT) { const int c = i & (DM - 1), r = (i >> 10) % 9, w = (i / (9 * DM)) & 1, l = i / (18 * DM);
        const float g = (w ? IN(7) : IN(6))[l * DM + c], sc = mod[(size_t)(l * 9 + r) * MODW + (w ? 4 : 1) * DM + c];
        GSV[i] = g * (1.f + sc); }
    constexpr int NCOL = INP + FF2;
    for (int t = gt; t < DEPTH * NCOL; t += NGT) { const int l = t / NCOL, cc = t % NCOL, w = cc >= INP, n = w ? cc - INP : cc;
        const bf16_t* wrow = w ? (const bf16_t*)(WSP + WS_WUP) + ((size_t)l * FF2 + n) * DM : (const bf16_t*)(WSP + WS_WIN) + ((size_t)l * INP + n) * DM;
        const float* sh = mod + (size_t)l * 9 * MODW + (w ? 3 : 0) * DM;
        float acc[9];
#pragma unroll
        for (int r = 0; r < 9; ++r) acc[r] = 0.f;
        for (int k = 0; k < DM; k += 8) { float wv[8]; unpack8(*(const u32x4*)(wrow + k), wv);
#pragma unroll
            for (int r = 0; r < 9; ++r) { const f32x4 s0 = *(const f32x4*)(sh + (size_t)r * MODW + k), s1 = *(const f32x4*)(sh + (size_t)r * MODW + k + 4);
                acc[r] += (s0[0] * wv[0] + s0[1] * wv[1]) + (s0[2] * wv[2] + s0[3] * wv[3]) + (s1[0] * wv[4] + s1[1] * wv[5]) + (s1[2] * wv[6] + s1[3] * wv[7]); } }
#pragma unroll
        for (int r = 0; r < 9; ++r) BIAS[((size_t)(l * 2 + w) * 9 + r) * FF2 + n] = acc[r]; }
}
__device__ __forceinline__ void stat_zero_phase(ParamsK p) {
    float* STAT = (float*)(WSP + WS_STAT);
    const int gt = blockIdx.x * 512 + otid(), NGT = gridDim.x * 512;
    for (int i = gt; i < 2 * TT; i += NGT) STAT[i] = 0.f;
}

__device__ __forceinline__ void shortconv_phase(ParamsK p, int l) {
    const bf16_t* U = (const bf16_t*)(WSP + WS_U); bf16_t* MIX = (bf16_t*)(WSP + WS_H);
    const float* cw = IN(14) + (size_t)l * 3 * 256; const float* cbias = IN(15) + (size_t)l * 256;
    const int gt = blockIdx.x * 512 + otid(), NGT = gridDim.x * 512;
    for (int task = gt; task < TT * 32; task += NGT) {
        const int R = task >> 5, c = (task & 31) * 8;
        int pos, L; if (R < TL) { pos = R & (SEQ - 1); L = SEQ; } else { pos = (R - TL) & (CTXL - 1); L = CTXL; }
        const bf16_t* ur = U + (size_t)R * INP;
        float bgt[8], cc[8], xx[8], acc[8];
        unpack8(*(const u32x4*)(ur + SB0 + c), bgt);
        unpack8(*(const u32x4*)(ur + SC0 + c), cc); unpack8(*(const u32x4*)(ur + SX0 + c), xx);
#pragma unroll
        for (int i = 0; i < 8; ++i) acc[i] = cbias[c + i] + cw[256 + c + i] * (cc[i] * xx[i]);
        if (pos > 0) { unpack8(*(const u32x4*)(ur - INP + SC0 + c), cc); unpack8(*(const u32x4*)(ur - INP + SX0 + c), xx);
#pragma unroll
            for (int i = 0; i < 8; ++i) acc[i] += cw[c + i] * (cc[i] * xx[i]); }
        if (pos < L - 1) { unpack8(*(const u32x4*)(ur + INP + SC0 + c), cc); unpack8(*(const u32x4*)(ur + INP + SX0 + c), xx);
#pragma unroll
            for (int i = 0; i < 8; ++i) acc[i] += cw[512 + c + i] * (cc[i] * xx[i]); }
        u32x4 w; w.x = pk2(bgt[0] * acc[0], bgt[1] * acc[1]); w.y = pk2(bgt[2] * acc[2], bgt[3] * acc[3]); w.z = pk2(bgt[4] * acc[4], bgt[5] * acc[5]); w.w = pk2(bgt[6] * acc[6], bgt[7] * acc[7]);
        *(u32x4*)(MIX + (size_t)R * DM + 384 + c) = w;
    }
}

__device__ __forceinline__ void vt_phase(ParamsK p, unsigned char* smem) {
    const bf16_t* U = (const bf16_t*)(WSP + WS_U);
    bf16_t* tile = (bf16_t*)smem;
    constexpr int TS = 72, NITEM = (TT / 64) * 12;
    const int tid = otid();
    const int tok = tid >> 3, d8 = (tid & 7) * 8;
    auto src = [&](int item) { const int tt = item / 12, hs = item % 12; const int col0 = hs < 6 ? NV0 + hs * 64 : V0 + (hs - 6) * 64;
        return U + (size_t)(tt * 64 + tok) * INP + col0 + d8; };
    int item = blockIdx.x;
    u32x4 wn = (u32x4){0u, 0u, 0u, 0u};
    if (item < NITEM) wn = *(const u32x4*)src(item);
    for (; item < NITEM; item += gridDim.x) {
        const u32x4 w = wn;
        if (item + (int)gridDim.x < NITEM) wn = *(const u32x4*)src(item + gridDim.x);
        const int tt = item / 12, hs = item % 12, row0 = tt * 64;
        const int h = hs < 6 ? hs : hs - 6;
        bf16_t* VTx = (bf16_t*)(WSP + (hs < 6 ? WS_VT : WS_VTG));
        int b, sp0; if (row0 < TL) { b = row0 >> 13; sp0 = row0 & (SEQ - 1); } else { b = (row0 - TL) >> 8; sp0 = SEQ + ((row0 - TL) & (CTXL - 1)); }
#pragma unroll
        for (int i = 0; i < 4; ++i) { tile[(d8 + 2 * i) * TS + tok] = (bf16_t)(w[i] & 0xffffu); tile[(d8 + 2 * i + 1) * TS + tok] = (bf16_t)(w[i] >> 16); }
        __syncthreads();
        { const int d = tid >> 3, t8 = (tid & 7) * 8;
          const u32x4 o = *(const u32x4*)(tile + d * TS + t8);
          *(u32x4*)(VTx + (size_t)((b * 6 + h) * 64 + d) * VTW + sp0 + t8) = o; }
        __syncthreads();
    }
}

template <int MODE>
__device__ __forceinline__ void na_chunk(const bf16_t* U, const bf16_t* vt, const float* rpbL, const bf16_t* Kc, const bf16_t* Vc, int b, int r, int h, int rs, int kc0, int qcol, int cs,
                                         const bf16x8 bq0, const bf16x8 bq1, float& m_run, float& l_run, f32x4 (&O)[4], int fr, int fq) {
    f32x4 s[16];
    float mx = -1e30f;
#pragma unroll
    for (int kg = 0; kg < 4; ++kg) {
        bf16x8 ka0[4], ka1[4];
#pragma unroll
        for (int i = 0; i < 4; ++i) { const int kb = kg * 4 + i;
            if (MODE == 2) { const bf16_t* kp = Kc + (kb * 16 + fr) * 72 + fq * 8; ka0[i] = as_bf16x8(*(const u32x4*)kp); ka1[i] = as_bf16x8(*(const u32x4*)(kp + 32)); }
            else { const int krow = MODE == 0 ? (b * SEQ + (rs + (kb >> 1)) * 64 + kc0 + (kb & 1) * 16 + fr) : (TL + b * CTXL + kb * 16 + fr);
                const bf16_t* kp = U + (size_t)krow * INP + NK0 + h * 64 + fq * 8; ka0[i] = as_bf16x8(*(const u32x4*)kp); ka1[i] = as_bf16x8(*(const u32x4*)(kp + 32)); } }
        __builtin_amdgcn_sched_barrier(0);
#pragma unroll
        for (int i = 0; i < 4; ++i) { const int kb = kg * 4 + i;
            f32x4 acc = (f32x4){0.f, 0.f, 0.f, 0.f};
            acc = __builtin_amdgcn_mfma_f32_16x16x32_bf16(ka0[i], bq0, acc, 0, 0, 0);
            acc = __builtin_amdgcn_mfma_f32_16x16x32_bf16(ka1[i], bq1, acc, 0, 0, 0);
            acc = acc * 0.125f;
            if (MODE == 0) {
                const int dr = rs + (kb >> 1) - r + 7;
#pragma unroll
                for (int j = 0; j < 4; ++j) { const int kcol = kc0 + (kb & 1) * 16 + fq * 4 + j; const bool valid = (kcol >= cs) && (kcol < cs + 16);
                    const int dc = min(max(kcol - qcol + 15, 0), 30);
                    acc[j] = valid ? acc[j] + rpbL[(h * 15 + dr) * 31 + dc] : -1e30f; }
            }
            s[kb] = acc;
            mx = fmaxf(mx, fmaxf(fmaxf(acc[0], acc[1]), fmaxf(acc[2], acc[3])));
        }
        __builtin_amdgcn_sched_barrier(0);
    }
    mx = fmaxf(mx, __shfl_xor(mx, 16)); mx = fmaxf(mx, __shfl_xor(mx, 32));
    const float m_new = fmaxf(m_run, mx), alpha = __expf(m_run - m_new);
    float lsum = 0.f; unsigned pkd[16][2];
#pragma unroll
    for (int kb = 0; kb < 16; ++kb) { const float p0 = __expf(s[kb][0] - m_new), p1 = __expf(s[kb][1] - m_new), p2 = __expf(s[kb][2] - m_new), p3 = __expf(s[kb][3] - m_new);
        lsum += (p0 + p1) + (p2 + p3); pkd[kb][0] = pk2(p0, p1); pkd[kb][1] = pk2(p2, p3); }
    lsum += __shfl_xor(lsum, 16); lsum += __shfl_xor(lsum, 32);
    l_run = l_run * alpha + lsum; m_run = m_new;
#pragma unroll
    for (int db = 0; db < 4; ++db) O[db] = O[db] * alpha;
#pragma unroll
    for (int pg = 0; pg < 4; ++pg) {
        u32x2 vlo[2][4], vhi[2][4];
#pragma unroll
        for (int i = 0; i < 2; ++i) { const int pr = pg * 2 + i;
            const int posA = MODE == 0 ? ((rs + pr) * 64 + kc0 + fq * 4) : (SEQ + pr * 32 + fq * 4);
#pragma unroll
            for (int db = 0; db < 4; ++db) {
                if (MODE == 2) { const bf16_t* vp = Vc + (db * 16 + fr) * 264 + pr * 32 + fq * 4; vlo[i][db] = *(const u32x2*)vp; vhi[i][db] = *(const u32x2*)(vp + 16); }
                else { const bf16_t* vp = vt + (size_t)(db * 16) * VTW + posA; vlo[i][db] = *(const u32x2*)vp; vhi[i][db] = *(const u32x2*)(vp + 16); } } }
        __builtin_amdgcn_sched_barrier(0);
#pragma unroll
        for (int i = 0; i < 2; ++i) { const int pr = pg * 2 + i;
            u32x4 bw; bw.x = pkd[2 * pr][0]; bw.y = pkd[2 * pr][1]; bw.z = pkd[2 * pr + 1][0]; bw.w = pkd[2 * pr + 1][1];
            const bf16x8 bp = as_bf16x8(bw);
#pragma unroll
            for (int db = 0; db < 4; ++db) { u32x4 aw; aw.x = vlo[i][db].x; aw.y = vlo[i][db].y; aw.z = vhi[i][db].x; aw.w = vhi[i][db].y;
                O[db] = __builtin_amdgcn_mfma_f32_16x16x32_bf16(as_bf16x8(aw), bp, O[db], 0, 0, 0); } }
        __builtin_amdgcn_sched_barrier(0);
    }
}
template <bool CTXLDS>
__device__ __forceinline__ void na_tile(const bf16_t* U, const bf16_t* VT, bf16_t* MIX, const float* rpbL, const bf16_t* Kc, const bf16_t* Vc, bool lat, int b, int r, int c0, int qrow0, int h, int lane) {
    const int fr = lane & 15, fq = lane >> 4;
    const bf16_t* qp = U + (size_t)(qrow0 + fr) * INP + NQ0 + h * 64 + fq * 8;
    const bf16x8 bq0 = as_bf16x8(*(const u32x4*)qp), bq1 = as_bf16x8(*(const u32x4*)(qp + 32));
    float m_run = -1e30f, l_run = 0.f;
    f32x4 O[4];
#pragma unroll
    for (int db = 0; db < 4; ++db) O[db] = (f32x4){0.f, 0.f, 0.f, 0.f};
    const bf16_t* vt = VT + (size_t)((b * 6 + h) * 64 + fr) * VTW;
    const int rs = min(max(r - 4, 0), 120), kc0 = min(max(c0 - 8, 0), 32);
    const int qcol = c0 + fr, cs = min(max(qcol - 8, 0), 48);
    if (lat) na_chunk<0>(U, vt, rpbL, Kc, Vc, b, r, h, rs, kc0, qcol, cs, bq0, bq1, m_run, l_run, O, fr, fq);
    na_chunk<CTXLDS ? 2 : 1>(U, vt, rpbL, Kc, Vc, b, r, h, rs, kc0, qcol, cs, bq0, bq1, m_run, l_run, O, fr, fq);
    const float inv = 1.f / l_run;
    bf16_t* op = MIX + (size_t)(qrow0 + fr) * DM + 640 + h * 64 + fq * 4;
#pragma unroll
    for (int db = 0; db < 4; ++db) { u32x2 w; w.x = pk2(O[db][0] * inv, O[db][1] * inv); w.y = pk2(O[db][2] * inv, O[db][3] * inv); *(u32x2*)(op + db * 16) = w; }
}
__device__ __forceinline__ void na_phase(ParamsK p, int l, unsigned char* smem, bool with_ctx) {
    const int tid = otid(), lane = tid & 63, wave = __builtin_amdgcn_readfirstlane(tid >> 6);
    float* rpbL = (float*)smem;
    bf16_t* Kc = (bf16_t*)(smem + 12288);
    bf16_t* Vc = (bf16_t*)(smem + 12288 + 36864);
    const float* rpb = IN(16) + (size_t)l * 6 * 15 * 31;
    for (int i = tid; i < 6 * 15 * 31; i += 512) rpbL[i] = rpb[i];
    __syncthreads();
    const bf16_t* U = (const bf16_t*)(WSP + WS_U); const bf16_t* VT = (const bf16_t*)(WSP + WS_VT); bf16_t* MIX = (bf16_t*)(WSP + WS_H);
    const int b = blockIdx.x & 7, lw = (blockIdx.x >> 3) * 8 + wave, nlw = (gridDim.x >> 3) * 8;
    const int NL = (SEQ / 16) * 6, NC = with_ctx ? (CTXL / 16) * 6 : 0;
    if (nlw == 256) {
        for (int round = 0; round < NL / 256; ++round) {
            const int w = lw + 256 * round, cq = w & 3, rr = (w >> 2) & 1, h = (w >> 3) % 6, r = (w / 48) * 2 + rr;
            __syncthreads();
#pragma unroll
            for (int i = 0; i < 4; ++i) { const int idx = i * 512 + tid, key = idx >> 3, part = idx & 7;
                *(u32x4*)(Kc + key * 72 + part * 8) = *(const u32x4*)(U + (size_t)(TL + b * CTXL + key) * INP + NK0 + h * 64 + part * 8); }
#pragma unroll
            for (int i = 0; i < 4; ++i) { const int idx = i * 512 + tid, d = idx >> 5, part = idx & 31;
                *(u32x4*)(Vc + d * 264 + part * 8) = *(const u32x4*)(VT + (size_t)((b * 6 + h) * 64 + d) * VTW + SEQ + part * 8); }
            __syncthreads();
            na_tile<true>(U, VT, MIX, rpbL, Kc, Vc, true, b, r, cq * 16, b * SEQ + r * 64 + cq * 16, h, lane);
        }
        for (int w = NL + lw; w < NL + NC; w += nlw) { const int t2 = w - NL, h = t2 % 6, qt = t2 / 6;
            na_tile<false>(U, VT, MIX, rpbL, Kc, Vc, false, b, 0, 0, TL + b * CTXL + qt * 16, h, lane); }
    } else {
        for (int w = lw; w < NL + NC; w += nlw) {
            if (w < NL) { const int cq = w & 3, h = (w >> 2) % 6, r = w / 24;
                na_tile<false>(U, VT, MIX, rpbL, Kc, Vc, true, b, r, cq * 16, b * SEQ + r * 64 + cq * 16, h, lane); }
            else { const int t2 = w - NL, h = t2 % 6, qt = t2 / 6;
                na_tile<false>(U, VT, MIX, rpbL, Kc, Vc, false, b, 0, 0, TL + b * CTXL + qt * 16, h, lane); }
        }
    }
    __syncthreads();
}

__device__ __forceinline__ void convgate_phase(ParamsK p, int l, int hs, int nrows) {
    constexpr int CG_RUN = 96, CG_LA = 6, NCG = FFN / 8;
    const bf16_t* FU = (const bf16_t*)(WSP + WS_FU); bf16_t* ACT = (bf16_t*)(WSP + WS_ACT);
    const float* cw = IN(19) + (size_t)l * 3 * FF2; const float* cb = IN(20) + (size_t)l * FF2;
    const int gt = blockIdx.x * 512 + otid();
    const int cgi = gt % NCG, sl = gt / NCG, c = cgi * 8;
    const int r0 = sl * CG_RUN;
    if (r0 >= nrows) return;
    const int r1 = min(r0 + CG_RUN, nrows);
    float wa[3][8], wb[3][8], ba[8], bb[8];
#pragma unroll
    for (int j = 0; j < 3; ++j)
#pragma unroll
        for (int i = 0; i < 8; ++i) { wa[j][i] = cw[j * FF2 + c + i]; wb[j][i] = cw[j * FF2 + FFN + c + i]; }
#pragma unroll
    for (int i = 0; i < 8; ++i) { ba[i] = cb[c + i]; bb[i] = cb[FFN + c + i]; }
    const bf16_t* ub = FU + c;
    auto seqpos = [&](int lr, int& pos, int& L) { const int Rg = hs + lr; if (Rg < TL) { pos = Rg & (SEQ - 1); L = SEQ; } else { pos = (Rg - TL) & (CTXL - 1); L = CTXL; } };
    float pa[8], pb[8], ca[8], cbv[8];
    { int pos, L; seqpos(r0, pos, L);
      if (pos > 0) { unpack8(*(const u32x4*)(ub + (size_t)(r0 - 1) * FF2), pa); unpack8(*(const u32x4*)(ub + (size_t)(r0 - 1) * FF2 + FFN), pb); }
      else {
#pragma unroll
          for (int i = 0; i < 8; ++i) { pa[i] = 0.f; pb[i] = 0.f; } }
      unpack8(*(const u32x4*)(ub + (size_t)r0 * FF2), ca); unpack8(*(const u32x4*)(ub + (size_t)r0 * FF2 + FFN), cbv); }
    u32x4 ra[CG_LA], rb[CG_LA];
#pragma unroll
    for (int i = 0; i < CG_LA; ++i) { const int lr = min(r0 + 1 + i, nrows - 1); ra[i] = *(const u32x4*)(ub + (size_t)lr * FF2); rb[i] = *(const u32x4*)(ub + (size_t)lr * FF2 + FFN); }
    for (int t = r0; t < r1; t += CG_LA) {
#pragma unroll
        for (int i = 0; i < CG_LA; ++i) {
            const int row = t + i;
            const u32x4 xa = ra[i], xb = rb[i];
            { const int lr = min(row + 1 + CG_LA, nrows - 1); ra[i] = *(const u32x4*)(ub + (size_t)lr * FF2); rb[i] = *(const u32x4*)(ub + (size_t)lr * FF2 + FFN); }
            int pos, L; seqpos(row, pos, L);
            float na[8], nb[8];
            if (pos < L - 1 && row + 1 < nrows) { unpack8(xa, na); unpack8(xb, nb); }
            else {
#pragma unroll
                for (int k = 0; k < 8; ++k) { na[k] = 0.f; nb[k] = 0.f; } }
            if (row < r1) {
                float o[8];
#pragma unroll
                for (int k = 0; k < 8; ++k) { const float a = wa[0][k] * pa[k] + wa[1][k] * ca[k] + wa[2][k] * na[k] + ba[k];
                    const float g = wb[0][k] * pb[k] + wb[1][k] * cbv[k] + wb[2][k] * nb[k] + bb[k];
                    o[k] = silu_f(a) * g; }
                u32x4 w; w.x = pk2(o[0], o[1]); w.y = pk2(o[2], o[3]); w.z = pk2(o[4], o[5]); w.w = pk2(o[6], o[7]);
                *(u32x4*)(ACT + (size_t)row * FFN + c) = w;
            }
            const bool lastOfSeq = (pos == L - 1);
#pragma unroll
            for (int k = 0; k < 8; ++k) { pa[k] = lastOfSeq ? 0.f : ca[k]; pb[k] = lastOfSeq ? 0.f : cbv[k]; }
            if (lastOfSeq && row + 1 < nrows) { unpack8(xa, ca); unpack8(xb, cbv); }
            else {
#pragma unroll
                for (int k = 0; k < 8; ++k) { ca[k] = na[k]; cbv[k] = nb[k]; } }
        }
    }
}

__global__ void __launch_bounds__(512, 2) fwd_megakernel(Params p_unused) {
    extern __shared__ __attribute__((aligned(16))) unsigned char smem[];
    cg::grid_group grid = cg::this_grid();
    __shared__ uint4 xb_words;
    if (threadIdx.x == 0) xb_words = make_uint4(0u, 0u, 0u, 0u);
    __syncthreads();
    XcdBarrier xb; { ParamsK p = getpk(); xb = xcd_barrier_post((unsigned*)(WSP + WS_CTL), (volatile LAS unsigned*)&xb_words); }
    { ParamsK p = getpk(); ada_phase(p, smem); }
    { ParamsK p = getpk(); weights_phase(p, smem); }
    GSYNC_CG();
    { ParamsK p = getpk(); prep_phase(p); }
    for (int l = 0; l < DEPTH; ++l) {
        const bool upd = l < DEPTH - 1;
        const int Mout = upd ? TT : TL;
        if (l == 0) {
            { ParamsK p = getpk(); const float* ml = (const float*)(WSP + WS_MOD);
              norm_phase(IN(0), IN(2), IN(6), ml, ml + DM, (bf16_t*)(WSP + WS_H), TT); }
            GSYNC();
            { ParamsK p = getpk(); EpiStore E; E.O = (bf16_t*)(WSP + WS_U); E.ldc = INP;
              run_gemm(smem, (const bf16_t*)(WSP + WS_H), (const bf16_t*)(WSP + WS_WIN), TT, INP, DM, E); }
        } else {
            ParamsK p = getpk(); EpiStoreN E; E.O = (bf16_t*)(WSP + WS_U) + (size_t)HALF0 * INP; E.ldc = INP; E.stat = (const float*)(WSP + WS_STAT); E.bias = (const float*)(WSP + WS_BIAS) + (size_t)(l * 2) * 9 * FF2; E.rowbase = HALF0;
            run_gemm(smem, (const bf16_t*)(WSP + WS_H) + (size_t)HALF0 * DM, (const bf16_t*)(WSP + WS_WIN) + (size_t)l * INP * DM, TT - HALF0, INP, DM, E);
        }
        GSYNC();
        for (int rep = 0; rep < REP_VT; ++rep) { ParamsK p = getpk(); vt_phase(p, smem); }
        { ParamsK p = getpk(); shortconv_phase(p, l); }
        GSYNC();
        for (int rep = 0; rep < REP_GLA; ++rep) { ParamsK p = getpk(); gla_step1(p, l, smem); }
        __syncthreads();
        for (int rep = 0; rep < REP_NA; ++rep) { ParamsK p = getpk(); na_phase(p, l, smem, upd); }
        GSYNC();
        { ParamsK p = getpk(); gla_step2(p); }
        GSYNC();
        for (int rep = 0; rep < REP_GLA; ++rep) { ParamsK p = getpk(); gla_step3(p, l, smem); }
        GSYNC();
        { ParamsK p = getpk(); const float* ml = (const float*)(WSP + WS_MOD) + (size_t)l * 9 * MODW;
          EpiResidN E; E.rin_l = l == 0 ? IN(0) : OUTP; E.rin_c = l == 0 ? IN(2) : (const float*)(WSP + WS_XC); E.rout_l = OUTP; E.rout_c = (float*)(WSP + WS_XC); E.gate = ml + 2 * DM; E.rowbase = 0;
          E.Hn = (bf16_t*)(WSP + WS_H2); E.gs = (const float*)(WSP + WS_GSV) + (size_t)(l * 2 + 1) * 9 * DM; E.stat = (float*)(WSP + WS_STAT) + (size_t)TT * 16;
          run_gemm(smem, (const bf16_t*)(WSP + WS_H), (const bf16_t*)(WSP + WS_WOUT) + (size_t)l * DM * DM, Mout, DM, DM, E); }
        GSYNC();
        for (int half = 0; half < 2; ++half) {
            const int hs = half * HALF0, nr = half == 0 ? HALF0 : Mout - HALF0;
            { ParamsK p = getpk(); EpiStoreN E; E.O = (bf16_t*)(WSP + WS_FU); E.ldc = FF2; E.stat = (const float*)(WSP + WS_STAT) + (size_t)TT * 16; E.bias = (const float*)(WSP + WS_BIAS) + (size_t)(l * 2 + 1) * 9 * FF2; E.rowbase = hs;
              run_gemm(smem, (const bf16_t*)(WSP + WS_H2) + (size_t)hs * DM, (const bf16_t*)(WSP + WS_WUP) + (size_t)l * FF2 * DM, nr, FF2, DM, E); }
            GSYNC();
            for (int rep = 0; rep < REP_CG; ++rep) { ParamsK p = getpk(); convgate_phase(p, l, hs, nr); }
            GSYNC();
            if (upd) { ParamsK p = getpk(); const float* ml = (const float*)(WSP + WS_MOD) + (size_t)l * 9 * MODW;
              EpiResidN E; E.rin_l = OUTP; E.rin_c = (const float*)(WSP + WS_XC); E.rout_l = OUTP; E.rout_c = (float*)(WSP + WS_XC); E.gate = ml + 5 * DM; E.rowbase = hs;
              E.Hn = (bf16_t*)(WSP + WS_H); E.gs = (const float*)(WSP + WS_GSV) + (size_t)((l + 1) * 2) * 9 * DM; E.stat = (float*)(WSP + WS_STAT);
              run_gemm(smem, (const bf16_t*)(WSP + WS_ACT), (const bf16_t*)(WSP + WS_WDN) + (size_t)l * DM * FFN, nr, DM, FFN, E);
              if (half == 1) {
                  EpiStoreN E2; E2.O = (bf16_t*)(WSP + WS_U); E2.ldc = INP; E2.stat = (const float*)(WSP + WS_STAT); E2.bias = (const float*)(WSP + WS_BIAS) + (size_t)((l + 1) * 2) * 9 * FF2; E2.rowbase = 0;
                  run_gemm(smem, (const bf16_t*)(WSP + WS_H), (const bf16_t*)(WSP + WS_WIN) + (size_t)(l + 1) * INP * DM, HALF0, INP, DM, E2, 224); } }
            else { ParamsK p = getpk(); const float* ml = (const float*)(WSP + WS_MOD) + (size_t)l * 9 * MODW;
              EpiResid E; E.rin_l = OUTP; E.rin_c = (const float*)(WSP + WS_XC); E.rout_l = OUTP; E.rout_c = (float*)(WSP + WS_XC); E.gate = ml + 5 * DM; E.rowbase = hs;
              run_gemm(smem, (const bf16_t*)(WSP + WS_ACT), (const bf16_t*)(WSP + WS_WDN) + (size_t)l * DM * FFN, nr, DM, FFN, E); }
        }
        GSYNC();
    }
    { ParamsK p = getpk(); final_norm_phase(OUTP, IN(22)); }
}

extern "C" void kernel_launch(void* const* d_in, const int* in_sizes, int n_in, void* d_out, int out_size, void* d_ws, size_t ws_size, hipStream_t stream) {
    static int grid_blocks = 0;
    if (grid_blocks == 0) {
        if (n_in != 23 || ws_size < WS_NEED) { fprintf(stderr, "kernel_launch: unexpected n_in %d or ws %zu < %zu\n", n_in, ws_size, (size_t)WS_NEED); grid_blocks = -1; return; }
        int dev = 0, cus = 0, per_cu = 0;
        hipGetDevice(&dev);
        hipDeviceGetAttribute(&cus, hipDeviceAttributeMultiprocessorCount, dev);
        if (hipFuncSetAttribute((const void*)fwd_megakernel, hipFuncAttributeMaxDynamicSharedMemorySize, LDS_BYTES) != hipSuccess) { fprintf(stderr, "kernel_launch: hipFuncSetAttribute failed\n"); }
        if (hipOccupancyMaxActiveBlocksPerMultiprocessor(&per_cu, (const void*)fwd_megakernel, 512, LDS_BYTES) != hipSuccess || per_cu < 1) { fprintf(stderr, "kernel_launch: occupancy query gave %d\n", per_cu); per_cu = 1; }
        (void)hipGetLastError();
        grid_blocks = cus * 1;
        if (grid_blocks <= 0) grid_blocks = 256;
    }
    if (grid_blocks < 0) return;
    if (hipMemsetAsync((char*)d_ws + WS_CTL, 0, 16384, stream) != hipSuccess) { fprintf(stderr, "kernel_launch: hipMemsetAsync of the barrier word failed\n"); return; }
    Params p{};
    for (int i = 0; i < 23; ++i) p.in[i] = (const float*)d_in[i];
    p.out = (float*)d_out; p.ws = (unsigned char*)d_ws;
    void* args[] = {&p};
    hipError_t e = hipLaunchCooperativeKernel((const void*)fwd_megakernel, dim3(grid_blocks), dim3(512), args, LDS_BYTES, stream);
    if (e != hipSuccess) fprintf(stderr, "cooperative launch failed: %s (grid %d)\n", hipGetErrorString(e), grid_blocks);
}
```

```cpp
#include <hip/hip_runtime.h>
#include <hip/hip_cooperative_groups.h>
#include <cstdio>
#include <cstdint>
namespace cg = cooperative_groups;
__device__ __forceinline__ int otid() { int t = threadIdx.x; asm volatile("" : "+v"(t)); return t; }
namespace pg8 {
#define PG8_LAS __attribute__((address_space(3)))
typedef unsigned short bf16_t;
typedef short bf16x8 __attribute__((ext_vector_type(8)));
typedef float f32x4 __attribute__((ext_vector_type(4)));
typedef unsigned u32x4 __attribute__((ext_vector_type(4)));
constexpr int BM = 256, BK = 64, HALF = 128, HTB = HALF * BK * 2  , STAGE_BYTES = 8 * HTB, NXCD = 8, WGM = 8;

__host__ __device__ __forceinline__ int lds_byte(int r, int c) { const int st = (r >> 4) * 2 + (c >> 5), rr = r & 15, cc = c & 31, ob = rr * 64 + cc * 2; return st * 1024 + (ob ^ (((ob >> 9) & 1) << 5)); }
__host__ __device__ __forceinline__ void stage_rc(int b, int& R, int& C) { const int st = b / 1024, sb = b % 1024, swz = sb ^ (((sb >> 9) & 1) << 5); R = (st >> 1) * 16 + swz / 64; C = (st & 1) * 32 + (swz % 64) / 2; }
__host__ __device__ __forceinline__ int perm32(int rho) { const int n = rho >> 4, i = rho & 15; return 8 * (i >> 2) + 4 * n + (i & 3); }

struct Unit { int pm, pn; };
struct Gemm { const bf16_t* A; const bf16_t* Bt; int M, N, K; };

struct StaticOrder {
    int nM, nN, nwg, G, c;
    __host__ __device__ void init(int M, int N, int G_, int c_) { nM = M / BM; nN = N / BM; nwg = nM * nN; G = G_; c = c_; }
    __host__ __device__ bool next(int i, Unit& u) const {
        const long L = (long)i * G + c; if (L >= nwg) return false;
        int wgid = (int)L; { const int q = nwg / NXCD, r = nwg % NXCD, xcd = wgid % NXCD, off = wgid / NXCD; wgid = (xcd < r ? xcd * (q + 1) : r * (q + 1) + (xcd - r) * q) + off; }
        const int nig = WGM * nN, gid = wgid / nig, fm = gid * WGM, gsz = (nM - fm) < WGM ? (nM - fm) : WGM;
        u.pm = fm + ((wgid % nig) % gsz); u.pn = (wgid % nig) / gsz; return true;
    }
    __device__ __forceinline__ void a_ready(const Unit&) const {}
    __device__ __forceinline__ void done(const Unit&) const {}
};

typedef float f32x2v_ __attribute__((ext_vector_type(2)));
typedef __bf16 bf16x2v_ __attribute__((ext_vector_type(2)));
__device__ __forceinline__ unsigned cvt_pk_bf16(float lo, float hi) { f32x2v_ v = {lo, hi}; bf16x2v_ b = __builtin_convertvector(v, bf16x2v_); return __builtin_bit_cast(unsigned, b); }
template <class Epi, class Sched, bool ALIGN_EPI = false, bool SP2 = false>
__device__ __forceinline__ void gemm_phase(PG8_LAS unsigned char* lds, const Gemm g, const Sched& S, const Epi& E) {
    const int tid = otid(), wid = __builtin_amdgcn_readfirstlane(tid >> 6), lane = tid & 63, wr = wid >> 2, wc = wid & 3, fr = lane & 15, fq = lane >> 4;
    const int K = g.K, nt = K / BK;
    unsigned voffA[2], voffB[2];
#pragma unroll
    for (int i = 0; i < 2; ++i) { int R, C; stage_rc(tid * 16 + i * 8192, R, C); const int Rb = Epi::PERM ? ((R & ~31) + perm32(R & 31)) : R;
        voffA[i] = (unsigned)(R * K + C) * 2u; voffB[i] = (unsigned)(Rb * K + C) * 2u; }
    const size_t kstep = (size_t)(BK * 2);
    const size_t hstep = (size_t)HALF * K * 2;
    const size_t tstep = 2 * hstep;
    const unsigned ldsw = (unsigned)wid * 1024u;
    const int aoff = lds_byte(wr * 64 + fr, fq * 8), boff = lds_byte(wc * 32 + fr, fq * 8);
#define PG8_SA(b, h) (((b) * 2 + (h)) * HTB)
#define PG8_SB(b, h) ((4 + (b) * 2 + (h)) * HTB)
#define PG8_STAGE(bufoff, gbase, voff) do { _Pragma("unroll") for (int _i = 0; _i < 2; ++_i) \
        __builtin_amdgcn_global_load_lds((const unsigned*)((const char*)(gbase) + (voff)[_i]), (PG8_LAS unsigned*)(lds + (bufoff) + ldsw + _i * 8192), 16, 0, 0); } while (0)
#define PG8_LDA(dst, b, h) do { _Pragma("unroll") for (int m = 0; m < 4; ++m) _Pragma("unroll") for (int k = 0; k < 2; ++k) dst[m][k] = *(const PG8_LAS bf16x8*)(lds + PG8_SA(b, h) + aoff + m * 2048 + k * 1024); } while (0)
#define PG8_LDB(dst, b, h) do { _Pragma("unroll") for (int n = 0; n < 2; ++n) _Pragma("unroll") for (int k = 0; k < 2; ++k) dst[n][k] = *(const PG8_LAS bf16x8*)(lds + PG8_SB(b, h) + boff + n * 2048 + k * 1024); } while (0)
#define PG8_MMA(ai, bj, At, Bt) do { __builtin_amdgcn_s_setprio(1); _Pragma("unroll") for (int m = 0; m < 4; ++m) _Pragma("unroll") for (int n = 0; n < 2; ++n) _Pragma("unroll") for (int k = 0; k < 2; ++k) \
        acc[ai][bj][m][n] = __builtin_amdgcn_mfma_f32_16x16x32_bf16(Bt[n][k], At[m][k], acc[ai][bj][m][n], 0, 0, 0); __builtin_amdgcn_s_setprio(0); } while (0)
#define PG8_WAIT_V(n) asm volatile("s_waitcnt vmcnt(" #n ")" ::: "memory")
#define PG8_WAIT_L(n) asm volatile("s_waitcnt lgkmcnt(" #n ")" ::: "memory")
#define PG8_BAR __builtin_amdgcn_s_barrier()
#define PG8_SCHED __builtin_amdgcn_sched_barrier(0)
    Unit cur, nxt; int ui = 0;
    if (!S.next(0, cur)) return;
    f32x4 acc[2][2][4][2];
#pragma unroll
    for (int a = 0; a < 2; ++a)
#pragma unroll
        for (int b = 0; b < 2; ++b)
#pragma unroll
            for (int m = 0; m < 4; ++m)
#pragma unroll
                for (int n = 0; n < 2; ++n) acc[a][b][m][n] = (f32x4){0.f, 0.f, 0.f, 0.f};
    bf16x8 At[4][2], B0[2][2], B1[2][2];
    const char* cA = (const char*)g.A + (size_t)cur.pm * tstep; const char* cB = (const char*)g.Bt + (size_t)cur.pn * tstep;
    S.a_ready(cur);
    if constexpr (SP2) {
        PG8_STAGE(PG8_SB(0, 0), cB, voffB); PG8_STAGE(PG8_SB(0, 1), cB + hstep, voffB); PG8_STAGE(PG8_SA(0, 0), cA, voffA); PG8_STAGE(PG8_SA(0, 1), cA + hstep, voffA);
        if (wr == 1) PG8_BAR;
        PG8_WAIT_V(2); PG8_BAR;
        PG8_STAGE(PG8_SB(1, 0), cB + kstep, voffB); PG8_STAGE(PG8_SA(1, 0), cA + kstep, voffA); PG8_STAGE(PG8_SB(1, 1), cB + hstep + kstep, voffB);
        PG8_WAIT_V(6); PG8_BAR;
    } else {
        PG8_STAGE(PG8_SB(0, 0), cB, voffB); PG8_STAGE(PG8_SA(0, 0), cA, voffA); PG8_STAGE(PG8_SB(0, 1), cB + hstep, voffB); PG8_STAGE(PG8_SA(0, 1), cA + hstep, voffA);
        if (wr == 1) PG8_BAR;
        PG8_WAIT_V(4); PG8_BAR;
        PG8_STAGE(PG8_SB(1, 0), cB + kstep, voffB); PG8_STAGE(PG8_SA(1, 0), cA + kstep, voffA); PG8_STAGE(PG8_SB(1, 1), cB + hstep + kstep, voffB);
        PG8_WAIT_V(6); PG8_BAR;
    }
    for (;;) {
        const bool has_next = S.next(ui + 1, nxt);
        const char* nA = has_next ? (const char*)g.A + (size_t)nxt.pm * tstep : cA; const char* nB = has_next ? (const char*)g.Bt + (size_t)nxt.pn * tstep : cB;
        for (int t = 0; t < nt; t += 2) {
            const bool last = (t == nt - 2);
            const char* a1 = cA + (size_t)(t + 1) * kstep;
            const char* a2 = last ? nA : cA + (size_t)(t + 2) * kstep; const char* b2 = last ? nB : cB + (size_t)(t + 2) * kstep;
            const char* a3 = a2 + kstep; const char* b3 = b2 + kstep;
            if (last && has_next) S.a_ready(nxt);
            if constexpr (SP2) {
            PG8_LDB(B0, 0, 0); PG8_LDB(B1, 0, 1); PG8_SCHED; PG8_LDA(At, 0, 0); PG8_STAGE(PG8_SA(1, 1), a1 + hstep, voffA);
            PG8_WAIT_V(8); PG8_WAIT_L(0); PG8_BAR; PG8_MMA(0, 0, At, B0); PG8_MMA(0, 1, At, B1); PG8_BAR; PG8_SCHED;
            PG8_LDA(At, 0, 1); PG8_STAGE(PG8_SB(0, 0), b2, voffB); PG8_STAGE(PG8_SB(0, 1), b2 + hstep, voffB); PG8_STAGE(PG8_SA(0, 0), a2, voffA);
            PG8_WAIT_V(8); PG8_WAIT_L(0); PG8_BAR; PG8_MMA(1, 0, At, B0); PG8_MMA(1, 1, At, B1); PG8_BAR; PG8_SCHED;
            PG8_LDB(B0, 1, 0); PG8_LDB(B1, 1, 1); PG8_SCHED; PG8_LDA(At, 1, 0); PG8_STAGE(PG8_SA(0, 1), a2 + hstep, voffA);
            PG8_WAIT_V(8); PG8_WAIT_L(0); PG8_BAR; PG8_MMA(0, 0, At, B0); PG8_MMA(0, 1, At, B1); PG8_BAR; PG8_SCHED;
            PG8_LDA(At, 1, 1); PG8_STAGE(PG8_SB(1, 0), b3, voffB); PG8_STAGE(PG8_SB(1, 1), b3 + hstep, voffB); PG8_STAGE(PG8_SA(1, 0), a3, voffA);
            PG8_WAIT_V(8); PG8_WAIT_L(0); PG8_BAR; PG8_MMA(1, 0, At, B0); PG8_MMA(1, 1, At, B1); PG8_BAR; PG8_SCHED;
            } else {
            PG8_LDB(B0, 0, 0); PG8_SCHED; PG8_LDA(At, 0, 0); PG8_STAGE(PG8_SA(1, 1), a1 + hstep, voffA);
            PG8_WAIT_L(8); PG8_BAR; PG8_WAIT_L(0); PG8_MMA(0, 0, At, B0); PG8_BAR; PG8_SCHED;
            PG8_LDB(B1, 0, 1); PG8_STAGE(PG8_SB(0, 0), b2, voffB);
            PG8_BAR; PG8_WAIT_L(0); PG8_MMA(0, 1, At, B1); PG8_BAR;
            PG8_LDA(At, 0, 1); PG8_STAGE(PG8_SA(0, 0), a2, voffA);
            PG8_BAR; PG8_WAIT_L(0); PG8_MMA(1, 0, At, B0); PG8_BAR; PG8_SCHED;
            PG8_STAGE(PG8_SB(0, 1), b2 + hstep, voffB);
            PG8_WAIT_V(6); PG8_BAR; PG8_MMA(1, 1, At, B1); PG8_BAR;
            PG8_LDB(B0, 1, 0); PG8_SCHED; PG8_LDA(At, 1, 0); PG8_STAGE(PG8_SA(0, 1), a2 + hstep, voffA);
            PG8_WAIT_L(8); PG8_BAR; PG8_WAIT_L(0); PG8_MMA(0, 0, At, B0); PG8_BAR; PG8_SCHED;
            PG8_LDB(B1, 1, 1); PG8_STAGE(PG8_SB(1, 0), b3, voffB);
            PG8_BAR; PG8_WAIT_L(0); PG8_MMA(0, 1, At, B1); PG8_BAR;
            PG8_LDA(At, 1, 1); PG8_STAGE(PG8_SA(1, 0), a3, voffA);
            PG8_BAR; PG8_WAIT_L(0); PG8_MMA(1, 0, At, B0); PG8_BAR; PG8_SCHED;
            PG8_STAGE(PG8_SB(1, 1), b3 + hstep, voffB);
            PG8_WAIT_V(6); PG8_BAR; PG8_MMA(1, 1, At, B1); PG8_BAR;
            }
        }
        if constexpr (ALIGN_EPI) { if (wr == 0) PG8_BAR; }
        if constexpr (!Epi::AFTER_DRAIN) { E(acc, cur, wr, wc, fr, fq); S.done(cur); }
        if (!has_next) break;
#pragma unroll
        for (int a = 0; a < 2; ++a)
#pragma unroll
            for (int b = 0; b < 2; ++b)
#pragma unroll
                for (int m = 0; m < 4; ++m)
#pragma unroll
                    for (int n = 0; n < 2; ++n) acc[a][b][m][n] = (f32x4){0.f, 0.f, 0.f, 0.f};
        cur = nxt; cA = nA; cB = nB; ++ui;
        if constexpr (ALIGN_EPI) { if (wr == 1) PG8_BAR; }
    }
    PG8_WAIT_V(0);
    if constexpr (!ALIGN_EPI) { if (wr == 0) PG8_BAR; }
    PG8_BAR;
    if constexpr (Epi::AFTER_DRAIN) { E.fused(acc, cur, wr, wc, fr, fq, lds, wid, lane); S.done(cur); }
#undef PG8_SA
#undef PG8_SB
#undef PG8_STAGE
#undef PG8_LDA
#undef PG8_LDB
#undef PG8_MMA
#undef PG8_WAIT_V
#undef PG8_WAIT_L
#undef PG8_BAR
#undef PG8_SCHED
}
}

typedef unsigned short bf16_t;
typedef short bf16x8 __attribute__((ext_vector_type(8)));
typedef float f32x4 __attribute__((ext_vector_type(4)));
typedef unsigned u32x4 __attribute__((ext_vector_type(4)));
typedef unsigned u32x2 __attribute__((ext_vector_type(2)));
#define LAS __attribute__((address_space(3)))

constexpr int DM = 1024, NBAT = 8, SEQ = 8192, DEPTH = 4, CTXL = 256;
constexpr int TL = NBAT * SEQ, TC = NBAT * CTXL, TT = TL + TC;
constexpr int INW = 3104, INP = 3328;
constexpr int Q0 = 0, K0 = 192, V0 = 384, GF0 = 768, GB0 = 784, R0 = 800, SB0 = 1184, SC0 = 1440, SX0 = 1696, NQ0 = 1952, NK0 = 2336, NV0 = 2720;
constexpr int FFN = 2816, FF2 = 5632;
constexpr int MODW = 6 * DM;
constexpr int NCH = 132;
constexpr int VTW = SEQ + CTXL;
constexpr int HALF0 = 32768;

constexpr size_t WS_WIN = 0;
constexpr size_t WS_WOUT = WS_WIN + (size_t)DEPTH * INP * DM * 2;
constexpr size_t WS_WUP = WS_WOUT + (size_t)DEPTH * DM * DM * 2;
constexpr size_t WS_WDN = WS_WUP + (size_t)DEPTH * FF2 * DM * 2;
constexpr size_t WS_MOD = WS_WDN + (size_t)DEPTH * DM * FFN * 2;
constexpr size_t WS_ROPE = WS_MOD + (size_t)DEPTH * 9 * MODW * 4;
constexpr size_t WS_XC = WS_ROPE + (size_t)SEQ * 32 * 4;
constexpr size_t WS_H = WS_XC + (size_t)TC * DM * 4;
constexpr size_t WS_BIG = WS_H + (size_t)TT * DM * 2;
constexpr size_t WS_U = WS_BIG;
constexpr size_t WS_VT = WS_U + (size_t)TT * INP * 2;
constexpr size_t WS_VTG = WS_VT + (size_t)48 * 64 * VTW * 2;
constexpr size_t WS_SL = WS_VTG + (size_t)48 * 64 * VTW * 2;
constexpr size_t WS_DEC = WS_SL + (size_t)96 * NCH * 2048 * 4;
constexpr size_t WS_OG = WS_DEC + (size_t)96 * NCH * 32 * 4;
constexpr size_t WS_END1 = WS_OG + (size_t)TT * 384 * 4;
constexpr size_t WS_FU = WS_BIG;
constexpr size_t WS_ACT = WS_FU + (size_t)34816 * FF2 * 2;
constexpr size_t WS_END2 = WS_ACT + (size_t)34816 * FFN * 2;
constexpr size_t WS_CTL = ((WS_END1 > WS_END2 ? WS_END1 : WS_END2) + 4095) / 4096 * 4096;
constexpr size_t WS_GSV = WS_CTL + 16384;
constexpr size_t WS_BIAS = WS_GSV + (size_t)DEPTH * 2 * 9 * DM * 4;
constexpr size_t WS_STAT = WS_BIAS + (size_t)DEPTH * 2 * 9 * FF2 * 4;
constexpr size_t WS_NEED = WS_STAT + (size_t)2 * TT * 16 * 4 + 4096;
constexpr size_t WS_H2 = (WS_END2 + 4095) / 4096 * 4096;
static_assert(WS_H2 + (size_t)TT * DM * 2 <= WS_CTL, "H2 overlay must end before the control words");
constexpr int LDS_BYTES = 131072;
#define GSYNC_CG() do { asm volatile("s_waitcnt vmcnt(0)" ::: "memory"); grid.sync(); } while (0)
#define XB_TMO      128
#define XB_XCNT(j)  (256  + 64 * (j))
#define XB_XSUB(j)  (1280 + 64 * (j))
#define XB_XGEN(j)  (2304 + 64 * (j))
#define XB_TOP      3328
#define XB_TOPGEN   3392
#define XCD_BAR_WORDS 3456
#define XB_SPIN_CAP (1u << 18)
__device__ __forceinline__ unsigned xb_ld(unsigned* p)              { return __hip_atomic_load(p, __ATOMIC_RELAXED, __HIP_MEMORY_SCOPE_AGENT); }
__device__ __forceinline__ unsigned xb_add(unsigned* p, unsigned v) { return __hip_atomic_fetch_add(p, v, __ATOMIC_RELAXED, __HIP_MEMORY_SCOPE_AGENT); }
__device__ __forceinline__ unsigned xb_xcc_id() { return (unsigned)__builtin_amdgcn_s_getreg((3 << 11) | 20) & 0xFu; }
#define XB_SPIN(cond, bar) do { unsigned _sp = 0; while (cond) { __builtin_amdgcn_s_sleep(1); \
    if ((++_sp & 255u) == 0u) { if (xb_ld(&(bar)[XB_TMO])) break; if (_sp > XB_SPIN_CAP) { atomicAdd(&(bar)[XB_TMO], 1u); break; } } } } while (0)
struct XcdBarrier { unsigned* bar; unsigned x; volatile LAS unsigned* st; };
__device__ __forceinline__ XcdBarrier xcd_barrier_post(unsigned* bar, volatile LAS unsigned* st) {
    XcdBarrier b; b.bar = bar; b.x = xb_xcc_id(); b.st = st;
    if (threadIdx.x == 0) (void)xb_add(&bar[XB_XCNT(b.x)], 1u);
    return b;
}
__device__ __forceinline__ void xcd_barrier_complete(unsigned* bar, unsigned x, unsigned& nloc, unsigned& nx) {
    const unsigned G = gridDim.x * gridDim.y * gridDim.z;
    unsigned sum, cnt, mine, sp = 0u;
    for (;;) {
        sum = 0u; cnt = 0u; mine = 0u;
#pragma unroll
        for (unsigned j = 0; j < 16; ++j) { const unsigned c = xb_ld(&bar[XB_XCNT(j)]); sum += c; cnt += (c > 0u) ? 1u : 0u; mine = (j == x) ? c : mine; }
        if (sum == G) break;
        __builtin_amdgcn_s_sleep(1);
        if ((++sp & 255u) == 0u) { if (xb_ld(&bar[XB_TMO])) break; if (sp > XB_SPIN_CAP) { atomicAdd(&bar[XB_TMO], 1u); break; } }
    }
    nloc = mine > 0u ? mine : 1u; nx = cnt > 0u ? cnt : 1u;
}
__device__ __forceinline__ void xcd_barrier(const XcdBarrier& b) {
    asm volatile("s_waitcnt vmcnt(0)" ::: "memory");
    __syncthreads();
    if (threadIdx.x == 0) {
        unsigned* bar = b.bar;
        __builtin_amdgcn_s_waitcnt(0);
        unsigned nloc = b.st[0], nx = b.st[1];
        if (nloc == 0u) { xcd_barrier_complete(bar, b.x, nloc, nx); b.st[0] = nloc; b.st[1] = nx; }
        const unsigned old = xb_add(&bar[XB_XSUB(b.x)], 1u);
        const unsigned gen = old / nloc;
        if (old + 1u == (gen + 1u) * nloc) {
            __builtin_amdgcn_fence(__ATOMIC_RELEASE, "agent");
            asm volatile("s_waitcnt vmcnt(0)" ::: "memory");
            const unsigned og = xb_add(&bar[XB_TOP], 1u);
            const unsigned tg = og / nx;
            if (og + 1u == (tg + 1u) * nx) xb_add(&bar[XB_TOPGEN], 1u);
            else XB_SPIN(xb_ld(&bar[XB_TOPGEN]) == tg, bar);
            __builtin_amdgcn_fence(__ATOMIC_ACQUIRE, "agent");
            xb_add(&bar[XB_XGEN(b.x)], 1u);
            asm volatile("s_waitcnt vmcnt(0)" ::: "memory");
        } else {
            XB_SPIN(xb_ld(&bar[XB_XGEN(b.x)]) == gen, bar);
            __builtin_amdgcn_fence(__ATOMIC_ACQUIRE, "agent");
            asm volatile("s_waitcnt vmcnt(0)" ::: "memory");
        }
    }
    __syncthreads();
}
#define GSYNC() xcd_barrier(xb)
#ifndef REP_GLA
#define REP_GLA 1
#endif
#ifndef REP_NA
#define REP_NA 1
#endif
#ifndef REP_CG
#define REP_CG 1
#endif
#ifndef REP_GEMM
#define REP_GEMM 1
#endif
#ifndef REP_NORM
#define REP_NORM 1
#endif
#ifndef REP_VT
#define REP_VT 1
#endif

struct Params {
    const float* in[23];
    float* out;
    unsigned char* ws;
};


typedef const Params __attribute__((address_space(4)))* ParamsK;
__device__ __forceinline__ ParamsK getpk() { ParamsK q = (ParamsK)__builtin_amdgcn_kernarg_segment_ptr(); asm volatile("" : "+s"(q)); return q; }
template <class T> __device__ __forceinline__ T* asglobal(T* q) {
#if defined(__HIP_DEVICE_COMPILE__)
    __builtin_assume(!__builtin_amdgcn_is_shared((const void*)q)); __builtin_assume(!__builtin_amdgcn_is_private((const void*)q));
#endif
    return q; }
#define IN(i) asglobal(p->in[i])
#define WSP asglobal(p->ws)
#define OUTP asglobal(p->out)
__device__ __forceinline__ float bf2f(bf16_t v) { return __uint_as_float(((unsigned)v) << 16); }
__device__ __forceinline__ float bflo(unsigned w) { return __uint_as_float(w << 16); }
__device__ __forceinline__ float bfhi(unsigned w) { return __uint_as_float(w & 0xffff0000u); }
__device__ __forceinline__ unsigned pk2(float lo, float hi) { return pg8::cvt_pk_bf16(lo, hi); }
__device__ __forceinline__ float wave_sum(float v) {
#pragma unroll
    for (int o = 1; o < 64; o <<= 1) v += __shfl_xor(v, o);
    return v;
}
__device__ __forceinline__ float silu_f(float v) { return v * __builtin_amdgcn_rcpf(1.f + __expf(-v)); }
#define LDS_WAIT() asm volatile("s_waitcnt lgkmcnt(0)" ::: "memory")

struct EpiStore {
    static constexpr bool PERM = true, AFTER_DRAIN = false;
    bf16_t* O; int ldc;
    __device__ __forceinline__ void operator()(const f32x4 (&acc)[2][2][4][2], const pg8::Unit& u, int wr, int wc, int fr, int fq) const {
        const int row0 = u.pm * 256 + wr * 64 + fr, col0 = u.pn * 256 + wc * 32 + 8 * fq;
#pragma unroll
        for (int ai = 0; ai < 2; ++ai)
#pragma unroll
            for (int m = 0; m < 4; ++m) { bf16_t* rowp = O + (size_t)(row0 + ai * 128 + m * 16) * ldc + col0;
#pragma unroll
                for (int bj = 0; bj < 2; ++bj) { const f32x4 v0 = acc[ai][bj][m][0], v1 = acc[ai][bj][m][1];
                    u32x4 w; w.x = pk2(v0[0], v0[1]); w.y = pk2(v0[2], v0[3]); w.z = pk2(v1[0], v1[1]); w.w = pk2(v1[2], v1[3]);
                    *(u32x4*)(rowp + bj * 128) = w; } }
    }
};
struct EpiResid {
    static constexpr bool PERM = true, AFTER_DRAIN = false;
    const float* rin_l; const float* rin_c; float* rout_l; float* rout_c; const float* gate; int rowbase;
    __device__ __forceinline__ void operator()(const f32x4 (&acc)[2][2][4][2], const pg8::Unit& u, int wr, int wc, int fr, int fq) const {
#pragma unroll
        for (int ai = 0; ai < 2; ++ai)
#pragma unroll
            for (int m = 0; m < 4; ++m) {
                const int R = rowbase + u.pm * 256 + ai * 128 + wr * 64 + m * 16 + fr;
                const bool islat = R < TL; const int mrow = islat ? (R >> 13) : 8;
                const float* src = islat ? rin_l + (size_t)R * DM : rin_c + (size_t)(R - TL) * DM;
                float* dst = islat ? rout_l + (size_t)R * DM : rout_c + (size_t)(R - TL) * DM;
                const float* gp = gate + (size_t)mrow * MODW;
#pragma unroll
                for (int bj = 0; bj < 2; ++bj)
#pragma unroll
                    for (int n = 0; n < 2; ++n) { const int c = u.pn * 256 + bj * 128 + wc * 32 + 8 * fq + 4 * n;
                        const f32x4 g4 = *(const f32x4*)(gp + c), x4 = *(const f32x4*)(src + c);
                        *(f32x4*)(dst + c) = x4 + g4 * acc[ai][bj][m][n]; } }
    }
};

struct EpiStoreN {
    static constexpr bool PERM = true, AFTER_DRAIN = false;
    bf16_t* O; int ldc; const float* stat; const float* bias; int rowbase;
    __device__ __forceinline__ void operator()(const f32x4 (&acc)[2][2][4][2], const pg8::Unit& u, int wr, int wc, int fr, int fq) const {
        const int row0 = u.pm * 256 + wr * 64 + fr, col0 = u.pn * 256 + wc * 32 + 8 * fq;
        const int Rt = rowbase + u.pm * 256;
        const float* bp = bias + (size_t)(Rt < TL ? (Rt >> 13) : 8) * FF2 + col0;
        f32x4 bv[2][2];
#pragma unroll
        for (int bj = 0; bj < 2; ++bj) { bv[bj][0] = *(const f32x4*)(bp + bj * 128); bv[bj][1] = *(const f32x4*)(bp + bj * 128 + 4); }
#pragma unroll
        for (int ai = 0; ai < 2; ++ai)
#pragma unroll
            for (int m = 0; m < 4; ++m) { const int r = row0 + ai * 128 + m * 16, Rg = rowbase + r;
                const f32x4 q = *(const f32x4*)(stat + (size_t)Rg * 16 + fq * 4);
                float ssq = (q[0] + q[1]) + (q[2] + q[3]); ssq += __shfl_xor(ssq, 16); ssq += __shfl_xor(ssq, 32);
                const float rstd = rsqrtf(ssq * (1.f / DM) + 1e-6f);
                bf16_t* rowp = O + (size_t)r * ldc + col0;
#pragma unroll
                for (int bj = 0; bj < 2; ++bj) { const f32x4 v0 = acc[ai][bj][m][0] * rstd + bv[bj][0], v1 = acc[ai][bj][m][1] * rstd + bv[bj][1];
                    u32x4 w; w.x = pk2(v0[0], v0[1]); w.y = pk2(v0[2], v0[3]); w.z = pk2(v1[0], v1[1]); w.w = pk2(v1[2], v1[3]);
                    *(u32x4*)(rowp + bj * 128) = w; } }
    }
};
struct EpiResidN {
    static constexpr bool PERM = true, AFTER_DRAIN = false;
    const float* rin_l; const float* rin_c; float* rout_l; float* rout_c; const float* gate; int rowbase;
    bf16_t* Hn; const float* gs; float* stat;
    __device__ __forceinline__ void operator()(const f32x4 (&acc)[2][2][4][2], const pg8::Unit& u, int wr, int wc, int fr, int fq) const {
        const int Rt = rowbase + u.pm * 256; const bool islat = Rt < TL; const int mrow = islat ? (Rt >> 13) : 8;
        const float* gp = gate + (size_t)mrow * MODW; const float* gsp = gs + (size_t)mrow * DM;
        f32x4 gv[2][2], sv[2][2];
#pragma unroll
        for (int bj = 0; bj < 2; ++bj) { const int c = u.pn * 256 + bj * 128 + wc * 32 + 8 * fq;
            gv[bj][0] = *(const f32x4*)(gp + c); gv[bj][1] = *(const f32x4*)(gp + c + 4); sv[bj][0] = *(const f32x4*)(gsp + c); sv[bj][1] = *(const f32x4*)(gsp + c + 4); }
#pragma unroll
        for (int ai = 0; ai < 2; ++ai)
#pragma unroll
            for (int m = 0; m < 4; ++m) {
                const int R = rowbase + u.pm * 256 + ai * 128 + wr * 64 + m * 16 + fr;
                const float* src = islat ? rin_l + (size_t)R * DM : rin_c + (size_t)(R - TL) * DM;
                float* dst = islat ? rout_l + (size_t)R * DM : rout_c + (size_t)(R - TL) * DM;
                float ss = 0.f;
#pragma unroll
                for (int bj = 0; bj < 2; ++bj) { const int c = u.pn * 256 + bj * 128 + wc * 32 + 8 * fq;
                    const f32x4 xa = *(const f32x4*)(src + c) + gv[bj][0] * acc[ai][bj][m][0];
                    const f32x4 xb = *(const f32x4*)(src + c + 4) + gv[bj][1] * acc[ai][bj][m][1];
                    *(f32x4*)(dst + c) = xa; *(f32x4*)(dst + c + 4) = xb;
                    ss += (xa[0] * xa[0] + xa[1] * xa[1]) + (xa[2] * xa[2] + xa[3] * xa[3]) + (xb[0] * xb[0] + xb[1] * xb[1]) + (xb[2] * xb[2] + xb[3] * xb[3]);
                    const f32x4 ya = xa * sv[bj][0], yb = xb * sv[bj][1];
                    u32x4 w; w.x = pk2(ya[0], ya[1]); w.y = pk2(ya[2], ya[3]); w.z = pk2(yb[0], yb[1]); w.w = pk2(yb[2], yb[3]);
                    *(u32x4*)(Hn + (size_t)R * DM + c) = w; }
                ss += __shfl_xor(ss, 16); ss += __shfl_xor(ss, 32);
                if (fq == 0) stat[(size_t)R * 16 + u.pn * 4 + wc] = ss;
            }
    }
};

__device__ __forceinline__ const void* uni_ptr(const void* q) { const unsigned long long a = (unsigned long long)q; const unsigned lo = __builtin_amdgcn_readfirstlane((unsigned)a), hi = __builtin_amdgcn_readfirstlane((unsigned)(a >> 32)); return (const void*)(((unsigned long long)hi << 32) | lo); }
template <class Epi>
__device__ __forceinline__ void run_gemm(unsigned char* smem, const bf16_t* A, const bf16_t* Bt, int M, int N, int K, const Epi& E, int crot = 0) {
    pg8::Gemm g; g.A = (const bf16_t*)uni_ptr(A); g.Bt = (const bf16_t*)uni_ptr(Bt); g.M = M; g.N = N; g.K = K;
    pg8::StaticOrder S; S.init(M, N, (int)gridDim.x, (int)((blockIdx.x + crot) % gridDim.x));
    pg8::gemm_phase<Epi, pg8::StaticOrder, true, true>((PG8_LAS unsigned char*)smem, g, S, E);
    __syncthreads();
}

__device__ __forceinline__ void ada_phase(ParamsK p, unsigned char* smem) {
    float* sc = (float*)smem;
    float* red = sc + 9 * 1024;
    const int tid = otid();
    const float* cvec = IN(1); const float* cctx = IN(3); const float* w_ada = IN(4); const float* b_ada = IN(5);
    float* mod = (float*)(WSP + WS_MOD);
    for (int i = tid; i < 9 * 1024; i += 512) { const int r = i >> 10, k = i & 1023; const float v = r < 8 ? cvec[r * 1024 + k] : cctx[k]; sc[i] = v / (1.f + expf(-v)); }
    __syncthreads();
    for (int task = blockIdx.x; task < DEPTH * 96; task += gridDim.x) {
        const int l = task / 96, cb = (task % 96) * 64, cl = tid & 63, ks = tid >> 6;
        const float* w = w_ada + (size_t)l * DM * MODW + cb + cl;
        float acc[9];
#pragma unroll
        for (int r = 0; r < 9; ++r) acc[r] = 0.f;
#pragma unroll 16
        for (int kk = 0; kk < 128; ++kk) { const int k = ks * 128 + kk; const float wv = w[(size_t)k * MODW];
#pragma unroll
            for (int r = 0; r < 9; ++r) acc[r] += sc[r * 1024 + k] * wv; }
#pragma unroll
        for (int r = 0; r < 9; ++r) red[(ks * 9 + r) * 64 + cl] = acc[r];
        __syncthreads();
        for (int o = tid; o < 576; o += 512) { const int r = o >> 6, cc = o & 63; float s = 0.f;
#pragma unroll
            for (int k8 = 0; k8 < 8; ++k8) s += red[(k8 * 9 + r) * 64 + cc];
            mod[(size_t)(l * 9 + r) * MODW + cb + cc] = s + b_ada[l * MODW + cb + cc]; }
        __syncthreads();
    }
}
__device__ __forceinline__ void transpose_item(const float* W, int K, int N, bf16_t* WT, float* scr, int item, int lane) {
    const int nblk = N / 32, kb = item / nblk, nb = item % nblk, k0 = 64 * kb, n0 = 32 * nb;
    float tv[32];
#pragma unroll
    for (int i = 0; i < 32; ++i) { const int kk = 2 * i + (lane >> 5); tv[i] = W[(size_t)(k0 + kk) * N + n0 + (lane & 31)]; }
#pragma unroll
    for (int i = 0; i < 32; ++i) { const int kk = 2 * i + (lane >> 5); scr[kk * 33 + (lane & 31)] = tv[i]; }
    LDS_WAIT();
    const int c = lane & 7;
#pragma unroll
    for (int j = 0; j < 4; ++j) { const int n = (lane >> 3) + 8 * j; const float* s = scr + (8 * c) * 33 + n;
        u32x4 o; o.x = pk2(s[0 * 33], s[1 * 33]); o.y = pk2(s[2 * 33], s[3 * 33]); o.z = pk2(s[4 * 33], s[5 * 33]); o.w = pk2(s[6 * 33], s[7 * 33]);
        *(u32x4*)(WT + (size_t)(n0 + n) * K + k0 + 8 * c) = o; }
    LDS_WAIT();
}
__device__ __forceinline__ void weights_phase(ParamsK p, unsigned char* smem) {
    const int tid = otid(), lane = tid & 63, wave = __builtin_amdgcn_readfirstlane(tid >> 6);
    float* scr = (float*)(smem + wave * 16384);
    const int gw = blockIdx.x * 8 + wave, NGW = gridDim.x * 8;
    constexpr int I_IN = 16 * (INW / 32), I_OUT = 16 * 32, I_UP = 16 * (FF2 / 32), I_DN = (FFN / 64) * 32, I_L = I_IN + I_OUT + I_UP + I_DN;
    for (int it = gw; it < DEPTH * I_L; it += NGW) {
        const int l = it / I_L; int r = it % I_L;
        if (r < I_IN) { transpose_item(IN(8) + (size_t)l * DM * INW, DM, INW, (bf16_t*)(WSP + WS_WIN) + (size_t)l * INP * DM, scr, r, lane); continue; } r -= I_IN;
        if (r < I_OUT) { transpose_item(IN(17) + (size_t)l * DM * DM, DM, DM, (bf16_t*)(WSP + WS_WOUT) + (size_t)l * DM * DM, scr, r, lane); continue; } r -= I_OUT;
        if (r < I_UP) { transpose_item(IN(18) + (size_t)l * DM * FF2, DM, FF2, (bf16_t*)(WSP + WS_WUP) + (size_t)l * FF2 * DM, scr, r, lane); continue; } r -= I_UP;
        transpose_item(IN(21) + (size_t)l * FFN * DM, FFN, DM, (bf16_t*)(WSP + WS_WDN) + (size_t)l * DM * FFN, scr, r, lane);
    }
    const int gt = blockIdx.x * 512 + tid, NGT = gridDim.x * 512;
    constexpr int PADV = (INP - INW) * DM / 8;
    for (int i = gt; i < DEPTH * PADV; i += NGT) { const int l = i / PADV, r = i % PADV;
        *(u32x4*)((bf16_t*)(WSP + WS_WIN) + (size_t)l * INP * DM + (size_t)INW * DM + (size_t)r * 8) = (u32x4){0u, 0u, 0u, 0u}; }
    float* rope = (float*)(WSP + WS_ROPE);
    for (int i = gt; i < SEQ * 16; i += NGT) { const int tok = i >> 4, j = i & 15, f = j & 7;
        const float invf = f == 0 ? 1.0f : f == 1 ? 0.31622776601683794f : f == 2 ? 0.1f : f == 3 ? 0.031622776601683794f : f == 4 ? 0.01f : f == 5 ? 0.0031622776601683794f : f == 6 ? 0.001f : 0.00031622776601683794f;
        const float pos = (float)(j < 8 ? (tok >> 6) : (tok & 63)); const float ang = pos * invf;
        const double a = (double)ang; const double kq = rint(a * 0.15915494309189535); const float rr = (float)(a - kq * 6.283185307179586);
        rope[tok * 32 + j] = cosf(rr); rope[tok * 32 + 16 + j] = sinf(rr); }
}

__device__ __forceinline__ void norm_phase(const float* xl, const float* xc, const float* g, const float* shift, const float* scale, bf16_t* H, int nrows) {
    const int tid = otid(), lane = tid & 63, wave = __builtin_amdgcn_readfirstlane(tid >> 6);
    const int gw = blockIdx.x * 8 + wave, NGW = gridDim.x * 8;
    for (int row0 = gw; row0 < nrows; row0 += 2 * NGW) {
        const int row1 = row0 + NGW; const bool has1 = row1 < nrows; const int rowb = has1 ? row1 : row0;
        const float* srcA = row0 < TL ? xl + (size_t)row0 * DM : xc + (size_t)(row0 - TL) * DM;
        const float* srcB = rowb < TL ? xl + (size_t)rowb * DM : xc + (size_t)(rowb - TL) * DM;
        f32x4 va[4], vb[4]; float sa = 0.f, sb = 0.f;
#pragma unroll
        for (int j = 0; j < 4; ++j) { va[j] = *(const f32x4*)(srcA + lane * 4 + 256 * j); vb[j] = *(const f32x4*)(srcB + lane * 4 + 256 * j); }
#pragma unroll
        for (int j = 0; j < 4; ++j) { sa += (va[j][0] * va[j][0] + va[j][1] * va[j][1]) + (va[j][2] * va[j][2] + va[j][3] * va[j][3]);
            sb += (vb[j][0] * vb[j][0] + vb[j][1] * vb[j][1]) + (vb[j][2] * vb[j][2] + vb[j][3] * vb[j][3]); }
#pragma unroll
        for (int o = 1; o < 64; o <<= 1) { sa += __shfl_xor(sa, o); sb += __shfl_xor(sb, o); }
        const float rstdA = rsqrtf(sa * (1.f / DM) + 1e-6f), rstdB = rsqrtf(sb * (1.f / DM) + 1e-6f);
        const int mA = row0 < TL ? (row0 >> 13) : 8, mB = rowb < TL ? (rowb >> 13) : 8;
#pragma unroll
        for (int j = 0; j < 4; ++j) { const int c = lane * 4 + 256 * j;
            const f32x4 g4 = *(const f32x4*)(g + c);
            { const f32x4 s4 = *(const f32x4*)(scale + (size_t)mA * MODW + c), h4 = *(const f32x4*)(shift + (size_t)mA * MODW + c);
              const f32x4 y = (va[j] * rstdA * g4) * (s4 + 1.f) + h4;
              u32x2 w; w.x = pk2(y[0], y[1]); w.y = pk2(y[2], y[3]); *(u32x2*)(H + (size_t)row0 * DM + c) = w; }
            if (has1) { const f32x4 s4 = *(const f32x4*)(scale + (size_t)mB * MODW + c), h4 = *(const f32x4*)(shift + (size_t)mB * MODW + c);
              const f32x4 y = (vb[j] * rstdB * g4) * (s4 + 1.f) + h4;
              u32x2 w; w.x = pk2(y[0], y[1]); w.y = pk2(y[2], y[3]); *(u32x2*)(H + (size_t)row1 * DM + c) = w; }
        }
    }
}
__device__ __forceinline__ void final_norm_phase(float* x, const float* g) {
    const int tid = otid(), lane = tid & 63, wave = __builtin_amdgcn_readfirstlane(tid >> 6);
    const int gw = blockIdx.x * 8 + wave, NGW = gridDim.x * 8;
    for (int row = gw; row < TL; row += NGW) {
        float* src = x + (size_t)row * DM;
        f32x4 v[4]; float ss = 0.f;
#pragma unroll
        for (int j = 0; j < 4; ++j) { v[j] = *(const f32x4*)(src + lane * 4 + 256 * j); ss += (v[j][0] * v[j][0] + v[j][1] * v[j][1]) + (v[j][2] * v[j][2] + v[j][3] * v[j][3]); }
        const float rstd = rsqrtf(wave_sum(ss) * (1.f / DM) + 1e-6f);
#pragma unroll
        for (int j = 0; j < 4; ++j) { const int c = lane * 4 + 256 * j; const f32x4 g4 = *(const f32x4*)(g + c); *(f32x4*)(src + c) = v[j] * rstd * g4; }
    }
}

typedef short bf16x4 __attribute__((ext_vector_type(4)));
constexpr int GS = 36;
__device__ __forceinline__ bf16x4 as_bf16x4(u32x2 w) { union { u32x2 u; bf16x4 b; } c; c.u = w; return c.b; }
__device__ __forceinline__ bf16x8 as_bf16x8(u32x4 w) { union { u32x4 u; bf16x8 b; } c; c.u = w; return c.b; }
__device__ __forceinline__ void unpack8(const u32x4 w, float (&f)[8]) {
#pragma unroll
    for (int i = 0; i < 4; ++i) { f[2 * i] = bflo(w[i]); f[2 * i + 1] = bfhi(w[i]); }
}
struct GlaRaw { u32x4 kraw, qraw; f32x4 cs, sn; u32x2 graw; };
template <bool NEEDQ>
__device__ __forceinline__ void gla_stage_load(const bf16_t* U, const float* rope, int row0, int tpos0, int h, int dir, int lane, GlaRaw& R) {
    const int tok = lane >> 2, qr = lane & 3;
    const bf16_t* ur = U + (size_t)(row0 + tok) * INP + h * 32 + qr * 8;
    R.kraw = *(const u32x4*)(ur + K0);
    if (NEEDQ) R.qraw = *(const u32x4*)(ur + Q0);
    if (tpos0 >= 0) { const float* rp = rope + (size_t)(tpos0 + tok) * 32 + qr * 4; R.cs = *(const f32x4*)rp; R.sn = *(const f32x4*)(rp + 16); }
    R.graw = *(const u32x2*)(U + (size_t)(row0 + tok) * INP + (dir ? GB0 : GF0) + qr * 4);
}
template <bool NEEDQ>
__device__ __forceinline__ void gla_stage16(const GlaRaw& R, float* qs, float* ks, float* Bs, float* Be, int tpos0, int dir, const float (&wg)[16], float bgk, int lane) {
    {
        const int tok = lane >> 2, qr = lane & 3;
        float kk[8], qq[8];
        unpack8(R.kraw, kk);
        if (NEEDQ) { unpack8(R.qraw, qq);
#pragma unroll
            for (int i = 0; i < 8; ++i) qq[i] *= 0.17677669529663687f; }
        if (tpos0 >= 0) { const f32x4 cs = R.cs, sn = R.sn;
#pragma unroll
            for (int i = 0; i < 4; ++i) { const float a = kk[2 * i] * cs[i] - kk[2 * i + 1] * sn[i], b2 = kk[2 * i] * sn[i] + kk[2 * i + 1] * cs[i]; kk[2 * i] = a; kk[2 * i + 1] = b2;
                if (NEEDQ) { const float c2 = qq[2 * i] * cs[i] - qq[2 * i + 1] * sn[i], d2 = qq[2 * i] * sn[i] + qq[2 * i + 1] * cs[i]; qq[2 * i] = c2; qq[2 * i + 1] = d2; } } }
        *(f32x4*)(ks + tok * GS + qr * 8) = (f32x4){kk[0], kk[1], kk[2], kk[3]}; *(f32x4*)(ks + tok * GS + qr * 8 + 4) = (f32x4){kk[4], kk[5], kk[6], kk[7]};
        if (NEEDQ) { *(f32x4*)(qs + tok * GS + qr * 8) = (f32x4){qq[0], qq[1], qq[2], qq[3]}; *(f32x4*)(qs + tok * GS + qr * 8 + 4) = (f32x4){qq[4], qq[5], qq[6], qq[7]}; }
    }
    bf16_t* Gs = (bf16_t*)(Be + 64);
    *(u32x2*)(Gs + lane * 4) = R.graw;
    LDS_WAIT();
    {
        const int k = lane & 31, hf = lane >> 5;
        float g[8];
#pragma unroll
        for (int i = 0; i < 8; ++i) {
            const u32x4 ga = *(const u32x4*)(Gs + (hf * 8 + i) * 16), gb = *(const u32x4*)(Gs + (hf * 8 + i) * 16 + 8);
            float x = bgk;
#pragma unroll
            for (int j = 0; j < 4; ++j) { x += bflo(ga[j]) * wg[2 * j] + bfhi(ga[j]) * wg[2 * j + 1]; }
#pragma unroll
            for (int j = 0; j < 4; ++j) { x += bflo(gb[j]) * wg[8 + 2 * j] + bfhi(gb[j]) * wg[8 + 2 * j + 1]; }
            g[i] = (fminf(x, 0.f) - __logf(1.f + __expf(-fabsf(x)))) * 0.0625f;
        }
        if (dir == 0) {
#pragma unroll
            for (int i = 1; i < 8; ++i) g[i] += g[i - 1];
            const float other = __shfl_xor(g[7], 32);
            if (hf == 1) {
#pragma unroll
                for (int i = 0; i < 8; ++i) g[i] += other;
                Be[k] = g[7]; }
        } else {
#pragma unroll
            for (int i = 6; i >= 0; --i) g[i] += g[i + 1];
            const float other = __shfl_xor(g[0], 32);
            if (hf == 0) {
#pragma unroll
                for (int i = 0; i < 8; ++i) g[i] += other;
                Be[k] = g[0]; }
        }
#pragma unroll
        for (int i = 0; i < 8; ++i) Bs[(hf * 8 + i) * GS + k] = g[i];
    }
    LDS_WAIT();
}
__device__ __forceinline__ void gla_load_gatew(ParamsK p, int l, int h, int dir, int lane, float (&wg)[16], float& bgk) {
    const int k = lane & 31;
    const float* w = (dir ? IN(11) : IN(9)) + (size_t)l * 16 * 192 + h * 32 + k;
#pragma unroll
    for (int i = 0; i < 16; ++i) wg[i] = w[i * 192];
    bgk = ((dir ? IN(12) : IN(10)) + (size_t)l * 192 + h * 32)[k];
}
__device__ __forceinline__ void gla_task(int task, int& bh, int& b, int& h, int& tc, int& rowb, int& vtb, int& tpb) {
    tc = task % NCH; bh = task / NCH; h = bh % 6; b = bh / 6;
    if (tc < 4) { rowb = TL + b * CTXL + tc * 64; vtb = SEQ + tc * 64; tpb = -1; }
    else { rowb = b * SEQ + (tc - 4) * 64; vtb = (tc - 4) * 64; tpb = (tc - 4) * 64; }
}
__device__ __forceinline__ void gla_state_ops(const float* ks, const float* Bs, const float* Be, int fr, int fq, bf16x4 (&ke)[2], f32x4 (&dec)[2]) {
#pragma unroll
    for (int kb = 0; kb < 2; ++kb) { const int kidx = kb * 16 + fr; const float be = Be[kidx]; float e[4];
#pragma unroll
        for (int j = 0; j < 4; ++j) e[j] = ks[(fq * 4 + j) * GS + kidx] * __expf(be - Bs[(fq * 4 + j) * GS + kidx]);
        u32x2 w; w.x = pk2(e[0], e[1]); w.y = pk2(e[2], e[3]); ke[kb] = as_bf16x4(w);
        const f32x4 bv = *(const f32x4*)(Be + kb * 16 + fq * 4);
        dec[kb] = (f32x4){__expf(bv[0]), __expf(bv[1]), __expf(bv[2]), __expf(bv[3])}; }
}
__device__ __forceinline__ void gla_step1(ParamsK p, int l, unsigned char* smem) {
    const int tid = otid(), lane = tid & 63, wave = __builtin_amdgcn_readfirstlane(tid >> 6), fr = lane & 15, fq = lane >> 4;
    float* qs = (float*)(smem + wave * 16384); float* ks = qs + 16 * GS; float* Bs = ks + 16 * GS; float* Be = Bs + 16 * GS;
    const bf16_t* U = (const bf16_t*)(WSP + WS_U); const float* rope = (const float*)(WSP + WS_ROPE); const bf16_t* VTG = (const bf16_t*)(WSP + WS_VTG);
    float* SL = (float*)(WSP + WS_SL); float* DEC = (float*)(WSP + WS_DEC);
    const int gw = wave * gridDim.x + blockIdx.x, NGW = gridDim.x * 8;
    for (int task = gw; task < 48 * NCH; task += NGW) {
        int bh, b, h, tc, rowb, vtb, tpb; gla_task(task, bh, b, h, tc, rowb, vtb, tpb);
        for (int dir = 0; dir < 2; ++dir) {
            const int c = dir == 0 ? tc : (tc < 4 ? 3 - tc : 135 - tc);
            float wg[16], bgk; gla_load_gatew(p, l, h, dir, lane, wg, bgk);
            f32x4 S[2][4];
#pragma unroll
            for (int kb = 0; kb < 2; ++kb)
#pragma unroll
                for (int db = 0; db < 4; ++db) S[kb][db] = (f32x4){0.f, 0.f, 0.f, 0.f};
            float bsum = 0.f;
            GlaRaw raw; { const int sc0 = dir ? 3 : 0; gla_stage_load<false>(U, rope, rowb + sc0 * 16, tpb < 0 ? -1 : tpb + sc0 * 16, h, dir, lane, raw); }
            for (int si = 0; si < 4; ++si) {
                const int sc = dir ? 3 - si : si;
                bf16x4 vt[4];
#pragma unroll
                for (int db = 0; db < 4; ++db) vt[db] = as_bf16x4(*(const u32x2*)(VTG + (size_t)(bh * 64 + db * 16 + fr) * VTW + vtb + sc * 16 + fq * 4));
                gla_stage16<false>(raw, qs, ks, Bs, Be, tpb, dir, wg, bgk, lane);
                if (si < 3) { const int scn = dir ? 2 - si : si + 1; gla_stage_load<false>(U, rope, rowb + scn * 16, tpb < 0 ? -1 : tpb + scn * 16, h, dir, lane, raw); }
                bf16x4 ke[2]; f32x4 dec[2]; gla_state_ops(ks, Bs, Be, fr, fq, ke, dec);
                bsum += Be[lane & 31];
#pragma unroll
                for (int kb = 0; kb < 2; ++kb)
#pragma unroll
                    for (int db = 0; db < 4; ++db) S[kb][db] = __builtin_amdgcn_mfma_f32_16x16x16bf16_1k(ke[kb], vt[db], S[kb][db] * dec[kb], 0, 0, 0);
                LDS_WAIT();
            }
            float* so = SL + ((size_t)(bh * 2 + dir) * NCH + c) * 2048;
#pragma unroll
            for (int kb = 0; kb < 2; ++kb)
#pragma unroll
                for (int db = 0; db < 4; ++db)
#pragma unroll
                    for (int j = 0; j < 4; ++j) so[(kb * 16 + fq * 4 + j) * 64 + db * 16 + fr] = S[kb][db][j];
            if (lane < 32) DEC[((size_t)(bh * 2 + dir) * NCH + c) * 32 + lane] = __expf(bsum);
        }
    }
}
__device__ __forceinline__ void gla_step2(ParamsK p) {
    float* SL = (float*)(WSP + WS_SL); const float* DEC = (const float*)(WSP + WS_DEC);
    const int gt = blockIdx.x * 512 + otid(), NGT = gridDim.x * 512;
    for (int e = gt; e < 96 * 2048; e += NGT) {
        const int bhd = e >> 11, kd = e & 2047, k = kd >> 6;
        float* sp = SL + (size_t)bhd * NCH * 2048 + kd; const float* dp = DEC + (size_t)bhd * NCH * 32 + k;
        float s = 0.f;
        for (int c0 = 0; c0 < NCH; c0 += 12) {
            float loc[12], dd[12];
#pragma unroll
            for (int j = 0; j < 12; ++j) { loc[j] = sp[(size_t)(c0 + j) * 2048]; dd[j] = dp[(c0 + j) * 32]; }
#pragma unroll
            for (int j = 0; j < 12; ++j) { sp[(size_t)(c0 + j) * 2048] = s; s = dd[j] * s + loc[j]; }
        }
    }
}
__device__ __forceinline__ void gla_step3(ParamsK p, int l, unsigned char* smem) {
    const int tid = otid(), lane = tid & 63, wave = __builtin_amdgcn_readfirstlane(tid >> 6), fr = lane & 15, fq = lane >> 4;
    float* qs = (float*)(smem + wave * 16384); float* ks = qs + 16 * GS; float* Bs = ks + 16 * GS; float* Be = Bs + 16 * GS;
    const bf16_t* U = (const bf16_t*)(WSP + WS_U); const float* rope = (const float*)(WSP + WS_ROPE); const bf16_t* VTG = (const bf16_t*)(WSP + WS_VTG);
    const float* SL = (const float*)(WSP + WS_SL); float* OG = (float*)(WSP + WS_OG);
    bf16_t* MIX = (bf16_t*)(WSP + WS_H);
    const float* ngp = IN(13) + l * 64;
    const int gw = wave * gridDim.x + blockIdx.x, NGW = gridDim.x * 8;
    for (int task = gw; task < 48 * NCH; task += NGW) {
        int bh, b, h, tc, rowb, vtb, tpb; gla_task(task, bh, b, h, tc, rowb, vtb, tpb);
        for (int dir = 0; dir < 2; ++dir) {
            const int c = dir == 0 ? tc : (tc < 4 ? 3 - tc : 135 - tc);
            float wg[16], bgk; gla_load_gatew(p, l, h, dir, lane, wg, bgk);
            f32x4 S[2][4];
            const float* si_ = SL + ((size_t)(bh * 2 + dir) * NCH + c) * 2048;
#pragma unroll
            for (int kb = 0; kb < 2; ++kb)
#pragma unroll
                for (int db = 0; db < 4; ++db)
#pragma unroll
                    for (int j = 0; j < 4; ++j) S[kb][db][j] = si_[(kb * 16 + fq * 4 + j) * 64 + db * 16 + fr];
            GlaRaw raw; { const int sc0 = dir ? 3 : 0; gla_stage_load<true>(U, rope, rowb + sc0 * 16, tpb < 0 ? -1 : tpb + sc0 * 16, h, dir, lane, raw); }
            for (int si = 0; si < 4; ++si) {
                const int sc = dir ? 3 - si : si;
                const int row = rowb + sc * 16 + fr;
                bf16x4 vt[4];
#pragma unroll
                for (int db = 0; db < 4; ++db) vt[db] = as_bf16x4(*(const u32x2*)(VTG + (size_t)(bh * 64 + db * 16 + fr) * VTW + vtb + sc * 16 + fq * 4));
                f32x4 og[4]; u32x2 rgw[4];
                if (dir == 1) {
#pragma unroll
                    for (int db = 0; db < 4; ++db) { og[db] = *(const f32x4*)(OG + (size_t)row * 384 + h * 64 + db * 16 + fq * 4);
                        rgw[db] = *(const u32x2*)(U + (size_t)row * INP + R0 + h * 64 + db * 16 + fq * 4); }
                }
                gla_stage16<true>(raw, qs, ks, Bs, Be, tpb, dir, wg, bgk, lane);
                if (si < 3) { const int scn = dir ? 2 - si : si + 1; gla_stage_load<true>(U, rope, rowb + scn * 16, tpb < 0 ? -1 : tpb + scn * 16, h, dir, lane, raw); }
                const f32x4 ba = *(const f32x4*)(Bs + fr * GS + fq * 4), bb = *(const f32x4*)(Bs + fr * GS + 16 + fq * 4);
                const f32x4 qa = *(const f32x4*)(qs + fr * GS + fq * 4), qb = *(const f32x4*)(qs + fr * GS + 16 + fq * 4);
                const f32x4 ka = *(const f32x4*)(ks + fr * GS + fq * 4), kc = *(const f32x4*)(ks + fr * GS + 16 + fq * 4);
                u32x4 qw, kw;
                qw.x = pk2(qa[0] * __expf(ba[0]), qa[1] * __expf(ba[1])); qw.y = pk2(qa[2] * __expf(ba[2]), qa[3] * __expf(ba[3]));
                qw.z = pk2(qb[0] * __expf(bb[0]), qb[1] * __expf(bb[1])); qw.w = pk2(qb[2] * __expf(bb[2]), qb[3] * __expf(bb[3]));
                kw.x = pk2(ka[0] * __expf(-ba[0]), ka[1] * __expf(-ba[1])); kw.y = pk2(ka[2] * __expf(-ba[2]), ka[3] * __expf(-ba[3]));
                kw.z = pk2(kc[0] * __expf(-bb[0]), kc[1] * __expf(-bb[1])); kw.w = pk2(kc[2] * __expf(-bb[2]), kc[3] * __expf(-bb[3]));
                const bf16x8 Qd = as_bf16x8(qw), Kd = as_bf16x8(kw);
                bf16x4 ke[2]; f32x4 dec[2]; gla_state_ops(ks, Bs, Be, fr, fq, ke, dec);
                f32x4 AT = __builtin_amdgcn_mfma_f32_16x16x32_bf16(Kd, Qd, (f32x4){0.f, 0.f, 0.f, 0.f}, 0, 0, 0);
#pragma unroll
                for (int j = 0; j < 4; ++j) { const int pp = fq * 4 + j; const bool keep = dir == 0 ? (pp <= fr) : (pp >= fr); AT[j] = keep ? AT[j] : 0.f; }
                u32x2 aw; aw.x = pk2(AT[0], AT[1]); aw.y = pk2(AT[2], AT[3]);
                const bf16x4 atb = as_bf16x4(aw);
                f32x4 O[4];
#pragma unroll
                for (int db = 0; db < 4; ++db) {
                    const f32x4 Oa = __builtin_amdgcn_mfma_f32_16x16x16bf16_1k(vt[db], atb, (f32x4){0.f, 0.f, 0.f, 0.f}, 0, 0, 0);
                    u32x4 sw; sw.x = pk2(S[0][db][0], S[0][db][1]); sw.y = pk2(S[0][db][2], S[0][db][3]); sw.z = pk2(S[1][db][0], S[1][db][1]); sw.w = pk2(S[1][db][2], S[1][db][3]);
                    const f32x4 Ob = __builtin_amdgcn_mfma_f32_16x16x32_bf16(as_bf16x8(sw), Qd, (f32x4){0.f, 0.f, 0.f, 0.f}, 0, 0, 0);
                    O[db] = Oa + Ob;
                }
#pragma unroll
                for (int kb = 0; kb < 2; ++kb)
#pragma unroll
                    for (int db = 0; db < 4; ++db) S[kb][db] = __builtin_amdgcn_mfma_f32_16x16x16bf16_1k(ke[kb], vt[db], S[kb][db] * dec[kb], 0, 0, 0);
                if (dir == 0) {
#pragma unroll
                    for (int db = 0; db < 4; ++db) *(f32x4*)(OG + (size_t)row * 384 + h * 64 + db * 16 + fq * 4) = O[db];
                } else {
                    float ss = 0.f;
#pragma unroll
                    for (int db = 0; db < 4; ++db) { O[db] = O[db] + og[db]; ss += (O[db][0] * O[db][0] + O[db][1] * O[db][1]) + (O[db][2] * O[db][2] + O[db][3] * O[db][3]); }
                    ss += __shfl_xor(ss, 16); ss += __shfl_xor(ss, 32);
                    const float rstd = rsqrtf(ss * (1.f / 64.f) + 1e-6f);
#pragma unroll
                    for (int db = 0; db < 4; ++db) { const f32x4 n4 = *(const f32x4*)(ngp + db * 16 + fq * 4);
                        const float r0 = bflo(rgw[db].x), r1 = bfhi(rgw[db].x), r2 = bflo(rgw[db].y), r3 = bfhi(rgw[db].y);
                        u32x2 w; w.x = pk2(O[db][0] * rstd * n4[0] * silu_f(r0), O[db][1] * rstd * n4[1] * silu_f(r1));
                        w.y = pk2(O[db][2] * rstd * n4[2] * silu_f(r2), O[db][3] * rstd * n4[3] * silu_f(r3));
                        *(u32x2*)(MIX + (size_t)row * DM + h * 64 + db * 16 + fq * 4) = w; }
                }
                LDS_WAIT();
            }
        }
    }
}

__device__ __forceinline__ void prep_phase(ParamsK p) {
    const float* mod = (const float*)(WSP + WS_MOD); float* GSV = (float*)(WSP + WS_GSV); float* BIAS = (float*)(WSP + WS_BIAS);
    const int gt = blockIdx.x * 512 + otid(), NGT = gridDim.x * 512;
    for (int i = gt; i < DEPTH * 2 * 9 * DM; i += NGT) { const int c = i & (DM - 1), r = (i >> 10) % 9, w = (i / (9 * DM)) & 1, l = i / (18 * DM);
        const float g = (w ? IN(7) : IN(6))[l * DM + c], sc = mod[(size_t)(l * 9 + r) * MODW + (w ? 4 : 1) * DM + c];
        GSV[i] = g * (1.f + sc); }
    constexpr int NCOL = INP + FF2;
    for (int t = gt; t < DEPTH * NCOL; t += NGT) { const int l = t / NCOL, cc = t % NCOL, w = cc >= INP, n = w ? cc - INP : cc;
        const bf16_t* wrow = w ? (const bf16_t*)(WSP + WS_WUP) + ((size_t)l * FF2 + n) * DM : (const bf16_t*)(WSP + WS_WIN) + ((size_t)l * INP + n) * DM;
        const float* sh = mod + (size_t)l * 9 * MODW + (w ? 3 : 0) * DM;
        float acc[9];
#pragma unroll
        for (int r = 0; r < 9; ++r) acc[r] = 0.f;
        for (int k = 0; k < DM; k += 8) { float wv[8]; unpack8(*(const u32x4*)(wrow + k), wv);
#pragma unroll
            for (int r = 0; r < 9; ++r) { const f32x4 s0 = *(const f32x4*)(sh + (size_t)r * MODW + k), s1 = *(const f32x4*)(sh + (size_t)r * MODW + k + 4);
                acc[r] += (s0[0] * wv[0] + s0[1] * wv[1]) + (s0[2] * wv[2] + s0[3] * wv[3]) + (s1[0] * wv[4] + s1[1] * wv[5]) + (s1[2] * wv[6] + s1[3] * wv[7]); } }
#pragma unroll
        for (int r = 0; r < 9; ++r) BIAS[((size_t)(l * 2 + w) * 9 + r) * FF2 + n] = acc[r]; }
}
__device__ __forceinline__ void stat_zero_phase(ParamsK p) {
    float* STAT = (float*)(WSP + WS_STAT);
    const int gt = blockIdx.x * 512 + otid(), NGT = gridDim.x * 512;
    for (int i = gt; i < 2 * TT; i += NGT) STAT[i] = 0.f;
}

__device__ __forceinline__ void shortconv_phase(ParamsK p, int l) {
    const bf16_t* U = (const bf16_t*)(WSP + WS_U); bf16_t* MIX = (bf16_t*)(WSP + WS_H);
    const float* cw = IN(14) + (size_t)l * 3 * 256; const float* cbias = IN(15) + (size_t)l * 256;
    const int gt = blockIdx.x * 512 + otid(), NGT = gridDim.x * 512;
    for (int task = gt; task < TT * 32; task += NGT) {
        const int R = task >> 5, c = (task & 31) * 8;
        int pos, L; if (R < TL) { pos = R & (SEQ - 1); L = SEQ; } else { pos = (R - TL) & (CTXL - 1); L = CTXL; }
        const bf16_t* ur = U + (size_t)R * INP;
        float bgt[8], cc[8], xx[8], acc[8];
        unpack8(*(const u32x4*)(ur + SB0 + c), bgt);
        unpack8(*(const u32x4*)(ur + SC0 + c), cc); unpack8(*(const u32x4*)(ur + SX0 + c), xx);
#pragma unroll
        for (int i = 0; i < 8; ++i) acc[i] = cbias[c + i] + cw[256 + c + i] * (cc[i] * xx[i]);
        if (pos > 0) { unpack8(*(const u32x4*)(ur - INP + SC0 + c), cc); unpack8(*(const u32x4*)(ur - INP + SX0 + c), xx);
#pragma unroll
            for (int i = 0; i < 8; ++i) acc[i] += cw[c + i] * (cc[i] * xx[i]); }
        if (pos < L - 1) { unpack8(*(const u32x4*)(ur + INP + SC0 + c), cc); unpack8(*(const u32x4*)(ur + INP + SX0 + c), xx);
#pragma unroll
            for (int i = 0; i < 8; ++i) acc[i] += cw[512 + c + i] * (cc[i] * xx[i]); }
        u32x4 w; w.x = pk2(bgt[0] * acc[0], bgt[1] * acc[1]); w.y = pk2(bgt[2] * acc[2], bgt[3] * acc[3]); w.z = pk2(bgt[4] * acc[4], bgt[5] * acc[5]); w.w = pk2(bgt[6] * acc[6], bgt[7] * acc[7]);
        *(u32x4*)(MIX + (size_t)R * DM + 384 + c) = w;
    }
}

__device__ __forceinline__ void vt_phase(ParamsK p, unsigned char* smem) {
    const bf16_t* U = (const bf16_t*)(WSP + WS_U);
    bf16_t* tile = (bf16_t*)smem;
    constexpr int TS = 72, NITEM = (TT / 64) * 12;
    const int tid = otid();
    const int tok = tid >> 3, d8 = (tid & 7) * 8;
    auto src = [&](int item) { const int tt = item / 12, hs = item % 12; const int col0 = hs < 6 ? NV0 + hs * 64 : V0 + (hs - 6) * 64;
        return U + (size_t)(tt * 64 + tok) * INP + col0 + d8; };
    int item = blockIdx.x;
    u32x4 wn = (u32x4){0u, 0u, 0u, 0u};
    if (item < NITEM) wn = *(const u32x4*)src(item);
    for (; item < NITEM; item += gridDim.x) {
        const u32x4 w = wn;
        if (item + (int)gridDim.x < NITEM) wn = *(const u32x4*)src(item + gridDim.x);
        const int tt = item / 12, hs = item % 12, row0 = tt * 64;
        const int h = hs < 6 ? hs : hs - 6;
        bf16_t* VTx = (bf16_t*)(WSP + (hs < 6 ? WS_VT : WS_VTG));
        int b, sp0; if (row0 < TL) { b = row0 >> 13; sp0 = row0 & (SEQ - 1); } else { b = (row0 - TL) >> 8; sp0 = SEQ + ((row0 - TL) & (CTXL - 1)); }
#pragma unroll
        for (int i = 0; i < 4; ++i) { tile[(d8 + 2 * i) * TS + tok] = (bf16_t)(w[i] & 0xffffu); tile[(d8 + 2 * i + 1) * TS + tok] = (bf16_t)(w[i] >> 16); }
        __syncthreads();
        { const int d = tid >> 3, t8 = (tid & 7) * 8;
          const u32x4 o = *(const u32x4*)(tile + d * TS + t8);
          *(u32x4*)(VTx + (size_t)((b * 6 + h) * 64 + d) * VTW + sp0 + t8) = o; }
        __syncthreads();
    }
}

template <int MODE>
__device__ __forceinline__ void na_chunk(const bf16_t* U, const bf16_t* vt, const float* rpbL, const bf16_t* Kc, const bf16_t* Vc, int b, int r, int h, int rs, int kc0, int qcol, int cs,
                                         const bf16x8 bq0, const bf16x8 bq1, float& m_run, float& l_run, f32x4 (&O)[4], int fr, int fq) {
    f32x4 s[16];
    float mx = -1e30f;
#pragma unroll
    for (int kg = 0; kg < 4; ++kg) {
        bf16x8 ka0[4], ka1[4];
#pragma unroll
        for (int i = 0; i < 4; ++i) { const int kb = kg * 4 + i;
            if (MODE == 2) { const bf16_t* kp = Kc + (kb * 16 + fr) * 72 + fq * 8; ka0[i] = as_bf16x8(*(const u32x4*)kp); ka1[i] = as_bf16x8(*(const u32x4*)(kp + 32)); }
            else { const int krow = MODE == 0 ? (b * SEQ + (rs + (kb >> 1)) * 64 + kc0 + (kb & 1) * 16 + fr) : (TL + b * CTXL + kb * 16 + fr);
                const bf16_t* kp = U + (size_t)krow * INP + NK0 + h * 64 + fq * 8; ka0[i] = as_bf16x8(*(const u32x4*)kp); ka1[i] = as_bf16x8(*(const u32x4*)(kp + 32)); } }
        __builtin_amdgcn_sched_barrier(0);
#pragma unroll
        for (int i = 0; i < 4; ++i) { const int kb = kg * 4 + i;
            f32x4 acc = (f32x4){0.f, 0.f, 0.f, 0.f};
            acc = __builtin_amdgcn_mfma_f32_16x16x32_bf16(ka0[i], bq0, acc, 0, 0, 0);
            acc = __builtin_amdgcn_mfma_f32_16x16x32_bf16(ka1[i], bq1, acc, 0, 0, 0);
            acc = acc * 0.125f;
            if (MODE == 0) {
                const int dr = rs + (kb >> 1) - r + 7;
#pragma unroll
                for (int j = 0; j < 4; ++j) { const int kcol = kc0 + (kb & 1) * 16 + fq * 4 + j; const bool valid = (kcol >= cs) && (kcol < cs + 16);
                    const int dc = min(max(kcol - qcol + 15, 0), 30);
                    acc[j] = valid ? acc[j] + rpbL[(h * 15 + dr) * 31 + dc] : -1e30f; }
            }
            s[kb] = acc;
            mx = fmaxf(mx, fmaxf(fmaxf(acc[0], acc[1]), fmaxf(acc[2], acc[3])));
        }
        __builtin_amdgcn_sched_barrier(0);
    }
    mx = fmaxf(mx, __shfl_xor(mx, 16)); mx = fmaxf(mx, __shfl_xor(mx, 32));
    const float m_new = fmaxf(m_run, mx), alpha = __expf(m_run - m_new);
    float lsum = 0.f; unsigned pkd[16][2];
#pragma unroll
    for (int kb = 0; kb < 16; ++kb) { const float p0 = __expf(s[kb][0] - m_new), p1 = __expf(s[kb][1] - m_new), p2 = __expf(s[kb][2] - m_new), p3 = __expf(s[kb][3] - m_new);
        lsum += (p0 + p1) + (p2 + p3); pkd[kb][0] = pk2(p0, p1); pkd[kb][1] = pk2(p2, p3); }
    lsum += __shfl_xor(lsum, 16); lsum += __shfl_xor(lsum, 32);
    l_run = l_run * alpha + lsum; m_run = m_new;
#pragma unroll
    for (int db = 0; db < 4; ++db) O[db] = O[db] * alpha;
#pragma unroll
    for (int pg = 0; pg < 4; ++pg) {
        u32x2 vlo[2][4], vhi[2][4];
#pragma unroll
        for (int i = 0; i < 2; ++i) { const int pr = pg * 2 + i;
            const int posA = MODE == 0 ? ((rs + pr) * 64 + kc0 + fq * 4) : (SEQ + pr * 32 + fq * 4);
#pragma unroll
            for (int db = 0; db < 4; ++db) {
                if (MODE == 2) { const bf16_t* vp = Vc + (db * 16 + fr) * 264 + pr * 32 + fq * 4; vlo[i][db] = *(const u32x2*)vp; vhi[i][db] = *(const u32x2*)(vp + 16); }
                else { const bf16_t* vp = vt + (size_t)(db * 16) * VTW + posA; vlo[i][db] = *(const u32x2*)vp; vhi[i][db] = *(const u32x2*)(vp + 16); } } }
        __builtin_amdgcn_sched_barrier(0);
#pragma unroll
        for (int i = 0; i < 2; ++i) { const int pr = pg * 2 + i;
            u32x4 bw; bw.x = pkd[2 * pr][0]; bw.y = pkd[2 * pr][1]; bw.z = pkd[2 * pr + 1][0]; bw.w = pkd[2 * pr + 1][1];
            const bf16x8 bp = as_bf16x8(bw);
#pragma unroll
            for (int db = 0; db < 4; ++db) { u32x4 aw; aw.x = vlo[i][db].x; aw.y = vlo[i][db].y; aw.z = vhi[i][db].x; aw.w = vhi[i][db].y;
                O[db] = __builtin_amdgcn_mfma_f32_16x16x32_bf16(as_bf16x8(aw), bp, O[db], 0, 0, 0); } }
        __builtin_amdgcn_sched_barrier(0);
    }
}
template <bool CTXLDS>
__device__ __forceinline__ void na_tile(const bf16_t* U, const bf16_t* VT, bf16_t* MIX, const float* rpbL, const bf16_t* Kc, const bf16_t* Vc, bool lat, int b, int r, int c0, int qrow0, int h, int lane) {
    const int fr = lane & 15, fq = lane >> 4;
    const bf16_t* qp = U + (size_t)(qrow0 + fr) * INP + NQ0 + h * 64 + fq * 8;
    const bf16x8 bq0 = as_bf16x8(*(const u32x4*)qp), bq1 = as_bf16x8(*(const u32x4*)(qp + 32));
    float m_run = -1e30f, l_run = 0.f;
    f32x4 O[4];
#pragma unroll
    for (int db = 0; db < 4; ++db) O[db] = (f32x4){0.f, 0.f, 0.f, 0.f};
    const bf16_t* vt = VT + (size_t)((b * 6 + h) * 64 + fr) * VTW;
    const int rs = min(max(r - 4, 0), 120), kc0 = min(max(c0 - 8, 0), 32);
    const int qcol = c0 + fr, cs = min(max(qcol - 8, 0), 48);
    if (lat) na_chunk<0>(U, vt, rpbL, Kc, Vc, b, r, h, rs, kc0, qcol, cs, bq0, bq1, m_run, l_run, O, fr, fq);
    na_chunk<CTXLDS ? 2 : 1>(U, vt, rpbL, Kc, Vc, b, r, h, rs, kc0, qcol, cs, bq0, bq1, m_run, l_run, O, fr, fq);
    const float inv = 1.f / l_run;
    bf16_t* op = MIX + (size_t)(qrow0 + fr) * DM + 640 + h * 64 + fq * 4;
#pragma unroll
    for (int db = 0; db < 4; ++db) { u32x2 w; w.x = pk2(O[db][0] * inv, O[db][1] * inv); w.y = pk2(O[db][2] * inv, O[db][3] * inv); *(u32x2*)(op + db * 16) = w; }
}
__device__ __forceinline__ void na_phase(ParamsK p, int l, unsigned char* smem, bool with_ctx) {
    const int tid = otid(), lane = tid & 63, wave = __builtin_amdgcn_readfirstlane(tid >> 6);
    float* rpbL = (float*)smem;
    bf16_t* Kc = (bf16_t*)(smem + 12288);
    bf16_t* Vc = (bf16_t*)(smem + 12288 + 36864);
    const float* rpb = IN(16) + (size_t)l * 6 * 15 * 31;
    for (int i = tid; i < 6 * 15 * 31; i += 512) rpbL[i] = rpb[i];
    __syncthreads();
    const bf16_t* U = (const bf16_t*)(WSP + WS_U); const bf16_t* VT = (const bf16_t*)(WSP + WS_VT); bf16_t* MIX = (bf16_t*)(WSP + WS_H);
    const int b = blockIdx.x & 7, lw = (blockIdx.x >> 3) * 8 + wave, nlw = (gridDim.x >> 3) * 8;
    const int NL = (SEQ / 16) * 6, NC = with_ctx ? (CTXL / 16) * 6 : 0;
    if (nlw == 256) {
        for (int round = 0; round < NL / 256; ++round) {
            const int w = lw + 256 * round, cq = w & 3, rr = (w >> 2) & 1, h = (w >> 3) % 6, r = (w / 48) * 2 + rr;
            __syncthreads();
#pragma unroll
            for (int i = 0; i < 4; ++i) { const int idx = i * 512 + tid, key = idx >> 3, part = idx & 7;
                *(u32x4*)(Kc + key * 72 + part * 8) = *(const u32x4*)(U + (size_t)(TL + b * CTXL + key) * INP + NK0 + h * 64 + part * 8); }
#pragma unroll
            for (int i = 0; i < 4; ++i) { const int idx = i * 512 + tid, d = idx >> 5, part = idx & 31;
                *(u32x4*)(Vc + d * 264 + part * 8) = *(const u32x4*)(VT + (size_t)((b * 6 + h) * 64 + d) * VTW + SEQ + part * 8); }
            __syncthreads();
            na_tile<true>(U, VT, MIX, rpbL, Kc, Vc, true, b, r, cq * 16, b * SEQ + r * 64 + cq * 16, h, lane);
        }
        for (int w = NL + lw; w < NL + NC; w += nlw) { const int t2 = w - NL, h = t2 % 6, qt = t2 / 6;
            na_tile<false>(U, VT, MIX, rpbL, Kc, Vc, false, b, 0, 0, TL + b * CTXL + qt * 16, h, lane); }
    } else {
        for (int w = lw; w < NL + NC; w += nlw) {
            if (w < NL) { const int cq = w & 3, h = (w >> 2) % 6, r = w / 24;
                na_tile<false>(U, VT, MIX, rpbL, Kc, Vc, true, b, r, cq * 16, b * SEQ + r * 64 + cq * 16, h, lane); }
            else { const int t2 = w - NL, h = t2 % 6, qt = t2 / 6;
                na_tile<false>(U, VT, MIX, rpbL, Kc, Vc, false, b, 0, 0, TL + b * CTXL + qt * 16, h, lane); }
        }
    }
    __syncthreads();
}

__device__ __forceinline__ void convgate_phase(ParamsK p, int l, int hs, int nrows) {
    constexpr int CG_RUN = 96, CG_LA = 6, NCG = FFN / 8;
    const bf16_t* FU = (const bf16_t*)(WSP + WS_FU); bf16_t* ACT = (bf16_t*)(WSP + WS_ACT);
    const float* cw = IN(19) + (size_t)l * 3 * FF2; const float* cb = IN(20) + (size_t)l * FF2;
    const int gt = blockIdx.x * 512 + otid();
    const int cgi = gt % NCG, sl = gt / NCG, c = cgi * 8;
    const int r0 = sl * CG_RUN;
    if (r0 >= nrows) return;
    const int r1 = min(r0 + CG_RUN, nrows);
    float wa[3][8], wb[3][8], ba[8], bb[8];
#pragma unroll
    for (int j = 0; j < 3; ++j)
#pragma unroll
        for (int i = 0; i < 8; ++i) { wa[j][i] = cw[j * FF2 + c + i]; wb[j][i] = cw[j * FF2 + FFN + c + i]; }
#pragma unroll
    for (int i = 0; i < 8; ++i) { ba[i] = cb[c + i]; bb[i] = cb[FFN + c + i]; }
    const bf16_t* ub = FU + c;
    auto seqpos = [&](int lr, int& pos, int& L) { const int Rg = hs + lr; if (Rg < TL) { pos = Rg & (SEQ - 1); L = SEQ; } else { pos = (Rg - TL) & (CTXL - 1); L = CTXL; } };
    float pa[8], pb[8], ca[8], cbv[8];
    { int pos, L; seqpos(r0, pos, L);
      if (pos > 0) { unpack8(*(const u32x4*)(ub + (size_t)(r0 - 1) * FF2), pa); unpack8(*(const u32x4*)(ub + (size_t)(r0 - 1) * FF2 + FFN), pb); }
      else {
#pragma unroll
          for (int i = 0; i < 8; ++i) { pa[i] = 0.f; pb[i] = 0.f; } }
      unpack8(*(const u32x4*)(ub + (size_t)r0 * FF2), ca); unpack8(*(const u32x4*)(ub + (size_t)r0 * FF2 + FFN), cbv); }
    u32x4 ra[CG_LA], rb[CG_LA];
#pragma unroll
    for (int i = 0; i < CG_LA; ++i) { const int lr = min(r0 + 1 + i, nrows - 1); ra[i] = __builtin_nontemporal_load((const u32x4*)(ub + (size_t)lr * FF2)); rb[i] = __builtin_nontemporal_load((const u32x4*)(ub + (size_t)lr * FF2 + FFN)); }
    for (int t = r0; t < r1; t += CG_LA) {
#pragma unroll
        for (int i = 0; i < CG_LA; ++i) {
            const int row = t + i;
            const u32x4 xa = ra[i], xb = rb[i];
            { const int lr = min(row + 1 + CG_LA, nrows - 1); ra[i] = __builtin_nontemporal_load((const u32x4*)(ub + (size_t)lr * FF2)); rb[i] = __builtin_nontemporal_load((const u32x4*)(ub + (size_t)lr * FF2 + FFN)); }
            int pos, L; seqpos(row, pos, L);
            float na[8], nb[8];
            if (pos < L - 1 && row + 1 < nrows) { unpack8(xa, na); unpack8(xb, nb); }
            else {
#pragma unroll
                for (int k = 0; k < 8; ++k) { na[k] = 0.f; nb[k] = 0.f; } }
            if (row < r1) {
                float o[8];
#pragma unroll
                for (int k = 0; k < 8; ++k) { const float a = wa[0][k] * pa[k] + wa[1][k] * ca[k] + wa[2][k] * na[k] + ba[k];
                    const float g = wb[0][k] * pb[k] + wb[1][k] * cbv[k] + wb[2][k] * nb[k] + bb[k];
                    o[k] = silu_f(a) * g; }
                u32x4 w; w.x = pk2(o[0], o[1]); w.y = pk2(o[2], o[3]); w.z = pk2(o[4], o[5]); w.w = pk2(o[6], o[7]);
                *(u32x4*)(ACT + (size_t)row * FFN + c) = w;
            }
            const bool lastOfSeq = (pos == L - 1);
#pragma unroll
            for (int k = 0; k < 8; ++k) { pa[k] = lastOfSeq ? 0.f : ca[k]; pb[k] = lastOfSeq ? 0.f : cbv[k]; }
            if (lastOfSeq && row + 1 < nrows) { unpack8(xa, ca); unpack8(xb, cbv); }
            else {
#pragma unroll
                for (int k = 0; k < 8; ++k) { ca[k] = na[k]; cbv[k] = nb[k]; } }
        }
    }
}

__global__ void __launch_bounds__(512, 2) fwd_megakernel(Params p_unused) {
    extern __shared__ __attribute__((aligned(16))) unsigned char smem[];
    cg::grid_group grid = cg::this_grid();
    __shared__ uint4 xb_words;
    if (threadIdx.x == 0) xb_words = make_uint4(0u, 0u, 0u, 0u);
    __syncthreads();
    XcdBarrier xb; { ParamsK p = getpk(); xb = xcd_barrier_post((unsigned*)(WSP + WS_CTL), (volatile LAS unsigned*)&xb_words); }
    { ParamsK p = getpk(); ada_phase(p, smem); }
    { ParamsK p = getpk(); weights_phase(p, smem); }
    GSYNC_CG();
    { ParamsK p = getpk(); prep_phase(p); }
    for (int l = 0; l < DEPTH; ++l) {
        const bool upd = l < DEPTH - 1;
        const int Mout = upd ? TT : TL;
        if (l == 0) {
            { ParamsK p = getpk(); const float* ml = (const float*)(WSP + WS_MOD);
              norm_phase(IN(0), IN(2), IN(6), ml, ml + DM, (bf16_t*)(WSP + WS_H), TT); }
            GSYNC();
            { ParamsK p = getpk(); EpiStore E; E.O = (bf16_t*)(WSP + WS_U); E.ldc = INP;
              run_gemm(smem, (const bf16_t*)(WSP + WS_H), (const bf16_t*)(WSP + WS_WIN), TT, INP, DM, E); }
        } else {
            ParamsK p = getpk(); EpiStoreN E; E.O = (bf16_t*)(WSP + WS_U) + (size_t)HALF0 * INP; E.ldc = INP; E.stat = (const float*)(WSP + WS_STAT); E.bias = (const float*)(WSP + WS_BIAS) + (size_t)(l * 2) * 9 * FF2; E.rowbase = HALF0;
            run_gemm(smem, (const bf16_t*)(WSP + WS_H) + (size_t)HALF0 * DM, (const bf16_t*)(WSP + WS_WIN) + (size_t)l * INP * DM, TT - HALF0, INP, DM, E);
        }
        GSYNC();
        for (int rep = 0; rep < REP_VT; ++rep) { ParamsK p = getpk(); vt_phase(p, smem); }
        { ParamsK p = getpk(); shortconv_phase(p, l); }
        GSYNC();
        for (int rep = 0; rep < REP_GLA; ++rep) { ParamsK p = getpk(); gla_step1(p, l, smem); }
        __syncthreads();
        for (int rep = 0; rep < REP_NA; ++rep) { ParamsK p = getpk(); na_phase(p, l, smem, upd); }
        GSYNC();
        { ParamsK p = getpk(); gla_step2(p); }
        GSYNC();
        for (int rep = 0; rep < REP_GLA; ++rep) { ParamsK p = getpk(); gla_step3(p, l, smem); }
        GSYNC();
        { ParamsK p = getpk(); const float* ml = (const float*)(WSP + WS_MOD) + (size_t)l * 9 * MODW;
          EpiResidN E; E.rin_l = l == 0 ? IN(0) : OUTP; E.rin_c = l == 0 ? IN(2) : (const float*)(WSP + WS_XC); E.rout_l = OUTP; E.rout_c = (float*)(WSP + WS_XC); E.gate = ml + 2 * DM; E.rowbase = 0;
          E.Hn = (bf16_t*)(WSP + WS_H2); E.gs = (const float*)(WSP + WS_GSV) + (size_t)(l * 2 + 1) * 9 * DM; E.stat = (float*)(WSP + WS_STAT) + (size_t)TT * 16;
          run_gemm(smem, (const bf16_t*)(WSP + WS_H), (const bf16_t*)(WSP + WS_WOUT) + (size_t)l * DM * DM, Mout, DM, DM, E); }
        GSYNC();
        for (int half = 0; half < 2; ++half) {
            const int hs = half * HALF0, nr = half == 0 ? HALF0 : Mout - HALF0;
            { ParamsK p = getpk(); EpiStoreN E; E.O = (bf16_t*)(WSP + WS_FU); E.ldc = FF2; E.stat = (const float*)(WSP + WS_STAT) + (size_t)TT * 16; E.bias = (const float*)(WSP + WS_BIAS) + (size_t)(l * 2 + 1) * 9 * FF2; E.rowbase = hs;
              run_gemm(smem, (const bf16_t*)(WSP + WS_H2) + (size_t)hs * DM, (const bf16_t*)(WSP + WS_WUP) + (size_t)l * FF2 * DM, nr, FF2, DM, E); }
            GSYNC();
            for (int rep = 0; rep < REP_CG; ++rep) { ParamsK p = getpk(); convgate_phase(p, l, hs, nr); }
            GSYNC();
            if (upd) { ParamsK p = getpk(); const float* ml = (const float*)(WSP + WS_MOD) + (size_t)l * 9 * MODW;
              EpiResidN E; E.rin_l = OUTP; E.rin_c = (const float*)(WSP + WS_XC); E.rout_l = OUTP; E.rout_c = (float*)(WSP + WS_XC); E.gate = ml + 5 * DM; E.rowbase = hs;
              E.Hn = (bf16_t*)(WSP + WS_H); E.gs = (const float*)(WSP + WS_GSV) + (size_t)((l + 1) * 2) * 9 * DM; E.stat = (float*)(WSP + WS_STAT);
              run_gemm(smem, (const bf16_t*)(WSP + WS_ACT), (const bf16_t*)(WSP + WS_WDN) + (size_t)l * DM * FFN, nr, DM, FFN, E);
              if (half == 1) {
                  EpiStoreN E2; E2.O = (bf16_t*)(WSP + WS_U); E2.ldc = INP; E2.stat = (const float*)(WSP + WS_STAT); E2.bias = (const float*)(WSP + WS_BIAS) + (size_t)((l + 1) * 2) * 9 * FF2; E2.rowbase = 0;
                  run_gemm(smem, (const bf16_t*)(WSP + WS_H), (const bf16_t*)(WSP + WS_WIN) + (size_t)(l + 1) * INP * DM, HALF0, INP, DM, E2, 224); } }
            else { ParamsK p = getpk(); const float* ml = (const float*)(WSP + WS_MOD) + (size_t)l * 9 * MODW;
              EpiResid E; E.rin_l = OUTP; E.rin_c = (const float*)(WSP + WS_XC); E.rout_l = OUTP; E.rout_c = (float*)(WSP + WS_XC); E.gate = ml + 5 * DM; E.rowbase = hs;
              run_gemm(smem, (const bf16_t*)(WSP + WS_ACT), (const bf16_t*)(WSP + WS_WDN) + (size_t)l * DM * FFN, nr, DM, FFN, E); }
        }
        GSYNC();
    }
    { ParamsK p = getpk(); final_norm_phase(OUTP, IN(22)); }
}

extern "C" void kernel_launch(void* const* d_in, const int* in_sizes, int n_in, void* d_out, int out_size, void* d_ws, size_t ws_size, hipStream_t stream) {
    static int grid_blocks = 0;
    if (grid_blocks == 0) {
        if (n_in != 23 || ws_size < WS_NEED) { fprintf(stderr, "kernel_launch: unexpected n_in %d or ws %zu < %zu\n", n_in, ws_size, (size_t)WS_NEED); grid_blocks = -1; return; }
        int dev = 0, cus = 0, per_cu = 0;
        hipGetDevice(&dev);
        hipDeviceGetAttribute(&cus, hipDeviceAttributeMultiprocessorCount, dev);
        if (hipFuncSetAttribute((const void*)fwd_megakernel, hipFuncAttributeMaxDynamicSharedMemorySize, LDS_BYTES) != hipSuccess) { fprintf(stderr, "kernel_launch: hipFuncSetAttribute failed\n"); }
        if (hipOccupancyMaxActiveBlocksPerMultiprocessor(&per_cu, (const void*)fwd_megakernel, 512, LDS_BYTES) != hipSuccess || per_cu < 1) { fprintf(stderr, "kernel_launch: occupancy query gave %d\n", per_cu); per_cu = 1; }
        (void)hipGetLastError();
        grid_blocks = cus * 1;
        if (grid_blocks <= 0) grid_blocks = 256;
    }
    if (grid_blocks < 0) return;
    if (hipMemsetAsync((char*)d_ws + WS_CTL, 0, 16384, stream) != hipSuccess) { fprintf(stderr, "kernel_launch: hipMemsetAsync of the barrier word failed\n"); return; }
    Params p{};
    for (int i = 0; i < 23; ++i) p.in[i] = (const float*)d_in[i];
    p.out = (float*)d_out; p.ws = (unsigned char*)d_ws;
    void* args[] = {&p};
    hipError_t e = hipLaunchCooperativeKernel((const void*)fwd_megakernel, dim3(grid_blocks), dim3(512), args, LDS_BYTES, stream);
    if (e != hipSuccess) fprintf(stderr, "cooperative launch failed: %s (grid %d)\n", hipGetErrorString(e), grid_blocks);
}
```

```cpp
#include <hip/hip_runtime.h>
#include <hip/hip_cooperative_groups.h>
#include <cstdio>
#include <cstdint>
namespace cg = cooperative_groups;
__device__ __forceinline__ int otid() { int t = threadIdx.x; asm volatile("" : "+v"(t)); return t; }
namespace pg8 {
#define PG8_LAS __attribute__((address_space(3)))
typedef unsigned short bf16_t;
typedef short bf16x8 __attribute__((ext_vector_type(8)));
typedef float f32x4 __attribute__((ext_vector_type(4)));
typedef unsigned u32x4 __attribute__((ext_vector_type(4)));
constexpr int BM = 256, BK = 64, HALF = 128, HTB = HALF * BK * 2  , STAGE_BYTES = 8 * HTB, NXCD = 8, WGM = 8;

__host__ __device__ __forceinline__ int lds_byte(int r, int c) { const int st = (r >> 4) * 2 + (c >> 5), rr = r & 15, cc = c & 31, ob = rr * 64 + cc * 2; return st * 1024 + (ob ^ (((ob >> 9) & 1) << 5)); }
__host__ __device__ __forceinline__ void stage_rc(int b, int& R, int& C) { const int st = b / 1024, sb = b % 1024, swz = sb ^ (((sb >> 9) & 1) << 5); R = (st >> 1) * 16 + swz / 64; C = (st & 1) * 32 + (swz % 64) / 2; }
__host__ __device__ __forceinline__ int perm32(int rho) { const int n = rho >> 4, i = rho & 15; return 8 * (i >> 2) + 4 * n + (i & 3); }

struct Unit { int pm, pn; };
struct Gemm { const bf16_t* A; const bf16_t* Bt; int M, N, K; };

struct StaticOrder {
    int nM, nN, nwg, G, c;
    __host__ __device__ void init(int M, int N, int G_, int c_) { nM = M / BM; nN = N / BM; nwg = nM * nN; G = G_; c = c_; }
    __host__ __device__ bool next(int i, Unit& u) const {
        const long L = (long)i * G + c; if (L >= nwg) return false;
        int wgid = (int)L; { const int q = nwg / NXCD, r = nwg % NXCD, xcd = wgid % NXCD, off = wgid / NXCD; wgid = (xcd < r ? xcd * (q + 1) : r * (q + 1) + (xcd - r) * q) + off; }
        const int nig = WGM * nN, gid = wgid / nig, fm = gid * WGM, gsz = (nM - fm) < WGM ? (nM - fm) : WGM;
        u.pm = fm + ((wgid % nig) % gsz); u.pn = (wgid % nig) / gsz; return true;
    }
    __device__ __forceinline__ void a_ready(const Unit&) const {}
    __device__ __forceinline__ void done(const Unit&) const {}
};

typedef float f32x2v_ __attribute__((ext_vector_type(2)));
typedef __bf16 bf16x2v_ __attribute__((ext_vector_type(2)));
__device__ __forceinline__ unsigned cvt_pk_bf16(float lo, float hi) { f32x2v_ v = {lo, hi}; bf16x2v_ b = __builtin_convertvector(v, bf16x2v_); return __builtin_bit_cast(unsigned, b); }
template <class Epi, class Sched, bool ALIGN_EPI = false, bool SP2 = false>
__device__ __forceinline__ void gemm_phase(PG8_LAS unsigned char* lds, const Gemm g, const Sched& S, const Epi& E) {
    const int tid = otid(), wid = __builtin_amdgcn_readfirstlane(tid >> 6), lane = tid & 63, wr = wid >> 2, wc = wid & 3, fr = lane & 15, fq = lane >> 4;
    const int K = g.K, nt = K / BK;
    unsigned voffA[2], voffB[2];
#pragma unroll
    for (int i = 0; i < 2; ++i) { int R, C; stage_rc(tid * 16 + i * 8192, R, C); const int Rb = Epi::PERM ? ((R & ~31) + perm32(R & 31)) : R;
        voffA[i] = (unsigned)(R * K + C) * 2u; voffB[i] = (unsigned)(Rb * K + C) * 2u; }
    const size_t kstep = (size_t)(BK * 2);
    const size_t hstep = (size_t)HALF * K * 2;
    const size_t tstep = 2 * hstep;
    const unsigned ldsw = (unsigned)wid * 1024u;
    const int aoff = lds_byte(wr * 64 + fr, fq * 8), boff = lds_byte(wc * 32 + fr, fq * 8);
#define PG8_SA(b, h) (((b) * 2 + (h)) * HTB)
#define PG8_SB(b, h) ((4 + (b) * 2 + (h)) * HTB)
#define PG8_STAGE(bufoff, gbase, voff) do { _Pragma("unroll") for (int _i = 0; _i < 2; ++_i) \
        __builtin_amdgcn_global_load_lds((const unsigned*)((const char*)(gbase) + (voff)[_i]), (PG8_LAS unsigned*)(lds + (bufoff) + ldsw + _i * 8192), 16, 0, 0); } while (0)
#define PG8_LDA(dst, b, h) do { _Pragma("unroll") for (int m = 0; m < 4; ++m) _Pragma("unroll") for (int k = 0; k < 2; ++k) dst[m][k] = *(const PG8_LAS bf16x8*)(lds + PG8_SA(b, h) + aoff + m * 2048 + k * 1024); } while (0)
#define PG8_LDB(dst, b, h) do { _Pragma("unroll") for (int n = 0; n < 2; ++n) _Pragma("unroll") for (int k = 0; k < 2; ++k) dst[n][k] = *(const PG8_LAS bf16x8*)(lds + PG8_SB(b, h) + boff + n * 2048 + k * 1024); } while (0)
#define PG8_MMA(ai, bj, At, Bt) do { __builtin_amdgcn_s_setprio(1); _Pragma("unroll") for (int m = 0; m < 4; ++m) _Pragma("unroll") for (int n = 0; n < 2; ++n) _Pragma("unroll") for (int k = 0; k < 2; ++k) \
        acc[ai][bj][m][n] = __builtin_amdgcn_mfma_f32_16x16x32_bf16(Bt[n][k], At[m][k], acc[ai][bj][m][n], 0, 0, 0); __builtin_amdgcn_s_setprio(0); } while (0)
#define PG8_WAIT_V(n) asm volatile("s_waitcnt vmcnt(" #n ")" ::: "memory")
#define PG8_WAIT_L(n) asm volatile("s_waitcnt lgkmcnt(" #n ")" ::: "memory")
#define PG8_BAR __builtin_amdgcn_s_barrier()
#define PG8_SCHED __builtin_amdgcn_sched_barrier(0)
    Unit cur, nxt; int ui = 0;
    if (!S.next(0, cur)) return;
    f32x4 acc[2][2][4][2];
#pragma unroll
    for (int a = 0; a < 2; ++a)
#pragma unroll
        for (int b = 0; b < 2; ++b)
#pragma unroll
            for (int m = 0; m < 4; ++m)
#pragma unroll
                for (int n = 0; n < 2; ++n) acc[a][b][m][n] = (f32x4){0.f, 0.f, 0.f, 0.f};
    bf16x8 At[4][2], B0[2][2], B1[2][2];
    const char* cA = (const char*)g.A + (size_t)cur.pm * tstep; const char* cB = (const char*)g.Bt + (size_t)cur.pn * tstep;
    S.a_ready(cur);
    if constexpr (SP2) {
        PG8_STAGE(PG8_SB(0, 0), cB, voffB); PG8_STAGE(PG8_SB(0, 1), cB + hstep, voffB); PG8_STAGE(PG8_SA(0, 0), cA, voffA); PG8_STAGE(PG8_SA(0, 1), cA + hstep, voffA);
        if (wr == 1) PG8_BAR;
        PG8_WAIT_V(2); PG8_BAR;
        PG8_STAGE(PG8_SB(1, 0), cB + kstep, voffB); PG8_STAGE(PG8_SA(1, 0), cA + kstep, voffA); PG8_STAGE(PG8_SB(1, 1), cB + hstep + kstep, voffB);
        PG8_WAIT_V(6); PG8_BAR;
    } else {
        PG8_STAGE(PG8_SB(0, 0), cB, voffB); PG8_STAGE(PG8_SA(0, 0), cA, voffA); PG8_STAGE(PG8_SB(0, 1), cB + hstep, voffB); PG8_STAGE(PG8_SA(0, 1), cA + hstep, voffA);
        if (wr == 1) PG8_BAR;
        PG8_WAIT_V(4); PG8_BAR;
        PG8_STAGE(PG8_SB(1, 0), cB + kstep, voffB); PG8_STAGE(PG8_SA(1, 0), cA + kstep, voffA); PG8_STAGE(PG8_SB(1, 1), cB + hstep + kstep, voffB);
        PG8_WAIT_V(6); PG8_BAR;
    }
    for (;;) {
        const bool has_next = S.next(ui + 1, nxt);
        const char* nA = has_next ? (const char*)g.A + (size_t)nxt.pm * tstep : cA; const char* nB = has_next ? (const char*)g.Bt + (size_t)nxt.pn * tstep : cB;
        for (int t = 0; t < nt; t += 2) {
            const bool last = (t == nt - 2);
            const char* a1 = cA + (size_t)(t + 1) * kstep;
            const char* a2 = last ? nA : cA + (size_t)(t + 2) * kstep; const char* b2 = last ? nB : cB + (size_t)(t + 2) * kstep;
            const char* a3 = a2 + kstep; const char* b3 = b2 + kstep;
            if (last && has_next) S.a_ready(nxt);
            if constexpr (SP2) {
            PG8_LDB(B0, 0, 0); PG8_LDB(B1, 0, 1); PG8_SCHED; PG8_LDA(At, 0, 0); PG8_STAGE(PG8_SA(1, 1), a1 + hstep, voffA);
            PG8_WAIT_V(8); PG8_WAIT_L(0); PG8_BAR; PG8_MMA(0, 0, At, B0); PG8_MMA(0, 1, At, B1); PG8_BAR; PG8_SCHED;
            PG8_LDA(At, 0, 1); PG8_STAGE(PG8_SB(0, 0), b2, voffB); PG8_STAGE(PG8_SB(0, 1), b2 + hstep, voffB); PG8_STAGE(PG8_SA(0, 0), a2, voffA);
            PG8_WAIT_V(8); PG8_WAIT_L(0); PG8_BAR; PG8_MMA(1, 0, At, B0); PG8_MMA(1, 1, At, B1); PG8_BAR; PG8_SCHED;
            PG8_LDB(B0, 1, 0); PG8_LDB(B1, 1, 1); PG8_SCHED; PG8_LDA(At, 1, 0); PG8_STAGE(PG8_SA(0, 1), a2 + hstep, voffA);
            PG8_WAIT_V(8); PG8_WAIT_L(0); PG8_BAR; PG8_MMA(0, 0, At, B0); PG8_MMA(0, 1, At, B1); PG8_BAR; PG8_SCHED;
            PG8_LDA(At, 1, 1); PG8_STAGE(PG8_SB(1, 0), b3, voffB); PG8_STAGE(PG8_SB(1, 1), b3 + hstep, voffB); PG8_STAGE(PG8_SA(1, 0), a3, voffA);
            PG8_WAIT_V(8); PG8_WAIT_L(0); PG8_BAR; PG8_MMA(1, 0, At, B0); PG8_MMA(1, 1, At, B1); PG8_BAR; PG8_SCHED;
            } else {
            PG8_LDB(B0, 0, 0); PG8_SCHED; PG8_LDA(At, 0, 0); PG8_STAGE(PG8_SA(1, 1), a1 + hstep, voffA);
            PG8_WAIT_L(8); PG8_BAR; PG8_WAIT_L(0); PG8_MMA(0, 0, At, B0); PG8_BAR; PG8_SCHED;
            PG8_LDB(B1, 0, 1); PG8_STAGE(PG8_SB(0, 0), b2, voffB);
            PG8_BAR; PG8_WAIT_L(0); PG8_MMA(0, 1, At, B1); PG8_BAR;
            PG8_LDA(At, 0, 1); PG8_STAGE(PG8_SA(0, 0), a2, voffA);
            PG8_BAR; PG8_WAIT_L(0); PG8_MMA(1, 0, At, B0); PG8_BAR; PG8_SCHED;
            PG8_STAGE(PG8_SB(0, 1), b2 + hstep, voffB);
            PG8_WAIT_V(6); PG8_BAR; PG8_MMA(1, 1, At, B1); PG8_BAR;
            PG8_LDB(B0, 1, 0); PG8_SCHED; PG8_LDA(At, 1, 0); PG8_STAGE(PG8_SA(0, 1), a2 + hstep, voffA);
            PG8_WAIT_L(8); PG8_BAR; PG8_WAIT_L(0); PG8_MMA(0, 0, At, B0); PG8_BAR; PG8_SCHED;
            PG8_LDB(B1, 1, 1); PG8_STAGE(PG8_SB(1, 0), b3, voffB);
            PG8_BAR; PG8_WAIT_L(0); PG8_MMA(0, 1, At, B1); PG8_BAR;
            PG8_LDA(At, 1, 1); PG8_STAGE(PG8_SA(1, 0), a3, voffA);
            PG8_BAR; PG8_WAIT_L(0); PG8_MMA(1, 0, At, B0); PG8_BAR; PG8_SCHED;
            PG8_STAGE(PG8_SB(1, 1), b3 + hstep, voffB);
            PG8_WAIT_V(6); PG8_BAR; PG8_MMA(1, 1, At, B1); PG8_BAR;
            }
        }
        if constexpr (ALIGN_EPI) { if (wr == 0) PG8_BAR; }
        if constexpr (!Epi::AFTER_DRAIN) { E(acc, cur, wr, wc, fr, fq); S.done(cur); }
        if (!has_next) break;
#pragma unroll
        for (int a = 0; a < 2; ++a)
#pragma unroll
            for (int b = 0; b < 2; ++b)
#pragma unroll
                for (int m = 0; m < 4; ++m)
#pragma unroll
                    for (int n = 0; n < 2; ++n) acc[a][b][m][n] = (f32x4){0.f, 0.f, 0.f, 0.f};
        cur = nxt; cA = nA; cB = nB; ++ui;
        if constexpr (ALIGN_EPI) { if (wr == 1) PG8_BAR; }
    }
    PG8_WAIT_V(0);
    if constexpr (!ALIGN_EPI) { if (wr == 0) PG8_BAR; }
    PG8_BAR;
    if constexpr (Epi::AFTER_DRAIN) { E.fused(acc, cur, wr, wc, fr, fq, lds, wid, lane); S.done(cur); }
#undef PG8_SA
#undef PG8_SB
#undef PG8_STAGE
#undef PG8_LDA
#undef PG8_LDB
#undef PG8_MMA
#undef PG8_WAIT_V
#undef PG8_WAIT_L
#undef PG8_BAR
#undef PG8_SCHED
}
}

typedef unsigned short bf16_t;
typedef short bf16x8 __attribute__((ext_vector_type(8)));
typedef float f32x4 __attribute__((ext_vector_type(4)));
typedef unsigned u32x4 __attribute__((ext_vector_type(4)));
typedef unsigned u32x2 __attribute__((ext_vector_type(2)));
#define LAS __attribute__((address_space(3)))

constexpr int DM = 1024, NBAT = 8, SEQ = 8192, DEPTH = 4, CTXL = 256;
constexpr int TL = NBAT * SEQ, TC = NBAT * CTXL, TT = TL + TC;
constexpr int INW = 3104, INP = 3328;
constexpr int Q0 = 0, K0 = 192, V0 = 384, GF0 = 768, GB0 = 784, R0 = 800, SB0 = 1184, SC0 = 1440, SX0 = 1696, NQ0 = 1952, NK0 = 2336, NV0 = 2720;
constexpr int FFN = 2816, FF2 = 5632;
constexpr int MODW = 6 * DM;
constexpr int NCH = 132;
constexpr int VTW = SEQ + CTXL;
constexpr int HALF0 = 32768;

constexpr size_t WS_WIN = 0;
constexpr size_t WS_WOUT = WS_WIN + (size_t)DEPTH * INP * DM * 2;
constexpr size_t WS_WUP = WS_WOUT + (size_t)DEPTH * DM * DM * 2;
constexpr size_t WS_WDN = WS_WUP + (size_t)DEPTH * FF2 * DM * 2;
constexpr size_t WS_MOD = WS_WDN + (size_t)DEPTH * DM * FFN * 2;
constexpr size_t WS_ROPE = WS_MOD + (size_t)DEPTH * 9 * MODW * 4;
constexpr size_t WS_XC = WS_ROPE + (size_t)SEQ * 32 * 4;
constexpr size_t WS_H = WS_XC + (size_t)TC * DM * 4;
constexpr size_t WS_BIG = WS_H + (size_t)TT * DM * 2;
constexpr size_t WS_U = WS_BIG;
constexpr size_t WS_VT = WS_U + (size_t)TT * INP * 2;
constexpr size_t WS_VTG = WS_VT + (size_t)48 * 64 * VTW * 2;
constexpr size_t WS_SL = WS_VTG + (size_t)48 * 64 * VTW * 2;
constexpr size_t WS_DEC = WS_SL + (size_t)96 * NCH * 2048 * 4;
constexpr size_t WS_OG = WS_DEC + (size_t)96 * NCH * 32 * 4;
constexpr size_t WS_END1 = WS_OG + (size_t)TT * 384 * 4;
constexpr size_t WS_FU = WS_BIG;
constexpr size_t WS_ACT = WS_FU + (size_t)34816 * FF2 * 2;
constexpr size_t WS_END2 = WS_ACT + (size_t)34816 * FFN * 2;
constexpr size_t WS_CTL = ((WS_END1 > WS_END2 ? WS_END1 : WS_END2) + 4095) / 4096 * 4096;
constexpr size_t WS_GSV = WS_CTL + 16384;
constexpr size_t WS_BIAS = WS_GSV + (size_t)DEPTH * 2 * 9 * DM * 4;
constexpr size_t WS_STAT = WS_BIAS + (size_t)DEPTH * 2 * 9 * FF2 * 4;
constexpr size_t WS_NEED = WS_STAT + (size_t)2 * TT * 16 * 4 + 4096;
constexpr size_t WS_H2 = (WS_END2 + 4095) / 4096 * 4096;
static_assert(WS_H2 + (size_t)TT * DM * 2 <= WS_CTL, "H2 overlay must end before the control words");
constexpr int LDS_BYTES = 131072;
#define GSYNC_CG() do { asm volatile("s_waitcnt vmcnt(0)" ::: "memory"); grid.sync(); } while (0)
#define XB_TMO      128
#define XB_XCNT(j)  (256  + 64 * (j))
#define XB_XSUB(j)  (1280 + 64 * (j))
#define XB_XGEN(j)  (2304 + 64 * (j))
#define XB_TOP      3328
#define XB_TOPGEN   3392
#define XCD_BAR_WORDS 3456
#define XB_SPIN_CAP (1u << 18)
__device__ __forceinline__ unsigned xb_ld(unsigned* p)              { return __hip_atomic_load(p, __ATOMIC_RELAXED, __HIP_MEMORY_SCOPE_AGENT); }
__device__ __forceinline__ unsigned xb_add(unsigned* p, unsigned v) { return __hip_atomic_fetch_add(p, v, __ATOMIC_RELAXED, __HIP_MEMORY_SCOPE_AGENT); }
__device__ __forceinline__ unsigned xb_xcc_id() { return (unsigned)__builtin_amdgcn_s_getreg((3 << 11) | 20) & 0xFu; }
#define XB_SPIN(cond, bar) do { unsigned _sp = 0; while (cond) { __builtin_amdgcn_s_sleep(1); \
    if ((++_sp & 255u) == 0u) { if (xb_ld(&(bar)[XB_TMO])) break; if (_sp > XB_SPIN_CAP) { atomicAdd(&(bar)[XB_TMO], 1u); break; } } } } while (0)
struct XcdBarrier { unsigned* bar; unsigned x; volatile LAS unsigned* st; };
__device__ __forceinline__ XcdBarrier xcd_barrier_post(unsigned* bar, volatile LAS unsigned* st) {
    XcdBarrier b; b.bar = bar; b.x = xb_xcc_id(); b.st = st;
    if (threadIdx.x == 0) (void)xb_add(&bar[XB_XCNT(b.x)], 1u);
    return b;
}
__device__ __forceinline__ void xcd_barrier_complete(unsigned* bar, unsigned x, unsigned& nloc, unsigned& nx) {
    const unsigned G = gridDim.x * gridDim.y * gridDim.z;
    unsigned sum, cnt, mine, sp = 0u;
    for (;;) {
        sum = 0u; cnt = 0u; mine = 0u;
#pragma unroll
        for (unsigned j = 0; j < 16; ++j) { const unsigned c = xb_ld(&bar[XB_XCNT(j)]); sum += c; cnt += (c > 0u) ? 1u : 0u; mine = (j == x) ? c : mine; }
        if (sum == G) break;
        __builtin_amdgcn_s_sleep(1);
        if ((++sp & 255u) == 0u) { if (xb_ld(&bar[XB_TMO])) break; if (sp > XB_SPIN_CAP) { atomicAdd(&bar[XB_TMO], 1u); break; } }
    }
    nloc = mine > 0u ? mine : 1u; nx = cnt > 0u ? cnt : 1u;
}
__device__ __forceinline__ void xcd_barrier(const XcdBarrier& b) {
    asm volatile("s_waitcnt vmcnt(0)" ::: "memory");
    __syncthreads();
    if (threadIdx.x == 0) {
        unsigned* bar = b.bar;
        __builtin_amdgcn_s_waitcnt(0);
        unsigned nloc = b.st[0], nx = b.st[1];
        if (nloc == 0u) { xcd_barrier_complete(bar, b.x, nloc, nx); b.st[0] = nloc; b.st[1] = nx; }
        const unsigned old = xb_add(&bar[XB_XSUB(b.x)], 1u);
        const unsigned gen = old / nloc;
        if (old + 1u == (gen + 1u) * nloc) {
            __builtin_amdgcn_fence(__ATOMIC_RELEASE, "agent");
            asm volatile("s_waitcnt vmcnt(0)" ::: "memory");
            const unsigned og = xb_add(&bar[XB_TOP], 1u);
            const unsigned tg = og / nx;
            if (og + 1u == (tg + 1u) * nx) xb_add(&bar[XB_TOPGEN], 1u);
            else XB_SPIN(xb_ld(&bar[XB_TOPGEN]) == tg, bar);
            __builtin_amdgcn_fence(__ATOMIC_ACQUIRE, "agent");
            xb_add(&bar[XB_XGEN(b.x)], 1u);
            asm volatile("s_waitcnt vmcnt(0)" ::: "memory");
        } else {
            XB_SPIN(xb_ld(&bar[XB_XGEN(b.x)]) == gen, bar);
            __builtin_amdgcn_fence(__ATOMIC_ACQUIRE, "agent");
            asm volatile("s_waitcnt vmcnt(0)" ::: "memory");
        }
    }
    __syncthreads();
}
#define GSYNC() xcd_barrier(xb)
#ifndef REP_GLA
#define REP_GLA 1
#endif
#ifndef REP_NA
#define REP_NA 1
#endif
#ifndef REP_CG
#define REP_CG 1
#endif
#ifndef REP_GEMM
#define REP_GEMM 1
#endif
#ifndef REP_NORM
#define REP_NORM 1
#endif
#ifndef REP_VT
#define REP_VT 1
#endif

struct Params {
    const float* in[23];
    float* out;
    unsigned char* ws;
};


typedef const Params __attribute__((address_space(4)))* ParamsK;
__device__ __forceinline__ ParamsK getpk() { ParamsK q = (ParamsK)__builtin_amdgcn_kernarg_segment_ptr(); asm volatile("" : "+s"(q)); return q; }
template <class T> __device__ __forceinline__ T* asglobal(T* q) {
#if defined(__HIP_DEVICE_COMPILE__)
    __builtin_assume(!__builtin_amdgcn_is_shared((const void*)q)); __builtin_assume(!__builtin_amdgcn_is_private((const void*)q));
#endif
    return q; }
#define IN(i) asglobal(p->in[i])
#define WSP asglobal(p->ws)
#define OUTP asglobal(p->out)
__device__ __forceinline__ float bf2f(bf16_t v) { return __uint_as_float(((unsigned)v) << 16); }
__device__ __forceinline__ float bflo(unsigned w) { return __uint_as_float(w << 16); }
__device__ __forceinline__ float bfhi(unsigned w) { return __uint_as_float(w & 0xffff0000u); }
__device__ __forceinline__ unsigned pk2(float lo, float hi) { return pg8::cvt_pk_bf16(lo, hi); }
__device__ __forceinline__ float wave_sum(float v) {
#pragma unroll
    for (int o = 1; o < 64; o <<= 1) v += __shfl_xor(v, o);
    return v;
}
__device__ __forceinline__ float silu_f(float v) { return v * __builtin_amdgcn_rcpf(1.f + __expf(-v)); }
#define LDS_WAIT() asm volatile("s_waitcnt lgkmcnt(0)" ::: "memory")

struct EpiStore {
    static constexpr bool PERM = true, AFTER_DRAIN = false;
    bf16_t* O; int ldc;
    __device__ __forceinline__ void operator()(const f32x4 (&acc)[2][2][4][2], const pg8::Unit& u, int wr, int wc, int fr, int fq) const {
        const int row0 = u.pm * 256 + wr * 64 + fr, col0 = u.pn * 256 + wc * 32 + 8 * fq;
#pragma unroll
        for (int ai = 0; ai < 2; ++ai)
#pragma unroll
            for (int m = 0; m < 4; ++m) { bf16_t* rowp = O + (size_t)(row0 + ai * 128 + m * 16) * ldc + col0;
#pragma unroll
                for (int bj = 0; bj < 2; ++bj) { const f32x4 v0 = acc[ai][bj][m][0], v1 = acc[ai][bj][m][1];
                    u32x4 w; w.x = pk2(v0[0], v0[1]); w.y = pk2(v0[2], v0[3]); w.z = pk2(v1[0], v1[1]); w.w = pk2(v1[2], v1[3]);
                    *(u32x4*)(rowp + bj * 128) = w; } }
    }
};
struct EpiResid {
    static constexpr bool PERM = true, AFTER_DRAIN = false;
    const float* rin_l; const float* rin_c; float* rout_l; float* rout_c; const float* gate; int rowbase;
    __device__ __forceinline__ void operator()(const f32x4 (&acc)[2][2][4][2], const pg8::Unit& u, int wr, int wc, int fr, int fq) const {
#pragma unroll
        for (int ai = 0; ai < 2; ++ai)
#pragma unroll
            for (int m = 0; m < 4; ++m) {
                const int R = rowbase + u.pm * 256 + ai * 128 + wr * 64 + m * 16 + fr;
                const bool islat = R < TL; const int mrow = islat ? (R >> 13) : 8;
                const float* src = islat ? rin_l + (size_t)R * DM : rin_c + (size_t)(R - TL) * DM;
                float* dst = islat ? rout_l + (size_t)R * DM : rout_c + (size_t)(R - TL) * DM;
                const float* gp = gate + (size_t)mrow * MODW;
#pragma unroll
                for (int bj = 0; bj < 2; ++bj)
#pragma unroll
                    for (int n = 0; n < 2; ++n) { const int c = u.pn * 256 + bj * 128 + wc * 32 + 8 * fq + 4 * n;
                        const f32x4 g4 = *(const f32x4*)(gp + c), x4 = *(const f32x4*)(src + c);
                        *(f32x4*)(dst + c) = x4 + g4 * acc[ai][bj][m][n]; } }
    }
};

struct EpiStoreN {
    static constexpr bool PERM = true, AFTER_DRAIN = false;
    bf16_t* O; int ldc; const float* stat; const float* bias; int rowbase;
    __device__ __forceinline__ void operator()(const f32x4 (&acc)[2][2][4][2], const pg8::Unit& u, int wr, int wc, int fr, int fq) const {
        const int row0 = u.pm * 256 + wr * 64 + fr, col0 = u.pn * 256 + wc * 32 + 8 * fq;
        const int Rt = rowbase + u.pm * 256;
        const float* bp = bias + (size_t)(Rt < TL ? (Rt >> 13) : 8) * FF2 + col0;
        f32x4 bv[2][2];
#pragma unroll
        for (int bj = 0; bj < 2; ++bj) { bv[bj][0] = *(const f32x4*)(bp + bj * 128); bv[bj][1] = *(const f32x4*)(bp + bj * 128 + 4); }
#pragma unroll
        for (int ai = 0; ai < 2; ++ai)
#pragma unroll
            for (int m = 0; m < 4; ++m) { const int r = row0 + ai * 128 + m * 16, Rg = rowbase + r;
                const f32x4 q = *(const f32x4*)(stat + (size_t)Rg * 16 + fq * 4);
                float ssq = (q[0] + q[1]) + (q[2] + q[3]); ssq += __shfl_xor(ssq, 16); ssq += __shfl_xor(ssq, 32);
                const float rstd = rsqrtf(ssq * (1.f / DM) + 1e-6f);
                bf16_t* rowp = O + (size_t)r * ldc + col0;
#pragma unroll
                for (int bj = 0; bj < 2; ++bj) { const f32x4 v0 = acc[ai][bj][m][0] * rstd + bv[bj][0], v1 = acc[ai][bj][m][1] * rstd + bv[bj][1];
                    u32x4 w; w.x = pk2(v0[0], v0[1]); w.y = pk2(v0[2], v0[3]); w.z = pk2(v1[0], v1[1]); w.w = pk2(v1[2], v1[3]);
                    *(u32x4*)(rowp + bj * 128) = w; } }
    }
};
struct EpiResidN {
    static constexpr bool PERM = true, AFTER_DRAIN = false;
    const float* rin_l; const float* rin_c; float* rout_l; float* rout_c; const float* gate; int rowbase;
    bf16_t* Hn; const float* gs; float* stat;
    __device__ __forceinline__ void operator()(const f32x4 (&acc)[2][2][4][2], const pg8::Unit& u, int wr, int wc, int fr, int fq) const {
        const int Rt = rowbase + u.pm * 256; const bool islat = Rt < TL; const int mrow = islat ? (Rt >> 13) : 8;
        const float* gp = gate + (size_t)mrow * MODW; const float* gsp = gs + (size_t)mrow * DM;
        f32x4 gv[2][2], sv[2][2];
#pragma unroll
        for (int bj = 0; bj < 2; ++bj) { const int c = u.pn * 256 + bj * 128 + wc * 32 + 8 * fq;
            gv[bj][0] = *(const f32x4*)(gp + c); gv[bj][1] = *(const f32x4*)(gp + c + 4); sv[bj][0] = *(const f32x4*)(gsp + c); sv[bj][1] = *(const f32x4*)(gsp + c + 4); }
#pragma unroll
        for (int ai = 0; ai < 2; ++ai)
#pragma unroll
            for (int m = 0; m < 4; ++m) {
                const int R = rowbase + u.pm * 256 + ai * 128 + wr * 64 + m * 16 + fr;
                const float* src = islat ? rin_l + (size_t)R * DM : rin_c + (size_t)(R - TL) * DM;
                float* dst = islat ? rout_l + (size_t)R * DM : rout_c + (size_t)(R - TL) * DM;
                float ss = 0.f;
#pragma unroll
                for (int bj = 0; bj < 2; ++bj) { const int c = u.pn * 256 + bj * 128 + wc * 32 + 8 * fq;
                    const f32x4 xa = *(const f32x4*)(src + c) + gv[bj][0] * acc[ai][bj][m][0];
                    const f32x4 xb = *(const f32x4*)(src + c + 4) + gv[bj][1] * acc[ai][bj][m][1];
                    *(f32x4*)(dst + c) = xa; *(f32x4*)(dst + c + 4) = xb;
                    ss += (xa[0] * xa[0] + xa[1] * xa[1]) + (xa[2] * xa[2] + xa[3] * xa[3]) + (xb[0] * xb[0] + xb[1] * xb[1]) + (xb[2] * xb[2] + xb[3] * xb[3]);
                    const f32x4 ya = xa * sv[bj][0], yb = xb * sv[bj][1];
                    u32x4 w; w.x = pk2(ya[0], ya[1]); w.y = pk2(ya[2], ya[3]); w.z = pk2(yb[0], yb[1]); w.w = pk2(yb[2], yb[3]);
                    *(u32x4*)(Hn + (size_t)R * DM + c) = w; }
                ss += __shfl_xor(ss, 16); ss += __shfl_xor(ss, 32);
                if (fq == 0) stat[(size_t)R * 16 + u.pn * 4 + wc] = ss;
            }
    }
};

__device__ __forceinline__ const void* uni_ptr(const void* q) { const unsigned long long a = (unsigned long long)q; const unsigned lo = __builtin_amdgcn_readfirstlane((unsigned)a), hi = __builtin_amdgcn_readfirstlane((unsigned)(a >> 32)); return (const void*)(((unsigned long long)hi << 32) | lo); }
template <class Epi>
__device__ __forceinline__ void run_gemm(unsigned char* smem, const bf16_t* A, const bf16_t* Bt, int M, int N, int K, const Epi& E, int crot = 0) {
    pg8::Gemm g; g.A = (const bf16_t*)uni_ptr(A); g.Bt = (const bf16_t*)uni_ptr(Bt); g.M = M; g.N = N; g.K = K;
    pg8::StaticOrder S; S.init(M, N, (int)gridDim.x, (int)((blockIdx.x + crot) % gridDim.x));
    pg8::gemm_phase<Epi, pg8::StaticOrder, true, true>((PG8_LAS unsigned char*)smem, g, S, E);
    __syncthreads();
}

__device__ __forceinline__ void ada_phase(ParamsK p, unsigned char* smem) {
    float* sc = (float*)smem;
    float* red = sc + 9 * 1024;
    const int tid = otid();
    const float* cvec = IN(1); const float* cctx = IN(3); const float* w_ada = IN(4); const float* b_ada = IN(5);
    float* mod = (float*)(WSP + WS_MOD);
    for (int i = tid; i < 9 * 1024; i += 512) { const int r = i >> 10, k = i & 1023; const float v = r < 8 ? cvec[r * 1024 + k] : cctx[k]; sc[i] = v / (1.f + expf(-v)); }
    __syncthreads();
    for (int task = blockIdx.x; task < DEPTH * 96; task += gridDim.x) {
        const int l = task / 96, cb = (task % 96) * 64, cl = tid & 63, ks = tid >> 6;
        const float* w = w_ada + (size_t)l * DM * MODW + cb + cl;
        float acc[9];
#pragma unroll
        for (int r = 0; r < 9; ++r) acc[r] = 0.f;
#pragma unroll 16
        for (int kk = 0; kk < 128; ++kk) { const int k = ks * 128 + kk; const float wv = w[(size_t)k * MODW];
#pragma unroll
            for (int r = 0; r < 9; ++r) acc[r] += sc[r * 1024 + k] * wv; }
#pragma unroll
        for (int r = 0; r < 9; ++r) red[(ks * 9 + r) * 64 + cl] = acc[r];
        __syncthreads();
        for (int o = tid; o < 576; o += 512) { const int r = o >> 6, cc = o & 63; float s = 0.f;
#pragma unroll
            for (int k8 = 0; k8 < 8; ++k8) s += red[(k8 * 9 + r) * 64 + cc];
            mod[(size_t)(l * 9 + r) * MODW + cb + cc] = s + b_ada[l * MODW + cb + cc]; }
        __syncthreads();
    }
}
__device__ __forceinline__ void transpose_item(const float* W, int K, int N, bf16_t* WT, float* scr, int item, int lane) {
    const int nblk = N / 32, kb = item / nblk, nb = item % nblk, k0 = 64 * kb, n0 = 32 * nb;
    float tv[32];
#pragma unroll
    for (int i = 0; i < 32; ++i) { const int kk = 2 * i + (lane >> 5); tv[i] = W[(size_t)(k0 + kk) * N + n0 + (lane & 31)]; }
#pragma unroll
    for (int i = 0; i < 32; ++i) { const int kk = 2 * i + (lane >> 5); scr[kk * 33 + (lane & 31)] = tv[i]; }
    LDS_WAIT();
    const int c = lane & 7;
#pragma unroll
    for (int j = 0; j < 4; ++j) { const int n = (lane >> 3) + 8 * j; const float* s = scr + (8 * c) * 33 + n;
        u32x4 o; o.x = pk2(s[0 * 33], s[1 * 33]); o.y = pk2(s[2 * 33], s[3 * 33]); o.z = pk2(s[4 * 33], s[5 * 33]); o.w = pk2(s[6 * 33], s[7 * 33]);
        *(u32x4*)(WT + (size_t)(n0 + n) * K + k0 + 8 * c) = o; }
    LDS_WAIT();
}
__device__ __forceinline__ void weights_phase(ParamsK p, unsigned char* smem) {
    const int tid = otid(), lane = tid & 63, wave = __builtin_amdgcn_readfirstlane(tid >> 6);
    float* scr = (float*)(smem + wave * 16384);
    const int gw = blockIdx.x * 8 + wave, NGW = gridDim.x * 8;
    constexpr int I_IN = 16 * (INW / 32), I_OUT = 16 * 32, I_UP = 16 * (FF2 / 32), I_DN = (FFN / 64) * 32, I_L = I_IN + I_OUT + I_UP + I_DN;
    for (int it = gw; it < DEPTH * I_L; it += NGW) {
        const int l = it / I_L; int r = it % I_L;
        if (r < I_IN) { transpose_item(IN(8) + (size_t)l * DM * INW, DM, INW, (bf16_t*)(WSP + WS_WIN) + (size_t)l * INP * DM, scr, r, lane); continue; } r -= I_IN;
        if (r < I_OUT) { transpose_item(IN(17) + (size_t)l * DM * DM, DM, DM, (bf16_t*)(WSP + WS_WOUT) + (size_t)l * DM * DM, scr, r, lane); continue; } r -= I_OUT;
        if (r < I_UP) { transpose_item(IN(18) + (size_t)l * DM * FF2, DM, FF2, (bf16_t*)(WSP + WS_WUP) + (size_t)l * FF2 * DM, scr, r, lane); continue; } r -= I_UP;
        transpose_item(IN(21) + (size_t)l * FFN * DM, FFN, DM, (bf16_t*)(WSP + WS_WDN) + (size_t)l * DM * FFN, scr, r, lane);
    }
    const int gt = blockIdx.x * 512 + tid, NGT = gridDim.x * 512;
    constexpr int PADV = (INP - INW) * DM / 8;
    for (int i = gt; i < DEPTH * PADV; i += NGT) { const int l = i / PADV, r = i % PADV;
        *(u32x4*)((bf16_t*)(WSP + WS_WIN) + (size_t)l * INP * DM + (size_t)INW * DM + (size_t)r * 8) = (u32x4){0u, 0u, 0u, 0u}; }
    float* rope = (float*)(WSP + WS_ROPE);
    for (int i = gt; i < SEQ * 16; i += NGT) { const int tok = i >> 4, j = i & 15, f = j & 7;
        const float invf = f == 0 ? 1.0f : f == 1 ? 0.31622776601683794f : f == 2 ? 0.1f : f == 3 ? 0.031622776601683794f : f == 4 ? 0.01f : f == 5 ? 0.0031622776601683794f : f == 6 ? 0.001f : 0.00031622776601683794f;
        const float pos = (float)(j < 8 ? (tok >> 6) : (tok & 63)); const float ang = pos * invf;
        const double a = (double)ang; const double kq = rint(a * 0.15915494309189535); const float rr = (float)(a - kq * 6.283185307179586);
        rope[tok * 32 + j] = cosf(rr); rope[tok * 32 + 16 + j] = sinf(rr); }
}

__device__ __forceinline__ void norm_phase(const float* xl, const float* xc, const float* g, const float* shift, const float* scale, bf16_t* H, int nrows) {
    const int tid = otid(), lane = tid & 63, wave = __builtin_amdgcn_readfirstlane(tid >> 6);
    const int gw = blockIdx.x * 8 + wave, NGW = gridDim.x * 8;
    for (int row0 = gw; row0 < nrows; row0 += 2 * NGW) {
        const int row1 = row0 + NGW; const bool has1 = row1 < nrows; const int rowb = has1 ? row1 : row0;
        const float* srcA = row0 < TL ? xl + (size_t)row0 * DM : xc + (size_t)(row0 - TL) * DM;
        const float* srcB = rowb < TL ? xl + (size_t)rowb * DM : xc + (size_t)(rowb - TL) * DM;
        f32x4 va[4], vb[4]; float sa = 0.f, sb = 0.f;
#pragma unroll
        for (int j = 0; j < 4; ++j) { va[j] = *(const f32x4*)(srcA + lane * 4 + 256 * j); vb[j] = *(const f32x4*)(srcB + lane * 4 + 256 * j); }
#pragma unroll
        for (int j = 0; j < 4; ++j) { sa += (va[j][0] * va[j][0] + va[j][1] * va[j][1]) + (va[j][2] * va[j][2] + va[j][3] * va[j][3]);
            sb += (vb[j][0] * vb[j][0] + vb[j][1] * vb[j][1]) + (vb[j][2] * vb[j][2] + vb[j][3] * vb[j][3]); }
#pragma unroll
        for (int o = 1; o < 64; o <<= 1) { sa += __shfl_xor(sa, o); sb += __shfl_xor(sb, o); }
        const float rstdA = rsqrtf(sa * (1.f / DM) + 1e-6f), rstdB = rsqrtf(sb * (1.f / DM) + 1e-6f);
        const int mA = row0 < TL ? (row0 >> 13) : 8, mB = rowb < TL ? (rowb >> 13) : 8;
#pragma unroll
        for (int j = 0; j < 4; ++j) { const int c = lane * 4 + 256 * j;
            const f32x4 g4 = *(const f32x4*)(g + c);
            { const f32x4 s4 = *(const f32x4*)(scale + (size_t)mA * MODW + c), h4 = *(const f32x4*)(shift + (size_t)mA * MODW + c);
              const f32x4 y = (va[j] * rstdA * g4) * (s4 + 1.f) + h4;
              u32x2 w; w.x = pk2(y[0], y[1]); w.y = pk2(y[2], y[3]); *(u32x2*)(H + (size_t)row0 * DM + c) = w; }
            if (has1) { const f32x4 s4 = *(const f32x4*)(scale + (size_t)mB * MODW + c), h4 = *(const f32x4*)(shift + (size_t)mB * MODW + c);
              const f32x4 y = (vb[j] * rstdB * g4) * (s4 + 1.f) + h4;
              u32x2 w; w.x = pk2(y[0], y[1]); w.y = pk2(y[2], y[3]); *(u32x2*)(H + (size_t)row1 * DM + c) = w; }
        }
    }
}
__device__ __forceinline__ void final_norm_phase(float* x, const float* g) {
    const int tid = otid(), lane = tid & 63, wave = __builtin_amdgcn_readfirstlane(tid >> 6);
    const int gw = blockIdx.x * 8 + wave, NGW = gridDim.x * 8;
    for (int row = gw; row < TL; row += NGW) {
        float* src = x + (size_t)row * DM;
        f32x4 v[4]; float ss = 0.f;
#pragma unroll
        for (int j = 0; j < 4; ++j) { v[j] = *(const f32x4*)(src + lane * 4 + 256 * j); ss += (v[j][0] * v[j][0] + v[j][1] * v[j][1]) + (v[j][2] * v[j][2] + v[j][3] * v[j][3]); }
        const float rstd = rsqrtf(wave_sum(ss) * (1.f / DM) + 1e-6f);
#pragma unroll
        for (int j = 0; j < 4; ++j) { const int c = lane * 4 + 256 * j; const f32x4 g4 = *(const f32x4*)(g + c); *(f32x4*)(src + c) = v[j] * rstd * g4; }
    }
}

typedef short bf16x4 __attribute__((ext_vector_type(4)));
constexpr int GS = 36;
__device__ __forceinline__ bf16x4 as_bf16x4(u32x2 w) { union { u32x2 u; bf16x4 b; } c; c.u = w; return c.b; }
__device__ __forceinline__ bf16x8 as_bf16x8(u32x4 w) { union { u32x4 u; bf16x8 b; } c; c.u = w; return c.b; }
__device__ __forceinline__ void unpack8(const u32x4 w, float (&f)[8]) {
#pragma unroll
    for (int i = 0; i < 4; ++i) { f[2 * i] = bflo(w[i]); f[2 * i + 1] = bfhi(w[i]); }
}
struct GlaRaw { u32x4 kraw, qraw; f32x4 cs, sn; u32x2 graw; };
template <bool NEEDQ>
__device__ __forceinline__ void gla_stage_load(const bf16_t* U, const float* rope, int row0, int tpos0, int h, int dir, int lane, GlaRaw& R) {
    const int tok = lane >> 2, qr = lane & 3;
    const bf16_t* ur = U + (size_t)(row0 + tok) * INP + h * 32 + qr * 8;
    R.kraw = *(const u32x4*)(ur + K0);
    if (NEEDQ) R.qraw = *(const u32x4*)(ur + Q0);
    if (tpos0 >= 0) { const float* rp = rope + (size_t)(tpos0 + tok) * 32 + qr * 4; R.cs = *(const f32x4*)rp; R.sn = *(const f32x4*)(rp + 16); }
    R.graw = *(const u32x2*)(U + (size_t)(row0 + tok) * INP + (dir ? GB0 : GF0) + qr * 4);
}
template <bool NEEDQ>
__device__ __forceinline__ void gla_stage16(const GlaRaw& R, float* qs, float* ks, float* Bs, float* Be, int tpos0, int dir, const float (&wg)[16], float bgk, int lane) {
    {
        const int tok = lane >> 2, qr = lane & 3;
        float kk[8], qq[8];
        unpack8(R.kraw, kk);
        if (NEEDQ) { unpack8(R.qraw, qq);
#pragma unroll
            for (int i = 0; i < 8; ++i) qq[i] *= 0.17677669529663687f; }
        if (tpos0 >= 0) { const f32x4 cs = R.cs, sn = R.sn;
#pragma unroll
            for (int i = 0; i < 4; ++i) { const float a = kk[2 * i] * cs[i] - kk[2 * i + 1] * sn[i], b2 = kk[2 * i] * sn[i] + kk[2 * i + 1] * cs[i]; kk[2 * i] = a; kk[2 * i + 1] = b2;
                if (NEEDQ) { const float c2 = qq[2 * i] * cs[i] - qq[2 * i + 1] * sn[i], d2 = qq[2 * i] * sn[i] + qq[2 * i + 1] * cs[i]; qq[2 * i] = c2; qq[2 * i + 1] = d2; } } }
        *(f32x4*)(ks + tok * GS + qr * 8) = (f32x4){kk[0], kk[1], kk[2], kk[3]}; *(f32x4*)(ks + tok * GS + qr * 8 + 4) = (f32x4){kk[4], kk[5], kk[6], kk[7]};
        if (NEEDQ) { *(f32x4*)(qs + tok * GS + qr * 8) = (f32x4){qq[0], qq[1], qq[2], qq[3]}; *(f32x4*)(qs + tok * GS + qr * 8 + 4) = (f32x4){qq[4], qq[5], qq[6], qq[7]}; }
    }
    bf16_t* Gs = (bf16_t*)(Be + 64);
    *(u32x2*)(Gs + lane * 4) = R.graw;
    LDS_WAIT();
    {
        const int k = lane & 31, hf = lane >> 5;
        float g[8];
#pragma unroll
        for (int i = 0; i < 8; ++i) {
            const u32x4 ga = *(const u32x4*)(Gs + (hf * 8 + i) * 16), gb = *(const u32x4*)(Gs + (hf * 8 + i) * 16 + 8);
            float x = bgk;
#pragma unroll
            for (int j = 0; j < 4; ++j) { x += bflo(ga[j]) * wg[2 * j] + bfhi(ga[j]) * wg[2 * j + 1]; }
#pragma unroll
            for (int j = 0; j < 4; ++j) { x += bflo(gb[j]) * wg[8 + 2 * j] + bfhi(gb[j]) * wg[8 + 2 * j + 1]; }
            g[i] = (fminf(x, 0.f) - __logf(1.f + __expf(-fabsf(x)))) * 0.0625f;
        }
        if (dir == 0) {
#pragma unroll
            for (int i = 1; i < 8; ++i) g[i] += g[i - 1];
            const float other = __shfl_xor(g[7], 32);
            if (hf == 1) {
#pragma unroll
                for (int i = 0; i < 8; ++i) g[i] += other;
                Be[k] = g[7]; }
        } else {
#pragma unroll
            for (int i = 6; i >= 0; --i) g[i] += g[i + 1];
            const float other = __shfl_xor(g[0], 32);
            if (hf == 0) {
#pragma unroll
                for (int i = 0; i < 8; ++i) g[i] += other;
                Be[k] = g[0]; }
        }
#pragma unroll
        for (int i = 0; i < 8; ++i) Bs[(hf * 8 + i) * GS + k] = g[i];
    }
    LDS_WAIT();
}
__device__ __forceinline__ void gla_load_gatew(ParamsK p, int l, int h, int dir, int lane, float (&wg)[16], float& bgk) {
    const int k = lane & 31;
    const float* w = (dir ? IN(11) : IN(9)) + (size_t)l * 16 * 192 + h * 32 + k;
#pragma unroll
    for (int i = 0; i < 16; ++i) wg[i] = w[i * 192];
    bgk = ((dir ? IN(12) : IN(10)) + (size_t)l * 192 + h * 32)[k];
}
__device__ __forceinline__ void gla_task(int task, int& bh, int& b, int& h, int& tc, int& rowb, int& vtb, int& tpb) {
    tc = task % NCH; bh = task / NCH; h = bh % 6; b = bh / 6;
    if (tc < 4) { rowb = TL + b * CTXL + tc * 64; vtb = SEQ + tc * 64; tpb = -1; }
    else { rowb = b * SEQ + (tc - 4) * 64; vtb = (tc - 4) * 64; tpb = (tc - 4) * 64; }
}
__device__ __forceinline__ void gla_state_ops(const float* ks, const float* Bs, const float* Be, int fr, int fq, bf16x4 (&ke)[2], f32x4 (&dec)[2]) {
#pragma unroll
    for (int kb = 0; kb < 2; ++kb) { const int kidx = kb * 16 + fr; const float be = Be[kidx]; float e[4];
#pragma unroll
        for (int j = 0; j < 4; ++j) e[j] = ks[(fq * 4 + j) * GS + kidx] * __expf(be - Bs[(fq * 4 + j) * GS + kidx]);
        u32x2 w; w.x = pk2(e[0], e[1]); w.y = pk2(e[2], e[3]); ke[kb] = as_bf16x4(w);
        const f32x4 bv = *(const f32x4*)(Be + kb * 16 + fq * 4);
        dec[kb] = (f32x4){__expf(bv[0]), __expf(bv[1]), __expf(bv[2]), __expf(bv[3])}; }
}
__device__ __forceinline__ void gla_step1(ParamsK p, int l, unsigned char* smem) {
    const int tid = otid(), lane = tid & 63, wave = __builtin_amdgcn_readfirstlane(tid >> 6), fr = lane & 15, fq = lane >> 4;
    float* qs = (float*)(smem + wave * 16384); float* ks = qs + 16 * GS; float* Bs = ks + 16 * GS; float* Be = Bs + 16 * GS;
    const bf16_t* U = (const bf16_t*)(WSP + WS_U); const float* rope = (const float*)(WSP + WS_ROPE); const bf16_t* VTG = (const bf16_t*)(WSP + WS_VTG);
    float* SL = (float*)(WSP + WS_SL); float* DEC = (float*)(WSP + WS_DEC);
    const int gw = wave * gridDim.x + blockIdx.x, NGW = gridDim.x * 8;
    for (int task = gw; task < 48 * NCH; task += NGW) {
        int bh, b, h, tc, rowb, vtb, tpb; gla_task(task, bh, b, h, tc, rowb, vtb, tpb);
        for (int dir = 0; dir < 2; ++dir) {
            const int c = dir == 0 ? tc : (tc < 4 ? 3 - tc : 135 - tc);
            float wg[16], bgk; gla_load_gatew(p, l, h, dir, lane, wg, bgk);
            f32x4 S[2][4];
#pragma unroll
            for (int kb = 0; kb < 2; ++kb)
#pragma unroll
                for (int db = 0; db < 4; ++db) S[kb][db] = (f32x4){0.f, 0.f, 0.f, 0.f};
            float bsum = 0.f;
            GlaRaw raw; { const int sc0 = dir ? 3 : 0; gla_stage_load<false>(U, rope, rowb + sc0 * 16, tpb < 0 ? -1 : tpb + sc0 * 16, h, dir, lane, raw); }
            for (int si = 0; si < 4; ++si) {
                const int sc = dir ? 3 - si : si;
                bf16x4 vt[4];
#pragma unroll
                for (int db = 0; db < 4; ++db) vt[db] = as_bf16x4(*(const u32x2*)(VTG + (size_t)(bh * 64 + db * 16 + fr) * VTW + vtb + sc * 16 + fq * 4));
                gla_stage16<false>(raw, qs, ks, Bs, Be, tpb, dir, wg, bgk, lane);
                if (si < 3) { const int scn = dir ? 2 - si : si + 1; gla_stage_load<false>(U, rope, rowb + scn * 16, tpb < 0 ? -1 : tpb + scn * 16, h, dir, lane, raw); }
                bf16x4 ke[2]; f32x4 dec[2]; gla_state_ops(ks, Bs, Be, fr, fq, ke, dec);
                bsum += Be[lane & 31];
#pragma unroll
                for (int kb = 0; kb < 2; ++kb)
#pragma unroll
                    for (int db = 0; db < 4; ++db) S[kb][db] = __builtin_amdgcn_mfma_f32_16x16x16bf16_1k(ke[kb], vt[db], S[kb][db] * dec[kb], 0, 0, 0);
                LDS_WAIT();
            }
            float* so = SL + ((size_t)(bh * 2 + dir) * NCH + c) * 2048;
#pragma unroll
            for (int kb = 0; kb < 2; ++kb)
#pragma unroll
                for (int db = 0; db < 4; ++db)
#pragma unroll
                    for (int j = 0; j < 4; ++j) so[(kb * 16 + fq * 4 + j) * 64 + db * 16 + fr] = S[kb][db][j];
            if (lane < 32) DEC[((size_t)(bh * 2 + dir) * NCH + c) * 32 + lane] = __expf(bsum);
        }
    }
}
__device__ __forceinline__ void gla_step2(ParamsK p) {
    float* SL = (float*)(WSP + WS_SL); const float* DEC = (const float*)(WSP + WS_DEC);
    const int gt = blockIdx.x * 512 + otid(), NGT = gridDim.x * 512;
    for (int e = gt; e < 96 * 2048; e += NGT) {
        const int bhd = e >> 11, kd = e & 2047, k = kd >> 6;
        float* sp = SL + (size_t)bhd * NCH * 2048 + kd; const float* dp = DEC + (size_t)bhd * NCH * 32 + k;
        float s = 0.f;
        for (int c0 = 0; c0 < NCH; c0 += 12) {
            float loc[12], dd[12];
#pragma unroll
            for (int j = 0; j < 12; ++j) { loc[j] = sp[(size_t)(c0 + j) * 2048]; dd[j] = dp[(c0 + j) * 32]; }
#pragma unroll
            for (int j = 0; j < 12; ++j) { sp[(size_t)(c0 + j) * 2048] = s; s = dd[j] * s + loc[j]; }
        }
    }
}
__device__ __forceinline__ void gla_step3(ParamsK p, int l, unsigned char* smem) {
    const int tid = otid(), lane = tid & 63, wave = __builtin_amdgcn_readfirstlane(tid >> 6), fr = lane & 15, fq = lane >> 4;
    float* qs = (float*)(smem + wave * 16384); float* ks = qs + 16 * GS; float* Bs = ks + 16 * GS; float* Be = Bs + 16 * GS;
    const bf16_t* U = (const bf16_t*)(WSP + WS_U); const float* rope = (const float*)(WSP + WS_ROPE); const bf16_t* VTG = (const bf16_t*)(WSP + WS_VTG);
    const float* SL = (const float*)(WSP + WS_SL); float* OG = (float*)(WSP + WS_OG);
    bf16_t* MIX = (bf16_t*)(WSP + WS_H);
    const float* ngp = IN(13) + l * 64;
    const int gw = wave * gridDim.x + blockIdx.x, NGW = gridDim.x * 8;
    for (int task = gw; task < 48 * NCH; task += NGW) {
        int bh, b, h, tc, rowb, vtb, tpb; gla_task(task, bh, b, h, tc, rowb, vtb, tpb);
        for (int dir = 0; dir < 2; ++dir) {
            const int c = dir == 0 ? tc : (tc < 4 ? 3 - tc : 135 - tc);
            float wg[16], bgk; gla_load_gatew(p, l, h, dir, lane, wg, bgk);
            f32x4 S[2][4];
            const float* si_ = SL + ((size_t)(bh * 2 + dir) * NCH + c) * 2048;
#pragma unroll
            for (int kb = 0; kb < 2; ++kb)
#pragma unroll
                for (int db = 0; db < 4; ++db)
#pragma unroll
                    for (int j = 0; j < 4; ++j) S[kb][db][j] = si_[(kb * 16 + fq * 4 + j) * 64 + db * 16 + fr];
            GlaRaw raw; { const int sc0 = dir ? 3 : 0; gla_stage_load<true>(U, rope, rowb + sc0 * 16, tpb < 0 ? -1 : tpb + sc0 * 16, h, dir, lane, raw); }
            for (int si = 0; si < 4; ++si) {
                const int sc = dir ? 3 - si : si;
                const int row = rowb + sc * 16 + fr;
                bf16x4 vt[4];
#pragma unroll
                for (int db = 0; db < 4; ++db) vt[db] = as_bf16x4(*(const u32x2*)(VTG + (size_t)(bh * 64 + db * 16 + fr) * VTW + vtb + sc * 16 + fq * 4));
                f32x4 og[4]; u32x2 rgw[4];
                if (dir == 1) {
#pragma unroll
                    for (int db = 0; db < 4; ++db) { og[db] = *(const f32x4*)(OG + (size_t)row * 384 + h * 64 + db * 16 + fq * 4);
                        rgw[db] = *(const u32x2*)(U + (size_t)row * INP + R0 + h * 64 + db * 16 + fq * 4); }
                }
                gla_stage16<true>(raw, qs, ks, Bs, Be, tpb, dir, wg, bgk, lane);
                if (si < 3) { const int scn = dir ? 2 - si : si + 1; gla_stage_load<true>(U, rope, rowb + scn * 16, tpb < 0 ? -1 : tpb + scn * 16, h, dir, lane, raw); }
                const f32x4 ba = *(const f32x4*)(Bs + fr * GS + fq * 4), bb = *(const f32x4*)(Bs + fr * GS + 16 + fq * 4);
                const f32x4 qa = *(const f32x4*)(qs + fr * GS + fq * 4), qb = *(const f32x4*)(qs + fr * GS + 16 + fq * 4);
                const f32x4 ka = *(const f32x4*)(ks + fr * GS + fq * 4), kc = *(const f32x4*)(ks + fr * GS + 16 + fq * 4);
                u32x4 qw, kw;
                qw.x = pk2(qa[0] * __expf(ba[0]), qa[1] * __expf(ba[1])); qw.y = pk2(qa[2] * __expf(ba[2]), qa[3] * __expf(ba[3]));
                qw.z = pk2(qb[0] * __expf(bb[0]), qb[1] * __expf(bb[1])); qw.w = pk2(qb[2] * __expf(bb[2]), qb[3] * __expf(bb[3]));
                kw.x = pk2(ka[0] * __expf(-ba[0]), ka[1] * __expf(-ba[1])); kw.y = pk2(ka[2] * __expf(-ba[2]), ka[3] * __expf(-ba[3]));
                kw.z = pk2(kc[0] * __expf(-bb[0]), kc[1] * __expf(-bb[1])); kw.w = pk2(kc[2] * __expf(-bb[2]), kc[3] * __expf(-bb[3]));
                const bf16x8 Qd = as_bf16x8(qw), Kd = as_bf16x8(kw);
                bf16x4 ke[2]; f32x4 dec[2]; gla_state_ops(ks, Bs, Be, fr, fq, ke, dec);
                f32x4 AT = __builtin_amdgcn_mfma_f32_16x16x32_bf16(Kd, Qd, (f32x4){0.f, 0.f, 0.f, 0.f}, 0, 0, 0);
#pragma unroll
                for (int j = 0; j < 4; ++j) { const int pp = fq * 4 + j; const bool keep = dir == 0 ? (pp <= fr) : (pp >= fr); AT[j] = keep ? AT[j] : 0.f; }
                u32x2 aw; aw.x = pk2(AT[0], AT[1]); aw.y = pk2(AT[2], AT[3]);
                const bf16x4 atb = as_bf16x4(aw);
                f32x4 O[4];
#pragma unroll
                for (int db = 0; db < 4; ++db) {
                    const f32x4 Oa = __builtin_amdgcn_mfma_f32_16x16x16bf16_1k(vt[db], atb, (f32x4){0.f, 0.f, 0.f, 0.f}, 0, 0, 0);
                    u32x4 sw; sw.x = pk2(S[0][db][0], S[0][db][1]); sw.y = pk2(S[0][db][2], S[0][db][3]); sw.z = pk2(S[1][db][0], S[1][db][1]); sw.w = pk2(S[1][db][2], S[1][db][3]);
                    const f32x4 Ob = __builtin_amdgcn_mfma_f32_16x16x32_bf16(as_bf16x8(sw), Qd, (f32x4){0.f, 0.f, 0.f, 0.f}, 0, 0, 0);
                    O[db] = Oa + Ob;
                }
#pragma unroll
                for (int kb = 0; kb < 2; ++kb)
#pragma unroll
                    for (int db = 0; db < 4; ++db) S[kb][db] = __builtin_amdgcn_mfma_f32_16x16x16bf16_1k(ke[kb], vt[db], S[kb][db] * dec[kb], 0, 0, 0);
                if (dir == 0) {
#pragma unroll
                    for (int db = 0; db < 4; ++db) *(f32x4*)(OG + (size_t)row * 384 + h * 64 + db * 16 + fq * 4) = O[db];
                } else {
                    float ss = 0.f;
#pragma unroll
                    for (int db = 0; db < 4; ++db) { O[db] = O[db] + og[db]; ss += (O[db][0] * O[db][0] + O[db][1] * O[db][1]) + (O[db][2] * O[db][2] + O[db][3] * O[db][3]); }
                    ss += __shfl_xor(ss, 16); ss += __shfl_xor(ss, 32);
                    const float rstd = rsqrtf(ss * (1.f / 64.f) + 1e-6f);
#pragma unroll
                    for (int db = 0; db < 4; ++db) { const f32x4 n4 = *(const f32x4*)(ngp + db * 16 + fq * 4);
                        const float r0 = bflo(rgw[db].x), r1 = bfhi(rgw[db].x), r2 = bflo(rgw[db].y), r3 = bfhi(rgw[db].y);
                        u32x2 w; w.x = pk2(O[db][0] * rstd * n4[0] * silu_f(r0), O[db][1] * rstd * n4[1] * silu_f(r1));
                        w.y = pk2(O[db][2] * rstd * n4[2] * silu_f(r2), O[db][3] * rstd * n4[3] * silu_f(r3));
                        *(u32x2*)(MIX + (size_t)row * DM + h * 64 + db * 16 + fq * 4) = w; }
                }
                LDS_WAIT();
            }
        }
    }
}

__device__ __forceinline__ void prep_phase(ParamsK p) {
    const float* mod = (const float*)(WSP + WS_MOD); float* GSV = (float*)(WSP + WS_GSV); float* BIAS = (float*)(WSP + WS_BIAS);
    const int gt = blockIdx.x * 512 + otid(), NGT = gridDim.x * 512;
    for (int i = gt; i < DEPTH * 2 * 9 * DM; i += NGT) { const int c = i & (DM - 1), r = (i >> 10) % 9, w = (i / (9 * DM)) & 1, l = i / (18 * DM);
        const float g = (w ? IN(7) : IN(6))[l * DM + c], sc = mod[(size_t)(l * 9 + r) * MODW + (w ? 4 : 1) * DM + c];
        GSV[i] = g * (1.f + sc); }
    constexpr int NCOL = INP + FF2;
    for (int t = gt; t < DEPTH * NCOL; t += NGT) { const int l = t / NCOL, cc = t % NCOL, w = cc >= INP, n = w ? cc - INP : cc;
        const bf16_t* wrow = w ? (const bf16_t*)(WSP + WS_WUP) + ((size_t)l * FF2 + n) * DM : (const bf16_t*)(WSP + WS_WIN) + ((size_t)l * INP + n) * DM;
        const float* sh = mod + (size_t)l * 9 * MODW + (w ? 3 : 0) * DM;
        float acc[9];
#pragma unroll
        for (int r = 0; r < 9; ++r) acc[r] = 0.f;
        for (int k = 0; k < DM; k += 8) { float wv[8]; unpack8(*(const u32x4*)(wrow + k), wv);
#pragma unroll
            for (int r = 0; r < 9; ++r) { const f32x4 s0 = *(const f32x4*)(sh + (size_t)r * MODW + k), s1 = *(const f32x4*)(sh + (size_t)r * MODW + k + 4);
                acc[r] += (s0[0] * wv[0] + s0[1] * wv[1]) + (s0[2] * wv[2] + s0[3] * wv[3]) + (s1[0] * wv[4] + s1[1] * wv[5]) + (s1[2] * wv[6] + s1[3] * wv[7]); } }
#pragma unroll
        for (int r = 0; r < 9; ++r) BIAS[((size_t)(l * 2 + w) * 9 + r) * FF2 + n] = acc[r]; }
}
__device__ __forceinline__ void stat_zero_phase(ParamsK p) {
    float* STAT = (float*)(WSP + WS_STAT);
    const int gt = blockIdx.x * 512 + otid(), NGT = gridDim.x * 512;
    for (int i = gt; i < 2 * TT; i += NGT) STAT[i] = 0.f;
}

__device__ __forceinline__ void shortconv_phase(ParamsK p, int l) {
    const bf16_t* U = (const bf16_t*)(WSP + WS_U); bf16_t* MIX = (bf16_t*)(WSP + WS_H);
    const float* cw = IN(14) + (size_t)l * 3 * 256; const float* cbias = IN(15) + (size_t)l * 256;
    const int tid = otid(), lane = tid & 63, wave = __builtin_amdgcn_readfirstlane(tid >> 6);
    const int NGW = gridDim.x * 8, gw = wave * gridDim.x + blockIdx.x;
    const int extra = (48 * NCH) % NGW;
    if (gw < extra) return;
    const int gt = (gw - extra) * 64 + lane, NGT = (NGW - extra) * 64;
    for (int task = gt; task < TT * 32; task += NGT) {
        const int R = task >> 5, c = (task & 31) * 8;
        int pos, L; if (R < TL) { pos = R & (SEQ - 1); L = SEQ; } else { pos = (R - TL) & (CTXL - 1); L = CTXL; }
        const bf16_t* ur = U + (size_t)R * INP;
        float bgt[8], cc[8], xx[8], acc[8];
        unpack8(*(const u32x4*)(ur + SB0 + c), bgt);
        unpack8(*(const u32x4*)(ur + SC0 + c), cc); unpack8(*(const u32x4*)(ur + SX0 + c), xx);
#pragma unroll
        for (int i = 0; i < 8; ++i) acc[i] = cbias[c + i] + cw[256 + c + i] * (cc[i] * xx[i]);
        if (pos > 0) { unpack8(*(const u32x4*)(ur - INP + SC0 + c), cc); unpack8(*(const u32x4*)(ur - INP + SX0 + c), xx);
#pragma unroll
            for (int i = 0; i < 8; ++i) acc[i] += cw[c + i] * (cc[i] * xx[i]); }
        if (pos < L - 1) { unpack8(*(const u32x4*)(ur + INP + SC0 + c), cc); unpack8(*(const u32x4*)(ur + INP + SX0 + c), xx);
#pragma unroll
            for (int i = 0; i < 8; ++i) acc[i] += cw[512 + c + i] * (cc[i] * xx[i]); }
        u32x4 w; w.x = pk2(bgt[0] * acc[0], bgt[1] * acc[1]); w.y = pk2(bgt[2] * acc[2], bgt[3] * acc[3]); w.z = pk2(bgt[4] * acc[4], bgt[5] * acc[5]); w.w = pk2(bgt[6] * acc[6], bgt[7] * acc[7]);
        *(u32x4*)(MIX + (size_t)R * DM + 384 + c) = w;
    }
}

__device__ __forceinline__ void vt_phase(ParamsK p, unsigned char* smem) {
    const bf16_t* U = (const bf16_t*)(WSP + WS_U);
    bf16_t* tile = (bf16_t*)smem;
    constexpr int TS = 72, NITEM = (TT / 64) * 12;
    const int tid = otid();
    const int tok = tid >> 3, d8 = (tid & 7) * 8;
    auto src = [&](int item) { const int tt = item / 12, hs = item % 12; const int col0 = hs < 6 ? NV0 + hs * 64 : V0 + (hs - 6) * 64;
        return U + (size_t)(tt * 64 + tok) * INP + col0 + d8; };
    int item = blockIdx.x;
    u32x4 wn = (u32x4){0u, 0u, 0u, 0u};
    if (item < NITEM) wn = *(const u32x4*)src(item);
    for (; item < NITEM; item += gridDim.x) {
        const u32x4 w = wn;
        if (item + (int)gridDim.x < NITEM) wn = *(const u32x4*)src(item + gridDim.x);
        const int tt = item / 12, hs = item % 12, row0 = tt * 64;
        const int h = hs < 6 ? hs : hs - 6;
        bf16_t* VTx = (bf16_t*)(WSP + (hs < 6 ? WS_VT : WS_VTG));
        int b, sp0; if (row0 < TL) { b = row0 >> 13; sp0 = row0 & (SEQ - 1); } else { b = (row0 - TL) >> 8; sp0 = SEQ + ((row0 - TL) & (CTXL - 1)); }
#pragma unroll
        for (int i = 0; i < 4; ++i) { tile[(d8 + 2 * i) * TS + tok] = (bf16_t)(w[i] & 0xffffu); tile[(d8 + 2 * i + 1) * TS + tok] = (bf16_t)(w[i] >> 16); }
        __syncthreads();
        { const int d = tid >> 3, t8 = (tid & 7) * 8;
          const u32x4 o = *(const u32x4*)(tile + d * TS + t8);
          *(u32x4*)(VTx + (size_t)((b * 6 + h) * 64 + d) * VTW + sp0 + t8) = o; }
        __syncthreads();
    }
}

template <int MODE>
__device__ __forceinline__ void na_chunk(const bf16_t* U, const bf16_t* vt, const float* rpbL, const bf16_t* Kc, const bf16_t* Vc, int b, int r, int h, int rs, int kc0, int qcol, int cs,
                                         const bf16x8 bq0, const bf16x8 bq1, float& m_run, float& l_run, f32x4 (&O)[4], int fr, int fq) {
    f32x4 s[16];
    float mx = -1e30f;
#pragma unroll
    for (int kg = 0; kg < 4; ++kg) {
        bf16x8 ka0[4], ka1[4];
#pragma unroll
        for (int i = 0; i < 4; ++i) { const int kb = kg * 4 + i;
            if (MODE == 2) { const bf16_t* kp = Kc + (kb * 16 + fr) * 72 + fq * 8; ka0[i] = as_bf16x8(*(const u32x4*)kp); ka1[i] = as_bf16x8(*(const u32x4*)(kp + 32)); }
            else { const int krow = MODE == 0 ? (b * SEQ + (rs + (kb >> 1)) * 64 + kc0 + (kb & 1) * 16 + fr) : (TL + b * CTXL + kb * 16 + fr);
                const bf16_t* kp = U + (size_t)krow * INP + NK0 + h * 64 + fq * 8; ka0[i] = as_bf16x8(*(const u32x4*)kp); ka1[i] = as_bf16x8(*(const u32x4*)(kp + 32)); } }
        __builtin_amdgcn_sched_barrier(0);
#pragma unroll
        for (int i = 0; i < 4; ++i) { const int kb = kg * 4 + i;
            f32x4 acc = (f32x4){0.f, 0.f, 0.f, 0.f};
            acc = __builtin_amdgcn_mfma_f32_16x16x32_bf16(ka0[i], bq0, acc, 0, 0, 0);
            acc = __builtin_amdgcn_mfma_f32_16x16x32_bf16(ka1[i], bq1, acc, 0, 0, 0);
            acc = acc * 0.125f;
            if (MODE == 0) {
                const int dr = rs + (kb >> 1) - r + 7;
#pragma unroll
                for (int j = 0; j < 4; ++j) { const int kcol = kc0 + (kb & 1) * 16 + fq * 4 + j; const bool valid = (kcol >= cs) && (kcol < cs + 16);
                    const int dc = min(max(kcol - qcol + 15, 0), 30);
                    acc[j] = valid ? acc[j] + rpbL[(h * 15 + dr) * 31 + dc] : -1e30f; }
            }
            s[kb] = acc;
            mx = fmaxf(mx, fmaxf(fmaxf(acc[0], acc[1]), fmaxf(acc[2], acc[3])));
        }
        __builtin_amdgcn_sched_barrier(0);
    }
    mx = fmaxf(mx, __shfl_xor(mx, 16)); mx = fmaxf(mx, __shfl_xor(mx, 32));
    const float m_new = fmaxf(m_run, mx), alpha = __expf(m_run - m_new);
    float lsum = 0.f; unsigned pkd[16][2];
#pragma unroll
    for (int kb = 0; kb < 16; ++kb) { const float p0 = __expf(s[kb][0] - m_new), p1 = __expf(s[kb][1] - m_new), p2 = __expf(s[kb][2] - m_new), p3 = __expf(s[kb][3] - m_new);
        lsum += (p0 + p1) + (p2 + p3); pkd[kb][0] = pk2(p0, p1); pkd[kb][1] = pk2(p2, p3); }
    lsum += __shfl_xor(lsum, 16); lsum += __shfl_xor(lsum, 32);
    l_run = l_run * alpha + lsum; m_run = m_new;
#pragma unroll
    for (int db = 0; db < 4; ++db) O[db] = O[db] * alpha;
#pragma unroll
    for (int pg = 0; pg < 4; ++pg) {
        u32x2 vlo[2][4], vhi[2][4];
#pragma unroll
        for (int i = 0; i < 2; ++i) { const int pr = pg * 2 + i;
            const int posA = MODE == 0 ? ((rs + pr) * 64 + kc0 + fq * 4) : (SEQ + pr * 32 + fq * 4);
#pragma unroll
            for (int db = 0; db < 4; ++db) {
                if (MODE == 2) { const bf16_t* vp = Vc + (db * 16 + fr) * 264 + pr * 32 + fq * 4; vlo[i][db] = *(const u32x2*)vp; vhi[i][db] = *(const u32x2*)(vp + 16); }
                else { const bf16_t* vp = vt + (size_t)(db * 16) * VTW + posA; vlo[i][db] = *(const u32x2*)vp; vhi[i][db] = *(const u32x2*)(vp + 16); } } }
        __builtin_amdgcn_sched_barrier(0);
#pragma unroll
        for (int i = 0; i < 2; ++i) { const int pr = pg * 2 + i;
            u32x4 bw; bw.x = pkd[2 * pr][0]; bw.y = pkd[2 * pr][1]; bw.z = pkd[2 * pr + 1][0]; bw.w = pkd[2 * pr + 1][1];
            const bf16x8 bp = as_bf16x8(bw);
#pragma unroll
            for (int db = 0; db < 4; ++db) { u32x4 aw; aw.x = vlo[i][db].x; aw.y = vlo[i][db].y; aw.z = vhi[i][db].x; aw.w = vhi[i][db].y;
                O[db] = __builtin_amdgcn_mfma_f32_16x16x32_bf16(as_bf16x8(aw), bp, O[db], 0, 0, 0); } }
        __builtin_amdgcn_sched_barrier(0);
    }
}
template <bool CTXLDS>
__device__ __forceinline__ void na_tile(const bf16_t* U, const bf16_t* VT, bf16_t* MIX, const float* rpbL, const bf16_t* Kc, const bf16_t* Vc, bool lat, int b, int r, int c0, int qrow0, int h, int lane) {
    const int fr = lane & 15, fq = lane >> 4;
    const bf16_t* qp = U + (size_t)(qrow0 + fr) * INP + NQ0 + h * 64 + fq * 8;
    const bf16x8 bq0 = as_bf16x8(*(const u32x4*)qp), bq1 = as_bf16x8(*(const u32x4*)(qp + 32));
    float m_run = -1e30f, l_run = 0.f;
    f32x4 O[4];
#pragma unroll
    for (int db = 0; db < 4; ++db) O[db] = (f32x4){0.f, 0.f, 0.f, 0.f};
    const bf16_t* vt = VT + (size_t)((b * 6 + h) * 64 + fr) * VTW;
    const int rs = min(max(r - 4, 0), 120), kc0 = min(max(c0 - 8, 0), 32);
    const int qcol = c0 + fr, cs = min(max(qcol - 8, 0), 48);
    if (lat) na_chunk<0>(U, vt, rpbL, Kc, Vc, b, r, h, rs, kc0, qcol, cs, bq0, bq1, m_run, l_run, O, fr, fq);
    na_chunk<CTXLDS ? 2 : 1>(U, vt, rpbL, Kc, Vc, b, r, h, rs, kc0, qcol, cs, bq0, bq1, m_run, l_run, O, fr, fq);
    const float inv = 1.f / l_run;
    bf16_t* op = MIX + (size_t)(qrow0 + fr) * DM + 640 + h * 64 + fq * 4;
#pragma unroll
    for (int db = 0; db < 4; ++db) { u32x2 w; w.x = pk2(O[db][0] * inv, O[db][1] * inv); w.y = pk2(O[db][2] * inv, O[db][3] * inv); *(u32x2*)(op + db * 16) = w; }
}
__device__ __forceinline__ void na_phase(ParamsK p, int l, unsigned char* smem, bool with_ctx) {
    const int tid = otid(), lane = tid & 63, wave = __builtin_amdgcn_readfirstlane(tid >> 6);
    float* rpbL = (float*)smem;
    bf16_t* Kc = (bf16_t*)(smem + 12288);
    bf16_t* Vc = (bf16_t*)(smem + 12288 + 36864);
    const float* rpb = IN(16) + (size_t)l * 6 * 15 * 31;
    for (int i = tid; i < 6 * 15 * 31; i += 512) rpbL[i] = rpb[i];
    __syncthreads();
    const bf16_t* U = (const bf16_t*)(WSP + WS_U); const bf16_t* VT = (const bf16_t*)(WSP + WS_VT); bf16_t* MIX = (bf16_t*)(WSP + WS_H);
    const int b = blockIdx.x & 7, lw = (blockIdx.x >> 3) * 8 + wave, nlw = (gridDim.x >> 3) * 8;
    const int NL = (SEQ / 16) * 6, NC = with_ctx ? (CTXL / 16) * 6 : 0;
    if (nlw == 256) {
        for (int round = 0; round < NL / 256; ++round) {
            const int w = lw + 256 * round, cq = w & 3, rr = (w >> 2) & 1, h = (w >> 3) % 6, r = (w / 48) * 2 + rr;
            __syncthreads();
#pragma unroll
            for (int i = 0; i < 4; ++i) { const int idx = i * 512 + tid, key = idx >> 3, part = idx & 7;
                *(u32x4*)(Kc + key * 72 + part * 8) = *(const u32x4*)(U + (size_t)(TL + b * CTXL + key) * INP + NK0 + h * 64 + part * 8); }
#pragma unroll
            for (int i = 0; i < 4; ++i) { const int idx = i * 512 + tid, d = idx >> 5, part = idx & 31;
                *(u32x4*)(Vc + d * 264 + part * 8) = *(const u32x4*)(VT + (size_t)((b * 6 + h) * 64 + d) * VTW + SEQ + part * 8); }
            __syncthreads();
            na_tile<true>(U, VT, MIX, rpbL, Kc, Vc, true, b, r, cq * 16, b * SEQ + r * 64 + cq * 16, h, lane);
        }
        for (int w = NL + lw; w < NL + NC; w += nlw) { const int t2 = w - NL, h = t2 % 6, qt = t2 / 6;
            na_tile<false>(U, VT, MIX, rpbL, Kc, Vc, false, b, 0, 0, TL + b * CTXL + qt * 16, h, lane); }
    } else {
        for (int w = lw; w < NL + NC; w += nlw) {
            if (w < NL) { const int cq = w & 3, h = (w >> 2) % 6, r = w / 24;
                na_tile<false>(U, VT, MIX, rpbL, Kc, Vc, true, b, r, cq * 16, b * SEQ + r * 64 + cq * 16, h, lane); }
            else { const int t2 = w - NL, h = t2 % 6, qt = t2 / 6;
                na_tile<false>(U, VT, MIX, rpbL, Kc, Vc, false, b, 0, 0, TL + b * CTXL + qt * 16, h, lane); }
        }
    }
    __syncthreads();
}

__device__ __forceinline__ void convgate_phase(ParamsK p, int l, int hs, int nrows) {
    constexpr int CG_RUN = 96, CG_LA = 6, NCG = FFN / 8;
    const bf16_t* FU = (const bf16_t*)(WSP + WS_FU); bf16_t* ACT = (bf16_t*)(WSP + WS_ACT);
    const float* cw = IN(19) + (size_t)l * 3 * FF2; const float* cb = IN(20) + (size_t)l * FF2;
    const int gt = blockIdx.x * 512 + otid();
    const int cgi = gt % NCG, sl = gt / NCG, c = cgi * 8;
    const int r0 = sl * CG_RUN;
    if (r0 >= nrows) return;
    const int r1 = min(r0 + CG_RUN, nrows);
    float wa[3][8], wb[3][8], ba[8], bb[8];
#pragma unroll
    for (int j = 0; j < 3; ++j)
#pragma unroll
        for (int i = 0; i < 8; ++i) { wa[j][i] = cw[j * FF2 + c + i]; wb[j][i] = cw[j * FF2 + FFN + c + i]; }
#pragma unroll
    for (int i = 0; i < 8; ++i) { ba[i] = cb[c + i]; bb[i] = cb[FFN + c + i]; }
    const bf16_t* ub = FU + c;
    auto seqpos = [&](int lr, int& pos, int& L) { const int Rg = hs + lr; if (Rg < TL) { pos = Rg & (SEQ - 1); L = SEQ; } else { pos = (Rg - TL) & (CTXL - 1); L = CTXL; } };
    float pa[8], pb[8], ca[8], cbv[8];
    { int pos, L; seqpos(r0, pos, L);
      if (pos > 0) { unpack8(*(const u32x4*)(ub + (size_t)(r0 - 1) * FF2), pa); unpack8(*(const u32x4*)(ub + (size_t)(r0 - 1) * FF2 + FFN), pb); }
      else {
#pragma unroll
          for (int i = 0; i < 8; ++i) { pa[i] = 0.f; pb[i] = 0.f; } }
      unpack8(*(const u32x4*)(ub + (size_t)r0 * FF2), ca); unpack8(*(const u32x4*)(ub + (size_t)r0 * FF2 + FFN), cbv); }
    u32x4 ra[CG_LA], rb[CG_LA];
#pragma unroll
    for (int i = 0; i < CG_LA; ++i) { const int lr = min(r0 + 1 + i, nrows - 1); ra[i] = __builtin_nontemporal_load((const u32x4*)(ub + (size_t)lr * FF2)); rb[i] = __builtin_nontemporal_load((const u32x4*)(ub + (size_t)lr * FF2 + FFN)); }
    for (int t = r0; t < r1; t += CG_LA) {
#pragma unroll
        for (int i = 0; i < CG_LA; ++i) {
            const int row = t + i;
            const u32x4 xa = ra[i], xb = rb[i];
            { const int lr = min(row + 1 + CG_LA, nrows - 1); ra[i] = __builtin_nontemporal_load((const u32x4*)(ub + (size_t)lr * FF2)); rb[i] = __builtin_nontemporal_load((const u32x4*)(ub + (size_t)lr * FF2 + FFN)); }
            int pos, L; seqpos(row, pos, L);
            float na[8], nb[8];
            if (pos < L - 1 && row + 1 < nrows) { unpack8(xa, na); unpack8(xb, nb); }
            else {
#pragma unroll
                for (int k = 0; k < 8; ++k) { na[k] = 0.f; nb[k] = 0.f; } }
            if (row < r1) {
                float o[8];
#pragma unroll
                for (int k = 0; k < 8; ++k) { const float a = wa[0][k] * pa[k] + wa[1][k] * ca[k] + wa[2][k] * na[k] + ba[k];
                    const float g = wb[0][k] * pb[k] + wb[1][k] * cbv[k] + wb[2][k] * nb[k] + bb[k];
                    o[k] = silu_f(a) * g; }
                u32x4 w; w.x = pk2(o[0], o[1]); w.y = pk2(o[2], o[3]); w.z = pk2(o[4], o[5]); w.w = pk2(o[6], o[7]);
                *(u32x4*)(ACT + (size_t)row * FFN + c) = w;
            }
            const bool lastOfSeq = (pos == L - 1);
#pragma unroll
            for (int k = 0; k < 8; ++k) { pa[k] = lastOfSeq ? 0.f : ca[k]; pb[k] = lastOfSeq ? 0.f : cbv[k]; }
            if (lastOfSeq && row + 1 < nrows) { unpack8(xa, ca); unpack8(xb, cbv); }
            else {
#pragma unroll
                for (int k = 0; k < 8; ++k) { ca[k] = na[k]; cbv[k] = nb[k]; } }
        }
    }
}

__global__ void __launch_bounds__(512, 2) fwd_megakernel(Params p_unused) {
    extern __shared__ __attribute__((aligned(16))) unsigned char smem[];
    cg::grid_group grid = cg::this_grid();
    __shared__ uint4 xb_words;
    if (threadIdx.x == 0) xb_words = make_uint4(0u, 0u, 0u, 0u);
    __syncthreads();
    XcdBarrier xb; { ParamsK p = getpk(); xb = xcd_barrier_post((unsigned*)(WSP + WS_CTL), (volatile LAS unsigned*)&xb_words); }
    { ParamsK p = getpk(); ada_phase(p, smem); }
    { ParamsK p = getpk(); weights_phase(p, smem); }
    GSYNC();
    { ParamsK p = getpk(); if (OUTP == nullptr) grid.sync(); }
    { ParamsK p = getpk(); prep_phase(p); }
    for (int l = 0; l < DEPTH; ++l) {
        const bool upd = l < DEPTH - 1;
        const int Mout = upd ? TT : TL;
        if (l == 0) {
            { ParamsK p = getpk(); const float* ml = (const float*)(WSP + WS_MOD);
              norm_phase(IN(0), IN(2), IN(6), ml, ml + DM, (bf16_t*)(WSP + WS_H), TT); }
            GSYNC();
            { ParamsK p = getpk(); EpiStore E; E.O = (bf16_t*)(WSP + WS_U); E.ldc = INP;
              run_gemm(smem, (const bf16_t*)(WSP + WS_H), (const bf16_t*)(WSP + WS_WIN), TT, INP, DM, E); }
        } else {
            ParamsK p = getpk(); EpiStoreN E; E.O = (bf16_t*)(WSP + WS_U) + (size_t)HALF0 * INP; E.ldc = INP; E.stat = (const float*)(WSP + WS_STAT); E.bias = (const float*)(WSP + WS_BIAS) + (size_t)(l * 2) * 9 * FF2; E.rowbase = HALF0;
            run_gemm(smem, (const bf16_t*)(WSP + WS_H) + (size_t)HALF0 * DM, (const bf16_t*)(WSP + WS_WIN) + (size_t)l * INP * DM, TT - HALF0, INP, DM, E);
        }
        GSYNC();
        for (int rep = 0; rep < REP_VT; ++rep) { ParamsK p = getpk(); vt_phase(p, smem); }
        GSYNC();
        for (int rep = 0; rep < REP_GLA; ++rep) { ParamsK p = getpk(); gla_step1(p, l, smem); }
        __syncthreads();
        for (int rep = 0; rep < REP_NA; ++rep) { ParamsK p = getpk(); na_phase(p, l, smem, upd); }
        GSYNC();
        { ParamsK p = getpk(); gla_step2(p); }
        GSYNC();
        for (int rep = 0; rep < REP_GLA; ++rep) { ParamsK p = getpk(); gla_step3(p, l, smem); }
        { ParamsK p = getpk(); shortconv_phase(p, l); }
        GSYNC();
        { ParamsK p = getpk(); const float* ml = (const float*)(WSP + WS_MOD) + (size_t)l * 9 * MODW;
          EpiResidN E; E.rin_l = l == 0 ? IN(0) : OUTP; E.rin_c = l == 0 ? IN(2) : (const float*)(WSP + WS_XC); E.rout_l = OUTP; E.rout_c = (float*)(WSP + WS_XC); E.gate = ml + 2 * DM; E.rowbase = 0;
          E.Hn = (bf16_t*)(WSP + WS_H2); E.gs = (const float*)(WSP + WS_GSV) + (size_t)(l * 2 + 1) * 9 * DM; E.stat = (float*)(WSP + WS_STAT) + (size_t)TT * 16;
          run_gemm(smem, (const bf16_t*)(WSP + WS_H), (const bf16_t*)(WSP + WS_WOUT) + (size_t)l * DM * DM, Mout, DM, DM, E); }
        GSYNC();
        for (int half = 0; half < 2; ++half) {
            const int hs = half * HALF0, nr = half == 0 ? HALF0 : Mout - HALF0;
            { ParamsK p = getpk(); EpiStoreN E; E.O = (bf16_t*)(WSP + WS_FU); E.ldc = FF2; E.stat = (const float*)(WSP + WS_STAT) + (size_t)TT * 16; E.bias = (const float*)(WSP + WS_BIAS) + (size_t)(l * 2 + 1) * 9 * FF2; E.rowbase = hs;
              run_gemm(smem, (const bf16_t*)(WSP + WS_H2) + (size_t)hs * DM, (const bf16_t*)(WSP + WS_WUP) + (size_t)l * FF2 * DM, nr, FF2, DM, E); }
            GSYNC();
            for (int rep = 0; rep < REP_CG; ++rep) { ParamsK p = getpk(); convgate_phase(p, l, hs, nr); }
            GSYNC();
            if (upd) { ParamsK p = getpk(); const float* ml = (const float*)(WSP + WS_MOD) + (size_t)l * 9 * MODW;
              EpiResidN E; E.rin_l = OUTP; E.rin_c = (const float*)(WSP + WS_XC); E.rout_l = OUTP; E.rout_c = (float*)(WSP + WS_XC); E.gate = ml + 5 * DM; E.rowbase = hs;
              E.Hn = (bf16_t*)(WSP + WS_H); E.gs = (const float*)(WSP + WS_GSV) + (size_t)((l + 1) * 2) * 9 * DM; E.stat = (float*)(WSP + WS_STAT);
              run_gemm(smem, (const bf16_t*)(WSP + WS_ACT), (const bf16_t*)(WSP + WS_WDN) + (size_t)l * DM * FFN, nr, DM, FFN, E);
              if (half == 1) {
                  EpiStoreN E2; E2.O = (bf16_t*)(WSP + WS_U); E2.ldc = INP; E2.stat = (const float*)(WSP + WS_STAT); E2.bias = (const float*)(WSP + WS_BIAS) + (size_t)((l + 1) * 2) * 9 * FF2; E2.rowbase = 0;
                  run_gemm(smem, (const bf16_t*)(WSP + WS_H), (const bf16_t*)(WSP + WS_WIN) + (size_t)(l + 1) * INP * DM, HALF0, INP, DM, E2, 224); } }
            else { ParamsK p = getpk(); const float* ml = (const float*)(WSP + WS_MOD) + (size_t)l * 9 * MODW;
              EpiResid E; E.rin_l = OUTP; E.rin_c = (const float*)(WSP + WS_XC); E.rout_l = OUTP; E.rout_c = (float*)(WSP + WS_XC); E.gate = ml + 5 * DM; E.rowbase = hs;
              run_gemm(smem, (const bf16_t*)(WSP + WS_ACT), (const bf16_t*)(WSP + WS_WDN) + (size_t)l * DM * FFN, nr, DM, FFN, E); }
        }
        GSYNC();
    }
    { ParamsK p = getpk(); final_norm_phase(OUTP, IN(22)); }
}

extern "C" void kernel_launch(void* const* d_in, const int* in_sizes, int n_in, void* d_out, int out_size, void* d_ws, size_t ws_size, hipStream_t stream) {
    static int grid_blocks = 0;
    if (grid_blocks == 0) {
        if (n_in != 23 || ws_size < WS_NEED) { fprintf(stderr, "kernel_launch: unexpected n_in %d or ws %zu < %zu\n", n_in, ws_size, (size_t)WS_NEED); grid_blocks = -1; return; }
        int dev = 0, cus = 0, per_cu = 0;
        hipGetDevice(&dev);
        hipDeviceGetAttribute(&cus, hipDeviceAttributeMultiprocessorCount, dev);
        if (hipFuncSetAttribute((const void*)fwd_megakernel, hipFuncAttributeMaxDynamicSharedMemorySize, LDS_BYTES) != hipSuccess) { fprintf(stderr, "kernel_launch: hipFuncSetAttribute failed\n"); }
        if (hipOccupancyMaxActiveBlocksPerMultiprocessor(&per_cu, (const void*)fwd_megakernel, 512, LDS_BYTES) != hipSuccess || per_cu < 1) { fprintf(stderr, "kernel_launch: occupancy query gave %d\n", per_cu); per_cu = 1; }
        (void)hipGetLastError();
        grid_blocks = cus * 1;
        if (grid_blocks <= 0) grid_blocks = 256;
    }
    if (grid_blocks < 0) return;
    if (hipMemsetAsync((char*)d_ws + WS_CTL, 0, 16384, stream) != hipSuccess) { fprintf(stderr, "kernel_launch: hipMemsetAsync of the barrier word failed\n"); return; }
    Params p{};
    for (int i = 0; i < 23; ++i) p.in[i] = (const float*)d_in[i];
    p.out = (float*)d_out; p.ws = (unsigned char*)d_ws;
    void* args[] = {&p};
    hipError_t e = hipLaunchCooperativeKernel((const void*)fwd_megakernel, dim3(grid_blocks), dim3(512), args, LDS_BYTES, stream);
    if (e != hipSuccess) fprintf(stderr, "cooperative launch failed: %s (grid %d)\n", hipGetErrorString(e), grid_blocks);
}
```

```cpp
#include <hip/hip_runtime.h>
#include <hip/hip_cooperative_groups.h>
#include <cstdio>
#include <cstdint>
namespace cg = cooperative_groups;
__device__ __forceinline__ int otid() { int t = threadIdx.x; asm volatile("" : "+v"(t)); return t; }
namespace pg8 {
#define PG8_LAS __attribute__((address_space(3)))
typedef unsigned short bf16_t;
typedef short bf16x8 __attribute__((ext_vector_type(8)));
typedef float f32x4 __attribute__((ext_vector_type(4)));
typedef unsigned u32x4 __attribute__((ext_vector_type(4)));
constexpr int BM = 256, BK = 64, HALF = 128, HTB = HALF * BK * 2  , STAGE_BYTES = 8 * HTB, NXCD = 8, WGM = 8;

__host__ __device__ __forceinline__ int lds_byte(int r, int c) { const int st = (r >> 4) * 2 + (c >> 5), rr = r & 15, cc = c & 31, ob = rr * 64 + cc * 2; return st * 1024 + (ob ^ (((ob >> 9) & 1) << 5)); }
__host__ __device__ __forceinline__ void stage_rc(int b, int& R, int& C) { const int st = b / 1024, sb = b % 1024, swz = sb ^ (((sb >> 9) & 1) << 5); R = (st >> 1) * 16 + swz / 64; C = (st & 1) * 32 + (swz % 64) / 2; }
__host__ __device__ __forceinline__ int perm32(int rho) { const int n = rho >> 4, i = rho & 15; return 8 * (i >> 2) + 4 * n + (i & 3); }

struct Unit { int pm, pn; };
struct Gemm { const bf16_t* A; const bf16_t* Bt; int M, N, K; };

struct StaticOrder {
    int nM, nN, nwg, G, c;
    __host__ __device__ void init(int M, int N, int G_, int c_) { nM = M / BM; nN = N / BM; nwg = nM * nN; G = G_; c = c_; }
    __host__ __device__ bool next(int i, Unit& u) const {
        const long L = (long)i * G + c; if (L >= nwg) return false;
        int wgid = (int)L; { const int q = nwg / NXCD, r = nwg % NXCD, xcd = wgid % NXCD, off = wgid / NXCD; wgid = (xcd < r ? xcd * (q + 1) : r * (q + 1) + (xcd - r) * q) + off; }
        const int nig = WGM * nN, gid = wgid / nig, fm = gid * WGM, gsz = (nM - fm) < WGM ? (nM - fm) : WGM;
        u.pm = fm + ((wgid % nig) % gsz); u.pn = (wgid % nig) / gsz; return true;
    }
    __device__ __forceinline__ void a_ready(const Unit&) const {}
    __device__ __forceinline__ void done(const Unit&) const {}
};

typedef float f32x2v_ __attribute__((ext_vector_type(2)));
typedef __bf16 bf16x2v_ __attribute__((ext_vector_type(2)));
__device__ __forceinline__ unsigned cvt_pk_bf16(float lo, float hi) { f32x2v_ v = {lo, hi}; bf16x2v_ b = __builtin_convertvector(v, bf16x2v_); return __builtin_bit_cast(unsigned, b); }
template <class Epi, class Sched, bool ALIGN_EPI = false, bool SP2 = false>
__device__ __forceinline__ void gemm_phase(PG8_LAS unsigned char* lds, const Gemm g, const Sched& S, const Epi& E) {
    const int tid = otid(), wid = __builtin_amdgcn_readfirstlane(tid >> 6), lane = tid & 63, wr = wid >> 2, wc = wid & 3, fr = lane & 15, fq = lane >> 4;
    const int K = g.K, nt = K / BK;
    unsigned voffA[2], voffB[2];
#pragma unroll
    for (int i = 0; i < 2; ++i) { int R, C; stage_rc(tid * 16 + i * 8192, R, C); const int Rb = Epi::PERM ? ((R & ~31) + perm32(R & 31)) : R;
        voffA[i] = (unsigned)(R * K + C) * 2u; voffB[i] = (unsigned)(Rb * K + C) * 2u; }
    const size_t kstep = (size_t)(BK * 2);
    const size_t hstep = (size_t)HALF * K * 2;
    const size_t tstep = 2 * hstep;
    const unsigned ldsw = (unsigned)wid * 1024u;
    const int aoff = lds_byte(wr * 64 + fr, fq * 8), boff = lds_byte(wc * 32 + fr, fq * 8);
#define PG8_SA(b, h) (((b) * 2 + (h)) * HTB)
#define PG8_SB(b, h) ((4 + (b) * 2 + (h)) * HTB)
#define PG8_STAGE(bufoff, gbase, voff) do { _Pragma("unroll") for (int _i = 0; _i < 2; ++_i) \
        __builtin_amdgcn_global_load_lds((const unsigned*)((const char*)(gbase) + (voff)[_i]), (PG8_LAS unsigned*)(lds + (bufoff) + ldsw + _i * 8192), 16, 0, 0); } while (0)
#define PG8_LDA(dst, b, h) do { _Pragma("unroll") for (int m = 0; m < 4; ++m) _Pragma("unroll") for (int k = 0; k < 2; ++k) dst[m][k] = *(const PG8_LAS bf16x8*)(lds + PG8_SA(b, h) + aoff + m * 2048 + k * 1024); } while (0)
#define PG8_LDB(dst, b, h) do { _Pragma("unroll") for (int n = 0; n < 2; ++n) _Pragma("unroll") for (int k = 0; k < 2; ++k) dst[n][k] = *(const PG8_LAS bf16x8*)(lds + PG8_SB(b, h) + boff + n * 2048 + k * 1024); } while (0)
#define PG8_MMA(ai, bj, At, Bt) do { __builtin_amdgcn_s_setprio(1); _Pragma("unroll") for (int m = 0; m < 4; ++m) _Pragma("unroll") for (int n = 0; n < 2; ++n) _Pragma("unroll") for (int k = 0; k < 2; ++k) \
        acc[ai][bj][m][n] = __builtin_amdgcn_mfma_f32_16x16x32_bf16(Bt[n][k], At[m][k], acc[ai][bj][m][n], 0, 0, 0); __builtin_amdgcn_s_setprio(0); } while (0)
#define PG8_WAIT_V(n) asm volatile("s_waitcnt vmcnt(" #n ")" ::: "memory")
#define PG8_WAIT_L(n) asm volatile("s_waitcnt lgkmcnt(" #n ")" ::: "memory")
#define PG8_BAR __builtin_amdgcn_s_barrier()
#define PG8_SCHED __builtin_amdgcn_sched_barrier(0)
    Unit cur, nxt; int ui = 0;
    if (!S.next(0, cur)) return;
    f32x4 acc[2][2][4][2];
#pragma unroll
    for (int a = 0; a < 2; ++a)
#pragma unroll
        for (int b = 0; b < 2; ++b)
#pragma unroll
            for (int m = 0; m < 4; ++m)
#pragma unroll
                for (int n = 0; n < 2; ++n) acc[a][b][m][n] = (f32x4){0.f, 0.f, 0.f, 0.f};
    bf16x8 At[4][2], B0[2][2], B1[2][2];
    const char* cA = (const char*)g.A + (size_t)cur.pm * tstep; const char* cB = (const char*)g.Bt + (size_t)cur.pn * tstep;
    S.a_ready(cur);
    if constexpr (SP2) {
        PG8_STAGE(PG8_SB(0, 0), cB, voffB); PG8_STAGE(PG8_SB(0, 1), cB + hstep, voffB); PG8_STAGE(PG8_SA(0, 0), cA, voffA); PG8_STAGE(PG8_SA(0, 1), cA + hstep, voffA);
        if (wr == 1) PG8_BAR;
        PG8_WAIT_V(2); PG8_BAR;
        PG8_STAGE(PG8_SB(1, 0), cB + kstep, voffB); PG8_STAGE(PG8_SA(1, 0), cA + kstep, voffA); PG8_STAGE(PG8_SB(1, 1), cB + hstep + kstep, voffB);
        PG8_WAIT_V(6); PG8_BAR;
    } else {
        PG8_STAGE(PG8_SB(0, 0), cB, voffB); PG8_STAGE(PG8_SA(0, 0), cA, voffA); PG8_STAGE(PG8_SB(0, 1), cB + hstep, voffB); PG8_STAGE(PG8_SA(0, 1), cA + hstep, voffA);
        if (wr == 1) PG8_BAR;
        PG8_WAIT_V(4); PG8_BAR;
        PG8_STAGE(PG8_SB(1, 0), cB + kstep, voffB); PG8_STAGE(PG8_SA(1, 0), cA + kstep, voffA); PG8_STAGE(PG8_SB(1, 1), cB + hstep + kstep, voffB);
        PG8_WAIT_V(6); PG8_BAR;
    }
    for (;;) {
        const bool has_next = S.next(ui + 1, nxt);
        const char* nA = has_next ? (const char*)g.A + (size_t)nxt.pm * tstep : cA; const char* nB = has_next ? (const char*)g.Bt + (size_t)nxt.pn * tstep : cB;
        for (int t = 0; t < nt; t += 2) {
            const bool last = (t == nt - 2);
            const char* a1 = cA + (size_t)(t + 1) * kstep;
            const char* a2 = last ? nA : cA + (size_t)(t + 2) * kstep; const char* b2 = last ? nB : cB + (size_t)(t + 2) * kstep;
            const char* a3 = a2 + kstep; const char* b3 = b2 + kstep;
            if (last && has_next) S.a_ready(nxt);
            if constexpr (SP2) {
            PG8_LDB(B0, 0, 0); PG8_LDB(B1, 0, 1); PG8_SCHED; PG8_LDA(At, 0, 0); PG8_STAGE(PG8_SA(1, 1), a1 + hstep, voffA);
            PG8_WAIT_V(8); PG8_WAIT_L(0); PG8_BAR; PG8_MMA(0, 0, At, B0); PG8_MMA(0, 1, At, B1); PG8_BAR; PG8_SCHED;
            PG8_LDA(At, 0, 1); PG8_STAGE(PG8_SB(0, 0), b2, voffB); PG8_STAGE(PG8_SB(0, 1), b2 + hstep, voffB); PG8_STAGE(PG8_SA(0, 0), a2, voffA);
            PG8_WAIT_V(8); PG8_WAIT_L(0); PG8_BAR; PG8_MMA(1, 0, At, B0); PG8_MMA(1, 1, At, B1); PG8_BAR; PG8_SCHED;
            PG8_LDB(B0, 1, 0); PG8_LDB(B1, 1, 1); PG8_SCHED; PG8_LDA(At, 1, 0); PG8_STAGE(PG8_SA(0, 1), a2 + hstep, voffA);
            PG8_WAIT_V(8); PG8_WAIT_L(0); PG8_BAR; PG8_MMA(0, 0, At, B0); PG8_MMA(0, 1, At, B1); PG8_BAR; PG8_SCHED;
            PG8_LDA(At, 1, 1); PG8_STAGE(PG8_SB(1, 0), b3, voffB); PG8_STAGE(PG8_SB(1, 1), b3 + hstep, voffB); PG8_STAGE(PG8_SA(1, 0), a3, voffA);
            PG8_WAIT_V(8); PG8_WAIT_L(0); PG8_BAR; PG8_MMA(1, 0, At, B0); PG8_MMA(1, 1, At, B1); PG8_BAR; PG8_SCHED;
            } else {
            PG8_LDB(B0, 0, 0); PG8_SCHED; PG8_LDA(At, 0, 0); PG8_STAGE(PG8_SA(1, 1), a1 + hstep, voffA);
            PG8_WAIT_L(8); PG8_BAR; PG8_WAIT_L(0); PG8_MMA(0, 0, At, B0); PG8_BAR; PG8_SCHED;
            PG8_LDB(B1, 0, 1); PG8_STAGE(PG8_SB(0, 0), b2, voffB);
            PG8_BAR; PG8_WAIT_L(0); PG8_MMA(0, 1, At, B1); PG8_BAR;
            PG8_LDA(At, 0, 1); PG8_STAGE(PG8_SA(0, 0), a2, voffA);
            PG8_BAR; PG8_WAIT_L(0); PG8_MMA(1, 0, At, B0); PG8_BAR; PG8_SCHED;
            PG8_STAGE(PG8_SB(0, 1), b2 + hstep, voffB);
            PG8_WAIT_V(6); PG8_BAR; PG8_MMA(1, 1, At, B1); PG8_BAR;
            PG8_LDB(B0, 1, 0); PG8_SCHED; PG8_LDA(At, 1, 0); PG8_STAGE(PG8_SA(0, 1), a2 + hstep, voffA);
            PG8_WAIT_L(8); PG8_BAR; PG8_WAIT_L(0); PG8_MMA(0, 0, At, B0); PG8_BAR; PG8_SCHED;
            PG8_LDB(B1, 1, 1); PG8_STAGE(PG8_SB(1, 0), b3, voffB);
            PG8_BAR; PG8_WAIT_L(0); PG8_MMA(0, 1, At, B1); PG8_BAR;
            PG8_LDA(At, 1, 1); PG8_STAGE(PG8_SA(1, 0), a3, voffA);
            PG8_BAR; PG8_WAIT_L(0); PG8_MMA(1, 0, At, B0); PG8_BAR; PG8_SCHED;
            PG8_STAGE(PG8_SB(1, 1), b3 + hstep, voffB);
            PG8_WAIT_V(6); PG8_BAR; PG8_MMA(1, 1, At, B1); PG8_BAR;
            }
        }
        if constexpr (ALIGN_EPI) { if (wr == 0) PG8_BAR; }
        if constexpr (!Epi::AFTER_DRAIN) { E(acc, cur, wr, wc, fr, fq); S.done(cur); }
        if (!has_next) break;
#pragma unroll
        for (int a = 0; a < 2; ++a)
#pragma unroll
            for (int b = 0; b < 2; ++b)
#pragma unroll
                for (int m = 0; m < 4; ++m)
#pragma unroll
                    for (int n = 0; n < 2; ++n) acc[a][b][m][n] = (f32x4){0.f, 0.f, 0.f, 0.f};
        cur = nxt; cA = nA; cB = nB; ++ui;
        if constexpr (ALIGN_EPI) { if (wr == 1) PG8_BAR; }
    }
    PG8_WAIT_V(0);
    if constexpr (!ALIGN_EPI) { if (wr == 0) PG8_BAR; }
    PG8_BAR;
    if constexpr (Epi::AFTER_DRAIN) { E.fused(acc, cur, wr, wc, fr, fq, lds, wid, lane); S.done(cur); }
#undef PG8_SA
#undef PG8_SB
#undef PG8_STAGE
#undef PG8_LDA
#undef PG8_LDB
#undef PG8_MMA
#undef PG8_WAIT_V
#undef PG8_WAIT_L
#undef PG8_BAR
#undef PG8_SCHED
}
}

typedef unsigned short bf16_t;
typedef short bf16x8 __attribute__((ext_vector_type(8)));
typedef float f32x4 __attribute__((ext_vector_type(4)));
typedef unsigned u32x4 __attribute__((ext_vector_type(4)));
typedef unsigned u32x2 __attribute__((ext_vector_type(2)));
#define LAS __attribute__((address_space(3)))

constexpr int DM = 1024, NBAT = 8, SEQ = 8192, DEPTH = 4, CTXL = 256;
constexpr int TL = NBAT * SEQ, TC = NBAT * CTXL, TT = TL + TC;
constexpr int INW = 3104, INP = 3328;
constexpr int Q0 = 0, K0 = 192, V0 = 384, GF0 = 768, GB0 = 784, R0 = 800, SB0 = 1184, SC0 = 1440, SX0 = 1696, NQ0 = 1952, NK0 = 2336, NV0 = 2720;
constexpr int FFN = 2816, FF2 = 5632;
constexpr int MODW = 6 * DM;
constexpr int GCH = 128, NSUB = GCH / 16, NCTXC = CTXL / GCH;
constexpr int NCH = (CTXL + SEQ) / GCH;
constexpr int VTW = SEQ + CTXL;
constexpr int HALF0 = 32768;

constexpr size_t WS_WIN = 0;
constexpr size_t WS_WOUT = WS_WIN + (size_t)DEPTH * INP * DM * 2;
constexpr size_t WS_WUP = WS_WOUT + (size_t)DEPTH * DM * DM * 2;
constexpr size_t WS_WDN = WS_WUP + (size_t)DEPTH * FF2 * DM * 2;
constexpr size_t WS_MOD = WS_WDN + (size_t)DEPTH * DM * FFN * 2;
constexpr size_t WS_ROPE = WS_MOD + (size_t)DEPTH * 9 * MODW * 4;
constexpr size_t WS_XC = WS_ROPE + (size_t)SEQ * 32 * 4;
constexpr size_t WS_H = WS_XC + (size_t)TC * DM * 4;
constexpr size_t WS_BIG = WS_H + (size_t)TT * DM * 2;
constexpr size_t WS_U = WS_BIG;
constexpr size_t WS_VT = WS_U + (size_t)TT * INP * 2;
constexpr size_t WS_VTG = WS_VT + (size_t)48 * 64 * VTW * 2;
constexpr size_t WS_SL = WS_VTG + (size_t)48 * 64 * VTW * 2;
constexpr size_t WS_DEC = WS_SL + (size_t)96 * NCH * 2048 * 4;
constexpr size_t WS_OG = WS_DEC + (size_t)96 * NCH * 32 * 4;
constexpr size_t WS_END1 = WS_OG + (size_t)TT * 384 * 4;
constexpr size_t WS_FU = WS_BIG;
constexpr size_t WS_ACT = WS_FU + (size_t)34816 * FF2 * 2;
constexpr size_t WS_END2 = WS_ACT + (size_t)34816 * FFN * 2;
constexpr size_t WS_H2END = (WS_END2 + 4095) / 4096 * 4096 + (size_t)TT * DM * 2;
constexpr size_t WS_CTL = (((WS_END1 > WS_END2 ? WS_END1 : WS_END2) > WS_H2END ? (WS_END1 > WS_END2 ? WS_END1 : WS_END2) : WS_H2END) + 4095) / 4096 * 4096;
constexpr size_t WS_GSV = WS_CTL + 16384;
constexpr size_t WS_BIAS = WS_GSV + (size_t)DEPTH * 2 * 9 * DM * 4;
constexpr size_t WS_STAT = WS_BIAS + (size_t)DEPTH * 2 * 9 * FF2 * 4;
constexpr size_t WS_NEED = WS_STAT + (size_t)2 * TT * 16 * 4 + 4096;
constexpr size_t WS_H2 = (WS_END2 + 4095) / 4096 * 4096;
static_assert(NCH % 11 == 0, "the prefix pass walks the chunks in batches of 11");
static_assert(WS_H2 + (size_t)TT * DM * 2 <= WS_CTL, "H2 overlay must end before the control words");
constexpr int LDS_BYTES = 131072;
#define GSYNC_CG() do { asm volatile("s_waitcnt vmcnt(0)" ::: "memory"); grid.sync(); } while (0)
#define XB_TMO      128
#define XB_XCNT(j)  (256  + 64 * (j))
#define XB_XSUB(j)  (1280 + 64 * (j))
#define XB_XGEN(j)  (2304 + 64 * (j))
#define XB_TOP      3328
#define XB_TOPGEN   3392
#define XCD_BAR_WORDS 3456
#define XB_SPIN_CAP (1u << 18)
__device__ __forceinline__ unsigned xb_ld(unsigned* p)              { return __hip_atomic_load(p, __ATOMIC_RELAXED, __HIP_MEMORY_SCOPE_AGENT); }
__device__ __forceinline__ unsigned xb_add(unsigned* p, unsigned v) { return __hip_atomic_fetch_add(p, v, __ATOMIC_RELAXED, __HIP_MEMORY_SCOPE_AGENT); }
__device__ __forceinline__ unsigned xb_xcc_id() { return (unsigned)__builtin_amdgcn_s_getreg((3 << 11) | 20) & 0xFu; }
#define XB_SPIN(cond, bar) do { unsigned _sp = 0; while (cond) { __builtin_amdgcn_s_sleep(1); \
    if ((++_sp & 255u) == 0u) { if (xb_ld(&(bar)[XB_TMO])) break; if (_sp > XB_SPIN_CAP) { atomicAdd(&(bar)[XB_TMO], 1u); break; } } } } while (0)
struct XcdBarrier { unsigned* bar; unsigned x; volatile LAS unsigned* st; };
__device__ __forceinline__ XcdBarrier xcd_barrier_post(unsigned* bar, volatile LAS unsigned* st) {
    XcdBarrier b; b.bar = bar; b.x = xb_xcc_id(); b.st = st;
    if (threadIdx.x == 0) (void)xb_add(&bar[XB_XCNT(b.x)], 1u);
    return b;
}
__device__ __forceinline__ void xcd_barrier_complete(unsigned* bar, unsigned x, unsigned& nloc, unsigned& nx) {
    const unsigned G = gridDim.x * gridDim.y * gridDim.z;
    unsigned sum, cnt, mine, sp = 0u;
    for (;;) {
        sum = 0u; cnt = 0u; mine = 0u;
#pragma unroll
        for (unsigned j = 0; j < 16; ++j) { const unsigned c = xb_ld(&bar[XB_XCNT(j)]); sum += c; cnt += (c > 0u) ? 1u : 0u; mine = (j == x) ? c : mine; }
        if (sum == G) break;
        __builtin_amdgcn_s_sleep(1);
        if ((++sp & 255u) == 0u) { if (xb_ld(&bar[XB_TMO])) break; if (sp > XB_SPIN_CAP) { atomicAdd(&bar[XB_TMO], 1u); break; } }
    }
    nloc = mine > 0u ? mine : 1u; nx = cnt > 0u ? cnt : 1u;
}
__device__ __forceinline__ void xcd_barrier(const XcdBarrier& b) {
    asm volatile("s_waitcnt vmcnt(0)" ::: "memory");
    __syncthreads();
    if (threadIdx.x == 0) {
        unsigned* bar = b.bar;
        __builtin_amdgcn_s_waitcnt(0);
        unsigned nloc = b.st[0], nx = b.st[1];
        if (nloc == 0u) { xcd_barrier_complete(bar, b.x, nloc, nx); b.st[0] = nloc; b.st[1] = nx; }
        const unsigned old = xb_add(&bar[XB_XSUB(b.x)], 1u);
        const unsigned gen = old / nloc;
        if (old + 1u == (gen + 1u) * nloc) {
            __builtin_amdgcn_fence(__ATOMIC_RELEASE, "agent");
            asm volatile("s_waitcnt vmcnt(0)" ::: "memory");
            const unsigned og = xb_add(&bar[XB_TOP], 1u);
            const unsigned tg = og / nx;
            if (og + 1u == (tg + 1u) * nx) xb_add(&bar[XB_TOPGEN], 1u);
            else XB_SPIN(xb_ld(&bar[XB_TOPGEN]) == tg, bar);
            __builtin_amdgcn_fence(__ATOMIC_ACQUIRE, "agent");
            xb_add(&bar[XB_XGEN(b.x)], 1u);
            asm volatile("s_waitcnt vmcnt(0)" ::: "memory");
        } else {
            XB_SPIN(xb_ld(&bar[XB_XGEN(b.x)]) == gen, bar);
            __builtin_amdgcn_fence(__ATOMIC_ACQUIRE, "agent");
            asm volatile("s_waitcnt vmcnt(0)" ::: "memory");
        }
    }
    __syncthreads();
}
#define GSYNC() xcd_barrier(xb)
#ifndef REP_GLA
#define REP_GLA 1
#endif
#ifndef REP_NA
#define REP_NA 1
#endif
#ifndef REP_CG
#define REP_CG 1
#endif
#ifndef REP_GEMM
#define REP_GEMM 1
#endif
#ifndef REP_NORM
#define REP_NORM 1
#endif
#ifndef REP_VT
#define REP_VT 1
#endif

struct Params {
    const float* in[23];
    float* out;
    unsigned char* ws;
};


typedef const Params __attribute__((address_space(4)))* ParamsK;
__device__ __forceinline__ ParamsK getpk() { ParamsK q = (ParamsK)__builtin_amdgcn_kernarg_segment_ptr(); asm volatile("" : "+s"(q)); return q; }
template <class T> __device__ __forceinline__ T* asglobal(T* q) {
#if defined(__HIP_DEVICE_COMPILE__)
    __builtin_assume(!__builtin_amdgcn_is_shared((const void*)q)); __builtin_assume(!__builtin_amdgcn_is_private((const void*)q));
#endif
    return q; }
#define IN(i) asglobal(p->in[i])
#define WSP asglobal(p->ws)
#define OUTP asglobal(p->out)
__device__ __forceinline__ float bf2f(bf16_t v) { return __uint_as_float(((unsigned)v) << 16); }
__device__ __forceinline__ float bflo(unsigned w) { return __uint_as_float(w << 16); }
__device__ __forceinline__ float bfhi(unsigned w) { return __uint_as_float(w & 0xffff0000u); }
__device__ __forceinline__ unsigned pk2(float lo, float hi) { return pg8::cvt_pk_bf16(lo, hi); }
__device__ __forceinline__ float wave_sum(float v) {
#pragma unroll
    for (int o = 1; o < 64; o <<= 1) v += __shfl_xor(v, o);
    return v;
}
__device__ __forceinline__ float silu_f(float v) { return v * __builtin_amdgcn_rcpf(1.f + __expf(-v)); }
#define LDS_WAIT() asm volatile("s_waitcnt lgkmcnt(0)" ::: "memory")

struct EpiStore {
    static constexpr bool PERM = true, AFTER_DRAIN = false;
    bf16_t* O; int ldc;
    __device__ __forceinline__ void operator()(const f32x4 (&acc)[2][2][4][2], const pg8::Unit& u, int wr, int wc, int fr, int fq) const {
        const int row0 = u.pm * 256 + wr * 64 + fr, col0 = u.pn * 256 + wc * 32 + 8 * fq;
#pragma unroll
        for (int ai = 0; ai < 2; ++ai)
#pragma unroll
            for (int m = 0; m < 4; ++m) { bf16_t* rowp = O + (size_t)(row0 + ai * 128 + m * 16) * ldc + col0;
#pragma unroll
                for (int bj = 0; bj < 2; ++bj) { const f32x4 v0 = acc[ai][bj][m][0], v1 = acc[ai][bj][m][1];
                    u32x4 w; w.x = pk2(v0[0], v0[1]); w.y = pk2(v0[2], v0[3]); w.z = pk2(v1[0], v1[1]); w.w = pk2(v1[2], v1[3]);
                    *(u32x4*)(rowp + bj * 128) = w; } }
    }
};
struct EpiResid {
    static constexpr bool PERM = true, AFTER_DRAIN = false;
    const float* rin_l; const float* rin_c; float* rout_l; float* rout_c; const float* gate; int rowbase;
    __device__ __forceinline__ void operator()(const f32x4 (&acc)[2][2][4][2], const pg8::Unit& u, int wr, int wc, int fr, int fq) const {
#pragma unroll
        for (int ai = 0; ai < 2; ++ai)
#pragma unroll
            for (int m = 0; m < 4; ++m) {
                const int R = rowbase + u.pm * 256 + ai * 128 + wr * 64 + m * 16 + fr;
                const bool islat = R < TL; const int mrow = islat ? (R >> 13) : 8;
                const float* src = islat ? rin_l + (size_t)R * DM : rin_c + (size_t)(R - TL) * DM;
                float* dst = islat ? rout_l + (size_t)R * DM : rout_c + (size_t)(R - TL) * DM;
                const float* gp = gate + (size_t)mrow * MODW;
#pragma unroll
                for (int bj = 0; bj < 2; ++bj)
#pragma unroll
                    for (int n = 0; n < 2; ++n) { const int c = u.pn * 256 + bj * 128 + wc * 32 + 8 * fq + 4 * n;
                        const f32x4 g4 = *(const f32x4*)(gp + c), x4 = *(const f32x4*)(src + c);
                        *(f32x4*)(dst + c) = x4 + g4 * acc[ai][bj][m][n]; } }
    }
};

struct EpiStoreN {
    static constexpr bool PERM = true, AFTER_DRAIN = false;
    bf16_t* O; int ldc; const float* stat; const float* bias; int rowbase;
    __device__ __forceinline__ void operator()(const f32x4 (&acc)[2][2][4][2], const pg8::Unit& u, int wr, int wc, int fr, int fq) const {
        const int row0 = u.pm * 256 + wr * 64 + fr, col0 = u.pn * 256 + wc * 32 + 8 * fq;
        const int Rt = rowbase + u.pm * 256;
        const float* bp = bias + (size_t)(Rt < TL ? (Rt >> 13) : 8) * FF2 + col0;
        f32x4 bv[2][2];
#pragma unroll
        for (int bj = 0; bj < 2; ++bj) { bv[bj][0] = *(const f32x4*)(bp + bj * 128); bv[bj][1] = *(const f32x4*)(bp + bj * 128 + 4); }
#pragma unroll
        for (int ai = 0; ai < 2; ++ai)
#pragma unroll
            for (int m = 0; m < 4; ++m) { const int r = row0 + ai * 128 + m * 16, Rg = rowbase + r;
                const f32x4 q = *(const f32x4*)(stat + (size_t)Rg * 16 + fq * 4);
                float ssq = (q[0] + q[1]) + (q[2] + q[3]); ssq += __shfl_xor(ssq, 16); ssq += __shfl_xor(ssq, 32);
                const float rstd = rsqrtf(ssq * (1.f / DM) + 1e-6f);
                bf16_t* rowp = O + (size_t)r * ldc + col0;
#pragma unroll
                for (int bj = 0; bj < 2; ++bj) { const f32x4 v0 = acc[ai][bj][m][0] * rstd + bv[bj][0], v1 = acc[ai][bj][m][1] * rstd + bv[bj][1];
                    u32x4 w; w.x = pk2(v0[0], v0[1]); w.y = pk2(v0[2], v0[3]); w.z = pk2(v1[0], v1[1]); w.w = pk2(v1[2], v1[3]);
                    *(u32x4*)(rowp + bj * 128) = w; } }
    }
};
struct EpiResidN {
    static constexpr bool PERM = true, AFTER_DRAIN = false;
    const float* rin_l; const float* rin_c; float* rout_l; float* rout_c; const float* gate; int rowbase;
    bf16_t* Hn; const float* gs; float* stat;
    __device__ __forceinline__ void operator()(const f32x4 (&acc)[2][2][4][2], const pg8::Unit& u, int wr, int wc, int fr, int fq) const {
        const int Rt = rowbase + u.pm * 256; const bool islat = Rt < TL; const int mrow = islat ? (Rt >> 13) : 8;
        const float* gp = gate + (size_t)mrow * MODW; const float* gsp = gs + (size_t)mrow * DM;
        f32x4 gv[2][2], sv[2][2];
#pragma unroll
        for (int bj = 0; bj < 2; ++bj) { const int c = u.pn * 256 + bj * 128 + wc * 32 + 8 * fq;
            gv[bj][0] = *(const f32x4*)(gp + c); gv[bj][1] = *(const f32x4*)(gp + c + 4); sv[bj][0] = *(const f32x4*)(gsp + c); sv[bj][1] = *(const f32x4*)(gsp + c + 4); }
#pragma unroll
        for (int ai = 0; ai < 2; ++ai)
#pragma unroll
            for (int m = 0; m < 4; ++m) {
                const int R = rowbase + u.pm * 256 + ai * 128 + wr * 64 + m * 16 + fr;
                const float* src = islat ? rin_l + (size_t)R * DM : rin_c + (size_t)(R - TL) * DM;
                float* dst = islat ? rout_l + (size_t)R * DM : rout_c + (size_t)(R - TL) * DM;
                float ss = 0.f;
#pragma unroll
                for (int bj = 0; bj < 2; ++bj) { const int c = u.pn * 256 + bj * 128 + wc * 32 + 8 * fq;
                    const f32x4 xa = *(const f32x4*)(src + c) + gv[bj][0] * acc[ai][bj][m][0];
                    const f32x4 xb = *(const f32x4*)(src + c + 4) + gv[bj][1] * acc[ai][bj][m][1];
                    *(f32x4*)(dst + c) = xa; *(f32x4*)(dst + c + 4) = xb;
                    ss += (xa[0] * xa[0] + xa[1] * xa[1]) + (xa[2] * xa[2] + xa[3] * xa[3]) + (xb[0] * xb[0] + xb[1] * xb[1]) + (xb[2] * xb[2] + xb[3] * xb[3]);
                    const f32x4 ya = xa * sv[bj][0], yb = xb * sv[bj][1];
                    u32x4 w; w.x = pk2(ya[0], ya[1]); w.y = pk2(ya[2], ya[3]); w.z = pk2(yb[0], yb[1]); w.w = pk2(yb[2], yb[3]);
                    *(u32x4*)(Hn + (size_t)R * DM + c) = w; }
                ss += __shfl_xor(ss, 16); ss += __shfl_xor(ss, 32);
                if (fq == 0) stat[(size_t)R * 16 + u.pn * 4 + wc] = ss;
            }
    }
};

__device__ __forceinline__ const void* uni_ptr(const void* q) { const unsigned long long a = (unsigned long long)q; const unsigned lo = __builtin_amdgcn_readfirstlane((unsigned)a), hi = __builtin_amdgcn_readfirstlane((unsigned)(a >> 32)); return (const void*)(((unsigned long long)hi << 32) | lo); }
template <class Epi>
__device__ __forceinline__ void run_gemm(unsigned char* smem, const bf16_t* A, const bf16_t* Bt, int M, int N, int K, const Epi& E, int crot = 0) {
    pg8::Gemm g; g.A = (const bf16_t*)uni_ptr(A); g.Bt = (const bf16_t*)uni_ptr(Bt); g.M = M; g.N = N; g.K = K;
    pg8::StaticOrder S; S.init(M, N, (int)gridDim.x, (int)((blockIdx.x + crot) % gridDim.x));
    pg8::gemm_phase<Epi, pg8::StaticOrder, true, true>((PG8_LAS unsigned char*)smem, g, S, E);
    __syncthreads();
}

__device__ __forceinline__ void ada_phase(ParamsK p, unsigned char* smem) {
    float* sc = (float*)smem;
    float* red = sc + 9 * 1024;
    const int tid = otid();
    const float* cvec = IN(1); const float* cctx = IN(3); const float* w_ada = IN(4); const float* b_ada = IN(5);
    float* mod = (float*)(WSP + WS_MOD);
    for (int i = tid; i < 9 * 1024; i += 512) { const int r = i >> 10, k = i & 1023; const float v = r < 8 ? cvec[r * 1024 + k] : cctx[k]; sc[i] = v / (1.f + expf(-v)); }
    __syncthreads();
    for (int task = blockIdx.x; task < DEPTH * 96; task += gridDim.x) {
        const int l = task / 96, cb = (task % 96) * 64, cl = tid & 63, ks = tid >> 6;
        const float* w = w_ada + (size_t)l * DM * MODW + cb + cl;
        float acc[9];
#pragma unroll
        for (int r = 0; r < 9; ++r) acc[r] = 0.f;
#pragma unroll 16
        for (int kk = 0; kk < 128; ++kk) { const int k = ks * 128 + kk; const float wv = w[(size_t)k * MODW];
#pragma unroll
            for (int r = 0; r < 9; ++r) acc[r] += sc[r * 1024 + k] * wv; }
#pragma unroll
        for (int r = 0; r < 9; ++r) red[(ks * 9 + r) * 64 + cl] = acc[r];
        __syncthreads();
        for (int o = tid; o < 576; o += 512) { const int r = o >> 6, cc = o & 63; float s = 0.f;
#pragma unroll
            for (int k8 = 0; k8 < 8; ++k8) s += red[(k8 * 9 + r) * 64 + cc];
            mod[(size_t)(l * 9 + r) * MODW + cb + cc] = s + b_ada[l * MODW + cb + cc]; }
        __syncthreads();
    }
}
__device__ __forceinline__ void transpose_item(const float* W, int K, int N, bf16_t* WT, float* scr, int item, int lane) {
    const int nblk = N / 32, kb = item / nblk, nb = item % nblk, k0 = 64 * kb, n0 = 32 * nb;
    float tv[32];
#pragma unroll
    for (int i = 0; i < 32; ++i) { const int kk = 2 * i + (lane >> 5); tv[i] = W[(size_t)(k0 + kk) * N + n0 + (lane & 31)]; }
#pragma unroll
    for (int i = 0; i < 32; ++i) { const int kk = 2 * i + (lane >> 5); scr[kk * 33 + (lane & 31)] = tv[i]; }
    LDS_WAIT();
    const int c = lane & 7;
#pragma unroll
    for (int j = 0; j < 4; ++j) { const int n = (lane >> 3) + 8 * j; const float* s = scr + (8 * c) * 33 + n;
        u32x4 o; o.x = pk2(s[0 * 33], s[1 * 33]); o.y = pk2(s[2 * 33], s[3 * 33]); o.z = pk2(s[4 * 33], s[5 * 33]); o.w = pk2(s[6 * 33], s[7 * 33]);
        *(u32x4*)(WT + (size_t)(n0 + n) * K + k0 + 8 * c) = o; }
    LDS_WAIT();
}
__device__ __forceinline__ void weights_phase(ParamsK p, unsigned char* smem) {
    const int tid = otid(), lane = tid & 63, wave = __builtin_amdgcn_readfirstlane(tid >> 6);
    float* scr = (float*)(smem + wave * 16384);
    const int gw = blockIdx.x * 8 + wave, NGW = gridDim.x * 8;
    constexpr int I_IN = 16 * (INW / 32), I_OUT = 16 * 32, I_UP = 16 * (FF2 / 32), I_DN = (FFN / 64) * 32, I_L = I_IN + I_OUT + I_UP + I_DN;
    for (int it = gw; it < DEPTH * I_L; it += NGW) {
        const int l = it / I_L; int r = it % I_L;
        if (r < I_IN) { transpose_item(IN(8) + (size_t)l * DM * INW, DM, INW, (bf16_t*)(WSP + WS_WIN) + (size_t)l * INP * DM, scr, r, lane); continue; } r -= I_IN;
        if (r < I_OUT) { transpose_item(IN(17) + (size_t)l * DM * DM, DM, DM, (bf16_t*)(WSP + WS_WOUT) + (size_t)l * DM * DM, scr, r, lane); continue; } r -= I_OUT;
        if (r < I_UP) { transpose_item(IN(18) + (size_t)l * DM * FF2, DM, FF2, (bf16_t*)(WSP + WS_WUP) + (size_t)l * FF2 * DM, scr, r, lane); continue; } r -= I_UP;
        transpose_item(IN(21) + (size_t)l * FFN * DM, FFN, DM, (bf16_t*)(WSP + WS_WDN) + (size_t)l * DM * FFN, scr, r, lane);
    }
    const int gt = blockIdx.x * 512 + tid, NGT = gridDim.x * 512;
    constexpr int PADV = (INP - INW) * DM / 8;
    for (int i = gt; i < DEPTH * PADV; i += NGT) { const int l = i / PADV, r = i % PADV;
        *(u32x4*)((bf16_t*)(WSP + WS_WIN) + (size_t)l * INP * DM + (size_t)INW * DM + (size_t)r * 8) = (u32x4){0u, 0u, 0u, 0u}; }
    float* rope = (float*)(WSP + WS_ROPE);
    for (int i = gt; i < SEQ * 16; i += NGT) { const int tok = i >> 4, j = i & 15, f = j & 7;
        const float invf = f == 0 ? 1.0f : f == 1 ? 0.31622776601683794f : f == 2 ? 0.1f : f == 3 ? 0.031622776601683794f : f == 4 ? 0.01f : f == 5 ? 0.0031622776601683794f : f == 6 ? 0.001f : 0.00031622776601683794f;
        const float pos = (float)(j < 8 ? (tok >> 6) : (tok & 63)); const float ang = pos * invf;
        const double a = (double)ang; const double kq = rint(a * 0.15915494309189535); const float rr = (float)(a - kq * 6.283185307179586);
        rope[tok * 32 + j] = cosf(rr); rope[tok * 32 + 16 + j] = sinf(rr); }
}

__device__ __forceinline__ void norm_phase(const float* xl, const float* xc, const float* g, const float* shift, const float* scale, bf16_t* H, int nrows) {
    const int tid = otid(), lane = tid & 63, wave = __builtin_amdgcn_readfirstlane(tid >> 6);
    const int gw = blockIdx.x * 8 + wave, NGW = gridDim.x * 8;
    for (int row0 = gw; row0 < nrows; row0 += 2 * NGW) {
        const int row1 = row0 + NGW; const bool has1 = row1 < nrows; const int rowb = has1 ? row1 : row0;
        const float* srcA = row0 < TL ? xl + (size_t)row0 * DM : xc + (size_t)(row0 - TL) * DM;
        const float* srcB = rowb < TL ? xl + (size_t)rowb * DM : xc + (size_t)(rowb - TL) * DM;
        f32x4 va[4], vb[4]; float sa = 0.f, sb = 0.f;
#pragma unroll
        for (int j = 0; j < 4; ++j) { va[j] = *(const f32x4*)(srcA + lane * 4 + 256 * j); vb[j] = *(const f32x4*)(srcB + lane * 4 + 256 * j); }
#pragma unroll
        for (int j = 0; j < 4; ++j) { sa += (va[j][0] * va[j][0] + va[j][1] * va[j][1]) + (va[j][2] * va[j][2] + va[j][3] * va[j][3]);
            sb += (vb[j][0] * vb[j][0] + vb[j][1] * vb[j][1]) + (vb[j][2] * vb[j][2] + vb[j][3] * vb[j][3]); }
#pragma unroll
        for (int o = 1; o < 64; o <<= 1) { sa += __shfl_xor(sa, o); sb += __shfl_xor(sb, o); }
        const float rstdA = rsqrtf(sa * (1.f / DM) + 1e-6f), rstdB = rsqrtf(sb * (1.f / DM) + 1e-6f);
        const int mA = row0 < TL ? (row0 >> 13) : 8, mB = rowb < TL ? (rowb >> 13) : 8;
#pragma unroll
        for (int j = 0; j < 4; ++j) { const int c = lane * 4 + 256 * j;
            const f32x4 g4 = *(const f32x4*)(g + c);
            { const f32x4 s4 = *(const f32x4*)(scale + (size_t)mA * MODW + c), h4 = *(const f32x4*)(shift + (size_t)mA * MODW + c);
              const f32x4 y = (va[j] * rstdA * g4) * (s4 + 1.f) + h4;
              u32x2 w; w.x = pk2(y[0], y[1]); w.y = pk2(y[2], y[3]); *(u32x2*)(H + (size_t)row0 * DM + c) = w; }
            if (has1) { const f32x4 s4 = *(const f32x4*)(scale + (size_t)mB * MODW + c), h4 = *(const f32x4*)(shift + (size_t)mB * MODW + c);
              const f32x4 y = (vb[j] * rstdB * g4) * (s4 + 1.f) + h4;
              u32x2 w; w.x = pk2(y[0], y[1]); w.y = pk2(y[2], y[3]); *(u32x2*)(H + (size_t)row1 * DM + c) = w; }
        }
    }
}
__device__ __forceinline__ void final_norm_phase(float* x, const float* g) {
    const int tid = otid(), lane = tid & 63, wave = __builtin_amdgcn_readfirstlane(tid >> 6);
    const int gw = blockIdx.x * 8 + wave, NGW = gridDim.x * 8;
    for (int row = gw; row < TL; row += NGW) {
        float* src = x + (size_t)row * DM;
        f32x4 v[4]; float ss = 0.f;
#pragma unroll
        for (int j = 0; j < 4; ++j) { v[j] = *(const f32x4*)(src + lane * 4 + 256 * j); ss += (v[j][0] * v[j][0] + v[j][1] * v[j][1]) + (v[j][2] * v[j][2] + v[j][3] * v[j][3]); }
        const float rstd = rsqrtf(wave_sum(ss) * (1.f / DM) + 1e-6f);
#pragma unroll
        for (int j = 0; j < 4; ++j) { const int c = lane * 4 + 256 * j; const f32x4 g4 = *(const f32x4*)(g + c); *(f32x4*)(src + c) = v[j] * rstd * g4; }
    }
}

typedef short bf16x4 __attribute__((ext_vector_type(4)));
constexpr int GS = 36;
__device__ __forceinline__ bf16x4 as_bf16x4(u32x2 w) { union { u32x2 u; bf16x4 b; } c; c.u = w; return c.b; }
__device__ __forceinline__ bf16x8 as_bf16x8(u32x4 w) { union { u32x4 u; bf16x8 b; } c; c.u = w; return c.b; }
__device__ __forceinline__ void unpack8(const u32x4 w, float (&f)[8]) {
#pragma unroll
    for (int i = 0; i < 4; ++i) { f[2 * i] = bflo(w[i]); f[2 * i + 1] = bfhi(w[i]); }
}
struct GlaRaw { u32x4 kraw, qraw; f32x4 cs, sn; u32x2 graw; };
template <bool NEEDQ>
__device__ __forceinline__ void gla_stage_load(const bf16_t* U, const float* rope, int row0, int tpos0, int h, int dir, int lane, GlaRaw& R) {
    const int tok = lane >> 2, qr = lane & 3;
    const bf16_t* ur = U + (size_t)(row0 + tok) * INP + h * 32 + qr * 8;
    R.kraw = *(const u32x4*)(ur + K0);
    if (NEEDQ) R.qraw = *(const u32x4*)(ur + Q0);
    if (tpos0 >= 0) { const float* rp = rope + (size_t)(tpos0 + tok) * 32 + qr * 4; R.cs = *(const f32x4*)rp; R.sn = *(const f32x4*)(rp + 16); }
    R.graw = *(const u32x2*)(U + (size_t)(row0 + tok) * INP + (dir ? GB0 : GF0) + qr * 4);
}
template <bool NEEDQ>
__device__ __forceinline__ void gla_stage16(const GlaRaw& R, float* qs, float* ks, float* Bs, float* Be, int tpos0, int dir, const float (&wg)[16], float bgk, int lane) {
    {
        const int tok = lane >> 2, qr = lane & 3;
        float kk[8], qq[8];
        unpack8(R.kraw, kk);
        if (NEEDQ) { unpack8(R.qraw, qq);
#pragma unroll
            for (int i = 0; i < 8; ++i) qq[i] *= 0.17677669529663687f; }
        if (tpos0 >= 0) { const f32x4 cs = R.cs, sn = R.sn;
#pragma unroll
            for (int i = 0; i < 4; ++i) { const float a = kk[2 * i] * cs[i] - kk[2 * i + 1] * sn[i], b2 = kk[2 * i] * sn[i] + kk[2 * i + 1] * cs[i]; kk[2 * i] = a; kk[2 * i + 1] = b2;
                if (NEEDQ) { const float c2 = qq[2 * i] * cs[i] - qq[2 * i + 1] * sn[i], d2 = qq[2 * i] * sn[i] + qq[2 * i + 1] * cs[i]; qq[2 * i] = c2; qq[2 * i + 1] = d2; } } }
        *(f32x4*)(ks + tok * GS + qr * 8) = (f32x4){kk[0], kk[1], kk[2], kk[3]}; *(f32x4*)(ks + tok * GS + qr * 8 + 4) = (f32x4){kk[4], kk[5], kk[6], kk[7]};
        if (NEEDQ) { *(f32x4*)(qs + tok * GS + qr * 8) = (f32x4){qq[0], qq[1], qq[2], qq[3]}; *(f32x4*)(qs + tok * GS + qr * 8 + 4) = (f32x4){qq[4], qq[5], qq[6], qq[7]}; }
    }
    bf16_t* Gs = (bf16_t*)(Be + 64);
    *(u32x2*)(Gs + lane * 4) = R.graw;
    LDS_WAIT();
    {
        const int k = lane & 31, hf = lane >> 5;
        float g[8];
#pragma unroll
        for (int i = 0; i < 8; ++i) {
            const u32x4 ga = *(const u32x4*)(Gs + (hf * 8 + i) * 16), gb = *(const u32x4*)(Gs + (hf * 8 + i) * 16 + 8);
            float x = bgk;
#pragma unroll
            for (int j = 0; j < 4; ++j) { x += bflo(ga[j]) * wg[2 * j] + bfhi(ga[j]) * wg[2 * j + 1]; }
#pragma unroll
            for (int j = 0; j < 4; ++j) { x += bflo(gb[j]) * wg[8 + 2 * j] + bfhi(gb[j]) * wg[8 + 2 * j + 1]; }
            g[i] = (fminf(x, 0.f) - __logf(1.f + __expf(-fabsf(x)))) * 0.0625f;
        }
        if (dir == 0) {
#pragma unroll
            for (int i = 1; i < 8; ++i) g[i] += g[i - 1];
            const float other = __shfl_xor(g[7], 32);
            if (hf == 1) {
#pragma unroll
                for (int i = 0; i < 8; ++i) g[i] += other;
                Be[k] = g[7]; }
        } else {
#pragma unroll
            for (int i = 6; i >= 0; --i) g[i] += g[i + 1];
            const float other = __shfl_xor(g[0], 32);
            if (hf == 0) {
#pragma unroll
                for (int i = 0; i < 8; ++i) g[i] += other;
                Be[k] = g[0]; }
        }
#pragma unroll
        for (int i = 0; i < 8; ++i) Bs[(hf * 8 + i) * GS + k] = g[i];
    }
    LDS_WAIT();
}
__device__ __forceinline__ void gla_load_gatew(ParamsK p, int l, int h, int dir, int lane, float (&wg)[16], float& bgk) {
    const int k = lane & 31;
    const float* w = (dir ? IN(11) : IN(9)) + (size_t)l * 16 * 192 + h * 32 + k;
#pragma unroll
    for (int i = 0; i < 16; ++i) wg[i] = w[i * 192];
    bgk = ((dir ? IN(12) : IN(10)) + (size_t)l * 192 + h * 32)[k];
}
__device__ __forceinline__ void gla_task(int task, int& bh, int& b, int& h, int& tc, int& rowb, int& vtb, int& tpb) {
    tc = task % NCH; bh = task / NCH; h = bh % 6; b = bh / 6;
    if (tc < NCTXC) { rowb = TL + b * CTXL + tc * GCH; vtb = SEQ + tc * GCH; tpb = -1; }
    else { rowb = b * SEQ + (tc - NCTXC) * GCH; vtb = (tc - NCTXC) * GCH; tpb = (tc - NCTXC) * GCH; }
}
__device__ __forceinline__ void gla_state_ops(const float* ks, const float* Bs, const float* Be, int fr, int fq, bf16x4 (&ke)[2], f32x4 (&dec)[2]) {
#pragma unroll
    for (int kb = 0; kb < 2; ++kb) { const int kidx = kb * 16 + fr; const float be = Be[kidx]; float e[4];
#pragma unroll
        for (int j = 0; j < 4; ++j) e[j] = ks[(fq * 4 + j) * GS + kidx] * __expf(be - Bs[(fq * 4 + j) * GS + kidx]);
        u32x2 w; w.x = pk2(e[0], e[1]); w.y = pk2(e[2], e[3]); ke[kb] = as_bf16x4(w);
        const f32x4 bv = *(const f32x4*)(Be + kb * 16 + fq * 4);
        dec[kb] = (f32x4){__expf(bv[0]), __expf(bv[1]), __expf(bv[2]), __expf(bv[3])}; }
}
__device__ __forceinline__ void gla_step1(ParamsK p, int l, unsigned char* smem) {
    const int tid = otid(), lane = tid & 63, wave = __builtin_amdgcn_readfirstlane(tid >> 6), fr = lane & 15, fq = lane >> 4;
    float* qs = (float*)(smem + wave * 16384); float* ks = qs + 16 * GS; float* Bs = ks + 16 * GS; float* Be = Bs + 16 * GS;
    const bf16_t* U = (const bf16_t*)(WSP + WS_U); const float* rope = (const float*)(WSP + WS_ROPE); const bf16_t* VTG = (const bf16_t*)(WSP + WS_VTG);
    float* SL = (float*)(WSP + WS_SL); float* DEC = (float*)(WSP + WS_DEC);
    const int gw = wave * gridDim.x + blockIdx.x, NGW = gridDim.x * 8;
    for (int task = gw; task < 48 * NCH; task += NGW) {
        int bh, b, h, tc, rowb, vtb, tpb; gla_task(task, bh, b, h, tc, rowb, vtb, tpb);
        for (int dir = 0; dir < 2; ++dir) {
            const int c = dir == 0 ? tc : (tc < NCTXC ? NCTXC - 1 - tc : (NCH - 1 + NCTXC) - tc);
            float wg[16], bgk; gla_load_gatew(p, l, h, dir, lane, wg, bgk);
            f32x4 S[2][4];
#pragma unroll
            for (int kb = 0; kb < 2; ++kb)
#pragma unroll
                for (int db = 0; db < 4; ++db) S[kb][db] = (f32x4){0.f, 0.f, 0.f, 0.f};
            float bsum = 0.f;
            GlaRaw raw; { const int sc0 = dir ? NSUB - 1 : 0; gla_stage_load<false>(U, rope, rowb + sc0 * 16, tpb < 0 ? -1 : tpb + sc0 * 16, h, dir, lane, raw); }
            for (int si = 0; si < NSUB; ++si) {
                const int sc = dir ? NSUB - 1 - si : si;
                bf16x4 vt[4];
#pragma unroll
                for (int db = 0; db < 4; ++db) vt[db] = as_bf16x4(*(const u32x2*)(VTG + (size_t)(bh * 64 + db * 16 + fr) * VTW + vtb + sc * 16 + fq * 4));
                gla_stage16<false>(raw, qs, ks, Bs, Be, tpb, dir, wg, bgk, lane);
                if (si < NSUB - 1) { const int scn = dir ? NSUB - 2 - si : si + 1; gla_stage_load<false>(U, rope, rowb + scn * 16, tpb < 0 ? -1 : tpb + scn * 16, h, dir, lane, raw); }
                bf16x4 ke[2]; f32x4 dec[2]; gla_state_ops(ks, Bs, Be, fr, fq, ke, dec);
                bsum += Be[lane & 31];
#pragma unroll
                for (int kb = 0; kb < 2; ++kb)
#pragma unroll
                    for (int db = 0; db < 4; ++db) S[kb][db] = __builtin_amdgcn_mfma_f32_16x16x16bf16_1k(ke[kb], vt[db], S[kb][db] * dec[kb], 0, 0, 0);
                LDS_WAIT();
            }
            float* so = SL + ((size_t)(bh * 2 + dir) * NCH + c) * 2048;
#pragma unroll
            for (int kb = 0; kb < 2; ++kb)
#pragma unroll
                for (int db = 0; db < 4; ++db)
#pragma unroll
                    for (int j = 0; j < 4; ++j) so[(kb * 16 + fq * 4 + j) * 64 + db * 16 + fr] = S[kb][db][j];
            if (lane < 32) DEC[((size_t)(bh * 2 + dir) * NCH + c) * 32 + lane] = __expf(bsum);
        }
    }
}
__device__ __forceinline__ void gla_step2(ParamsK p) {
    float* SL = (float*)(WSP + WS_SL); const float* DEC = (const float*)(WSP + WS_DEC);
    const int gt = blockIdx.x * 512 + otid(), NGT = gridDim.x * 512;
    for (int e = gt; e < 96 * 2048; e += NGT) {
        const int bhd = e >> 11, kd = e & 2047, k = kd >> 6;
        float* sp = SL + (size_t)bhd * NCH * 2048 + kd; const float* dp = DEC + (size_t)bhd * NCH * 32 + k;
        float s = 0.f;
        for (int c0 = 0; c0 < NCH; c0 += 11) {
            float loc[11], dd[11];
#pragma unroll
            for (int j = 0; j < 11; ++j) { loc[j] = sp[(size_t)(c0 + j) * 2048]; dd[j] = dp[(c0 + j) * 32]; }
#pragma unroll
            for (int j = 0; j < 11; ++j) { sp[(size_t)(c0 + j) * 2048] = s; s = dd[j] * s + loc[j]; }
        }
    }
}
__device__ __forceinline__ void gla_step3(ParamsK p, int l, unsigned char* smem) {
    const int tid = otid(), lane = tid & 63, wave = __builtin_amdgcn_readfirstlane(tid >> 6), fr = lane & 15, fq = lane >> 4;
    float* qs = (float*)(smem + wave * 16384); float* ks = qs + 16 * GS; float* Bs = ks + 16 * GS; float* Be = Bs + 16 * GS;
    const bf16_t* U = (const bf16_t*)(WSP + WS_U); const float* rope = (const float*)(WSP + WS_ROPE); const bf16_t* VTG = (const bf16_t*)(WSP + WS_VTG);
    const float* SL = (const float*)(WSP + WS_SL); float* OG = (float*)(WSP + WS_OG);
    bf16_t* MIX = (bf16_t*)(WSP + WS_H);
    const float* ngp = IN(13) + l * 64;
    const int gw = wave * gridDim.x + blockIdx.x, NGW = gridDim.x * 8;
    for (int task = gw; task < 48 * NCH; task += NGW) {
        int bh, b, h, tc, rowb, vtb, tpb; gla_task(task, bh, b, h, tc, rowb, vtb, tpb);
        for (int dir = 0; dir < 2; ++dir) {
            const int c = dir == 0 ? tc : (tc < NCTXC ? NCTXC - 1 - tc : (NCH - 1 + NCTXC) - tc);
            float wg[16], bgk; gla_load_gatew(p, l, h, dir, lane, wg, bgk);
            f32x4 S[2][4];
            const float* si_ = SL + ((size_t)(bh * 2 + dir) * NCH + c) * 2048;
#pragma unroll
            for (int kb = 0; kb < 2; ++kb)
#pragma unroll
                for (int db = 0; db < 4; ++db)
#pragma unroll
                    for (int j = 0; j < 4; ++j) S[kb][db][j] = si_[(kb * 16 + fq * 4 + j) * 64 + db * 16 + fr];
            GlaRaw raw; { const int sc0 = dir ? NSUB - 1 : 0; gla_stage_load<true>(U, rope, rowb + sc0 * 16, tpb < 0 ? -1 : tpb + sc0 * 16, h, dir, lane, raw); }
            for (int si = 0; si < NSUB; ++si) {
                const int sc = dir ? NSUB - 1 - si : si;
                const int row = rowb + sc * 16 + fr;
                bf16x4 vt[4];
#pragma unroll
                for (int db = 0; db < 4; ++db) vt[db] = as_bf16x4(*(const u32x2*)(VTG + (size_t)(bh * 64 + db * 16 + fr) * VTW + vtb + sc * 16 + fq * 4));
                f32x4 og[4]; u32x2 rgw[4];
                if (dir == 1) {
#pragma unroll
                    for (int db = 0; db < 4; ++db) { og[db] = *(const f32x4*)(OG + (size_t)row * 384 + h * 64 + db * 16 + fq * 4);
                        rgw[db] = *(const u32x2*)(U + (size_t)row * INP + R0 + h * 64 + db * 16 + fq * 4); }
                }
                gla_stage16<true>(raw, qs, ks, Bs, Be, tpb, dir, wg, bgk, lane);
                if (si < NSUB - 1) { const int scn = dir ? NSUB - 2 - si : si + 1; gla_stage_load<true>(U, rope, rowb + scn * 16, tpb < 0 ? -1 : tpb + scn * 16, h, dir, lane, raw); }
                const f32x4 ba = *(const f32x4*)(Bs + fr * GS + fq * 4), bb = *(const f32x4*)(Bs + fr * GS + 16 + fq * 4);
                const f32x4 qa = *(const f32x4*)(qs + fr * GS + fq * 4), qb = *(const f32x4*)(qs + fr * GS + 16 + fq * 4);
                const f32x4 ka = *(const f32x4*)(ks + fr * GS + fq * 4), kc = *(const f32x4*)(ks + fr * GS + 16 + fq * 4);
                u32x4 qw, kw;
                qw.x = pk2(qa[0] * __expf(ba[0]), qa[1] * __expf(ba[1])); qw.y = pk2(qa[2] * __expf(ba[2]), qa[3] * __expf(ba[3]));
                qw.z = pk2(qb[0] * __expf(bb[0]), qb[1] * __expf(bb[1])); qw.w = pk2(qb[2] * __expf(bb[2]), qb[3] * __expf(bb[3]));
                kw.x = pk2(ka[0] * __expf(-ba[0]), ka[1] * __expf(-ba[1])); kw.y = pk2(ka[2] * __expf(-ba[2]), ka[3] * __expf(-ba[3]));
                kw.z = pk2(kc[0] * __expf(-bb[0]), kc[1] * __expf(-bb[1])); kw.w = pk2(kc[2] * __expf(-bb[2]), kc[3] * __expf(-bb[3]));
                const bf16x8 Qd = as_bf16x8(qw), Kd = as_bf16x8(kw);
                bf16x4 ke[2]; f32x4 dec[2]; gla_state_ops(ks, Bs, Be, fr, fq, ke, dec);
                f32x4 AT = __builtin_amdgcn_mfma_f32_16x16x32_bf16(Kd, Qd, (f32x4){0.f, 0.f, 0.f, 0.f}, 0, 0, 0);
#pragma unroll
                for (int j = 0; j < 4; ++j) { const int pp = fq * 4 + j; const bool keep = dir == 0 ? (pp <= fr) : (pp >= fr); AT[j] = keep ? AT[j] : 0.f; }
                u32x2 aw; aw.x = pk2(AT[0], AT[1]); aw.y = pk2(AT[2], AT[3]);
                const bf16x4 atb = as_bf16x4(aw);
                f32x4 O[4];
#pragma unroll
                for (int db = 0; db < 4; ++db) {
                    const f32x4 Oa = __builtin_amdgcn_mfma_f32_16x16x16bf16_1k(vt[db], atb, (f32x4){0.f, 0.f, 0.f, 0.f}, 0, 0, 0);
                    u32x4 sw; sw.x = pk2(S[0][db][0], S[0][db][1]); sw.y = pk2(S[0][db][2], S[0][db][3]); sw.z = pk2(S[1][db][0], S[1][db][1]); sw.w = pk2(S[1][db][2], S[1][db][3]);
                    const f32x4 Ob = __builtin_amdgcn_mfma_f32_16x16x32_bf16(as_bf16x8(sw), Qd, (f32x4){0.f, 0.f, 0.f, 0.f}, 0, 0, 0);
                    O[db] = Oa + Ob;
                }
#pragma unroll
                for (int kb = 0; kb < 2; ++kb)
#pragma unroll
                    for (int db = 0; db < 4; ++db) S[kb][db] = __builtin_amdgcn_mfma_f32_16x16x16bf16_1k(ke[kb], vt[db], S[kb][db] * dec[kb], 0, 0, 0);
                if (dir == 0) {
#pragma unroll
                    for (int db = 0; db < 4; ++db) *(f32x4*)(OG + (size_t)row * 384 + h * 64 + db * 16 + fq * 4) = O[db];
                } else {
                    float ss = 0.f;
#pragma unroll
                    for (int db = 0; db < 4; ++db) { O[db] = O[db] + og[db]; ss += (O[db][0] * O[db][0] + O[db][1] * O[db][1]) + (O[db][2] * O[db][2] + O[db][3] * O[db][3]); }
                    ss += __shfl_xor(ss, 16); ss += __shfl_xor(ss, 32);
                    const float rstd = rsqrtf(ss * (1.f / 64.f) + 1e-6f);
#pragma unroll
                    for (int db = 0; db < 4; ++db) { const f32x4 n4 = *(const f32x4*)(ngp + db * 16 + fq * 4);
                        const float r0 = bflo(rgw[db].x), r1 = bfhi(rgw[db].x), r2 = bflo(rgw[db].y), r3 = bfhi(rgw[db].y);
                        u32x2 w; w.x = pk2(O[db][0] * rstd * n4[0] * silu_f(r0), O[db][1] * rstd * n4[1] * silu_f(r1));
                        w.y = pk2(O[db][2] * rstd * n4[2] * silu_f(r2), O[db][3] * rstd * n4[3] * silu_f(r3));
                        *(u32x2*)(MIX + (size_t)row * DM + h * 64 + db * 16 + fq * 4) = w; }
                }
                LDS_WAIT();
            }
        }
    }
}

__device__ __forceinline__ void prep_phase(ParamsK p) {
    const float* mod = (const float*)(WSP + WS_MOD); float* GSV = (float*)(WSP + WS_GSV); float* BIAS = (float*)(WSP + WS_BIAS);
    const int gt = blockIdx.x * 512 + otid(), NGT = gridDim.x * 512;
    for (int i = gt; i < DEPTH * 2 * 9 * DM; i += NGT) { const int c = i & (DM - 1), r = (i >> 10) % 9, w = (i / (9 * DM)) & 1, l = i / (18 * DM);
        const float g = (w ? IN(7) : IN(6))[l * DM + c], sc = mod[(size_t)(l * 9 + r) * MODW + (w ? 4 : 1) * DM + c];
        GSV[i] = g * (1.f + sc); }
    constexpr int NCOL = INP + FF2;
    for (int t = gt; t < DEPTH * NCOL; t += NGT) { const int l = t / NCOL, cc = t % NCOL, w = cc >= INP, n = w ? cc - INP : cc;
        const bf16_t* wrow = w ? (const bf16_t*)(WSP + WS_WUP) + ((size_t)l * FF2 + n) * DM : (const bf16_t*)(WSP + WS_WIN) + ((size_t)l * INP + n) * DM;
        const float* sh = mod + (size_t)l * 9 * MODW + (w ? 3 : 0) * DM;
        float acc[9];
#pragma unroll
        for (int r = 0; r < 9; ++r) acc[r] = 0.f;
        for (int k = 0; k < DM; k += 8) { float wv[8]; unpack8(*(const u32x4*)(wrow + k), wv);
#pragma unroll
            for (int r = 0; r < 9; ++r) { const f32x4 s0 = *(const f32x4*)(sh + (size_t)r * MODW + k), s1 = *(const f32x4*)(sh + (size_t)r * MODW + k + 4);
                acc[r] += (s0[0] * wv[0] + s0[1] * wv[1]) + (s0[2] * wv[2] + s0[3] * wv[3]) + (s1[0] * wv[4] + s1[1] * wv[5]) + (s1[2] * wv[6] + s1[3] * wv[7]); } }
#pragma unroll
        for (int r = 0; r < 9; ++r) BIAS[((size_t)(l * 2 + w) * 9 + r) * FF2 + n] = acc[r]; }
}
__device__ __forceinline__ void stat_zero_phase(ParamsK p) {
    float* STAT = (float*)(WSP + WS_STAT);
    const int gt = blockIdx.x * 512 + otid(), NGT = gridDim.x * 512;
    for (int i = gt; i < 2 * TT; i += NGT) STAT[i] = 0.f;
}

__device__ __forceinline__ void shortconv_phase(ParamsK p, int l) {
    const bf16_t* U = (const bf16_t*)(WSP + WS_U); bf16_t* MIX = (bf16_t*)(WSP + WS_H);
    const float* cw = IN(14) + (size_t)l * 3 * 256; const float* cbias = IN(15) + (size_t)l * 256;
    const int tid = otid(), lane = tid & 63, wave = __builtin_amdgcn_readfirstlane(tid >> 6);
    const int NGW = gridDim.x * 8, gw = wave * gridDim.x + blockIdx.x;
    const int extra = (48 * NCH) % NGW;
    if (gw < extra) return;
    const int gt = (gw - extra) * 64 + lane, NGT = (NGW - extra) * 64;
    for (int task = gt; task < TT * 32; task += NGT) {
        const int R = task >> 5, c = (task & 31) * 8;
        int pos, L; if (R < TL) { pos = R & (SEQ - 1); L = SEQ; } else { pos = (R - TL) & (CTXL - 1); L = CTXL; }
        const bf16_t* ur = U + (size_t)R * INP;
        float bgt[8], cc[8], xx[8], acc[8];
        unpack8(*(const u32x4*)(ur + SB0 + c), bgt);
        unpack8(*(const u32x4*)(ur + SC0 + c), cc); unpack8(*(const u32x4*)(ur + SX0 + c), xx);
#pragma unroll
        for (int i = 0; i < 8; ++i) acc[i] = cbias[c + i] + cw[256 + c + i] * (cc[i] * xx[i]);
        if (pos > 0) { unpack8(*(const u32x4*)(ur - INP + SC0 + c), cc); unpack8(*(const u32x4*)(ur - INP + SX0 + c), xx);
#pragma unroll
            for (int i = 0; i < 8; ++i) acc[i] += cw[c + i] * (cc[i] * xx[i]); }
        if (pos < L - 1) { unpack8(*(const u32x4*)(ur + INP + SC0 + c), cc); unpack8(*(const u32x4*)(ur + INP + SX0 + c), xx);
#pragma unroll
            for (int i = 0; i < 8; ++i) acc[i] += cw[512 + c + i] * (cc[i] * xx[i]); }
        u32x4 w; w.x = pk2(bgt[0] * acc[0], bgt[1] * acc[1]); w.y = pk2(bgt[2] * acc[2], bgt[3] * acc[3]); w.z = pk2(bgt[4] * acc[4], bgt[5] * acc[5]); w.w = pk2(bgt[6] * acc[6], bgt[7] * acc[7]);
        *(u32x4*)(MIX + (size_t)R * DM + 384 + c) = w;
    }
}

__device__ __forceinline__ void vt_phase(ParamsK p, unsigned char* smem) {
    const bf16_t* U = (const bf16_t*)(WSP + WS_U);
    bf16_t* tile = (bf16_t*)smem;
    constexpr int TS = 72, NITEM = (TT / 64) * 12;
    const int tid = otid();
    const int tok = tid >> 3, d8 = (tid & 7) * 8;
    auto src = [&](int item) { const int tt = item / 12, hs = item % 12; const int col0 = hs < 6 ? NV0 + hs * 64 : V0 + (hs - 6) * 64;
        return U + (size_t)(tt * 64 + tok) * INP + col0 + d8; };
    int item = blockIdx.x;
    u32x4 wn = (u32x4){0u, 0u, 0u, 0u};
    if (item < NITEM) wn = *(const u32x4*)src(item);
    for (; item < NITEM; item += gridDim.x) {
        const u32x4 w = wn;
        if (item + (int)gridDim.x < NITEM) wn = *(const u32x4*)src(item + gridDim.x);
        const int tt = item / 12, hs = item % 12, row0 = tt * 64;
        const int h = hs < 6 ? hs : hs - 6;
        bf16_t* VTx = (bf16_t*)(WSP + (hs < 6 ? WS_VT : WS_VTG));
        int b, sp0; if (row0 < TL) { b = row0 >> 13; sp0 = row0 & (SEQ - 1); } else { b = (row0 - TL) >> 8; sp0 = SEQ + ((row0 - TL) & (CTXL - 1)); }
#pragma unroll
        for (int i = 0; i < 4; ++i) { tile[(d8 + 2 * i) * TS + tok] = (bf16_t)(w[i] & 0xffffu); tile[(d8 + 2 * i + 1) * TS + tok] = (bf16_t)(w[i] >> 16); }
        __syncthreads();
        { const int d = tid >> 3, t8 = (tid & 7) * 8;
          const u32x4 o = *(const u32x4*)(tile + d * TS + t8);
          *(u32x4*)(VTx + (size_t)((b * 6 + h) * 64 + d) * VTW + sp0 + t8) = o; }
        __syncthreads();
    }
}

template <int MODE>
__device__ __forceinline__ void na_chunk(const bf16_t* U, const bf16_t* vt, const float* rpbL, const bf16_t* Kc, const bf16_t* Vc, int b, int r, int h, int rs, int kc0, int qcol, int cs,
                                         const bf16x8 bq0, const bf16x8 bq1, float& m_run, float& l_run, f32x4 (&O)[4], int fr, int fq) {
    f32x4 s[16];
    float mx = -1e30f;
#pragma unroll
    for (int kg = 0; kg < 4; ++kg) {
        bf16x8 ka0[4], ka1[4];
#pragma unroll
        for (int i = 0; i < 4; ++i) { const int kb = kg * 4 + i;
            if (MODE == 2) { const bf16_t* kp = Kc + (kb * 16 + fr) * 72 + fq * 8; ka0[i] = as_bf16x8(*(const u32x4*)kp); ka1[i] = as_bf16x8(*(const u32x4*)(kp + 32)); }
            else { const int krow = MODE == 0 ? (b * SEQ + (rs + (kb >> 1)) * 64 + kc0 + (kb & 1) * 16 + fr) : (TL + b * CTXL + kb * 16 + fr);
                const bf16_t* kp = U + (size_t)krow * INP + NK0 + h * 64 + fq * 8; ka0[i] = as_bf16x8(*(const u32x4*)kp); ka1[i] = as_bf16x8(*(const u32x4*)(kp + 32)); } }
        __builtin_amdgcn_sched_barrier(0);
#pragma unroll
        for (int i = 0; i < 4; ++i) { const int kb = kg * 4 + i;
            f32x4 acc = (f32x4){0.f, 0.f, 0.f, 0.f};
            acc = __builtin_amdgcn_mfma_f32_16x16x32_bf16(ka0[i], bq0, acc, 0, 0, 0);
            acc = __builtin_amdgcn_mfma_f32_16x16x32_bf16(ka1[i], bq1, acc, 0, 0, 0);
            acc = acc * 0.125f;
            if (MODE == 0) {
                const int dr = rs + (kb >> 1) - r + 7;
#pragma unroll
                for (int j = 0; j < 4; ++j) { const int kcol = kc0 + (kb & 1) * 16 + fq * 4 + j; const bool valid = (kcol >= cs) && (kcol < cs + 16);
                    const int dc = min(max(kcol - qcol + 15, 0), 30);
                    acc[j] = valid ? acc[j] + rpbL[(h * 15 + dr) * 31 + dc] : -1e30f; }
            }
            s[kb] = acc;
            mx = fmaxf(mx, fmaxf(fmaxf(acc[0], acc[1]), fmaxf(acc[2], acc[3])));
        }
        __builtin_amdgcn_sched_barrier(0);
    }
    mx = fmaxf(mx, __shfl_xor(mx, 16)); mx = fmaxf(mx, __shfl_xor(mx, 32));
    const float m_new = fmaxf(m_run, mx), alpha = __expf(m_run - m_new);
    float lsum = 0.f; unsigned pkd[16][2];
#pragma unroll
    for (int kb = 0; kb < 16; ++kb) { const float p0 = __expf(s[kb][0] - m_new), p1 = __expf(s[kb][1] - m_new), p2 = __expf(s[kb][2] - m_new), p3 = __expf(s[kb][3] - m_new);
        lsum += (p0 + p1) + (p2 + p3); pkd[kb][0] = pk2(p0, p1); pkd[kb][1] = pk2(p2, p3); }
    lsum += __shfl_xor(lsum, 16); lsum += __shfl_xor(lsum, 32);
    l_run = l_run * alpha + lsum; m_run = m_new;
#pragma unroll
    for (int db = 0; db < 4; ++db) O[db] = O[db] * alpha;
#pragma unroll
    for (int pg = 0; pg < 4; ++pg) {
        u32x2 vlo[2][4], vhi[2][4];
#pragma unroll
        for (int i = 0; i < 2; ++i) { const int pr = pg * 2 + i;
            const int posA = MODE == 0 ? ((rs + pr) * 64 + kc0 + fq * 4) : (SEQ + pr * 32 + fq * 4);
#pragma unroll
            for (int db = 0; db < 4; ++db) {
                if (MODE == 2) { const bf16_t* vp = Vc + (db * 16 + fr) * 264 + pr * 32 + fq * 4; vlo[i][db] = *(const u32x2*)vp; vhi[i][db] = *(const u32x2*)(vp + 16); }
                else { const bf16_t* vp = vt + (size_t)(db * 16) * VTW + posA; vlo[i][db] = *(const u32x2*)vp; vhi[i][db] = *(const u32x2*)(vp + 16); } } }
        __builtin_amdgcn_sched_barrier(0);
#pragma unroll
        for (int i = 0; i < 2; ++i) { const int pr = pg * 2 + i;
            u32x4 bw; bw.x = pkd[2 * pr][0]; bw.y = pkd[2 * pr][1]; bw.z = pkd[2 * pr + 1][0]; bw.w = pkd[2 * pr + 1][1];
            const bf16x8 bp = as_bf16x8(bw);
#pragma unroll
            for (int db = 0; db < 4; ++db) { u32x4 aw; aw.x = vlo[i][db].x; aw.y = vlo[i][db].y; aw.z = vhi[i][db].x; aw.w = vhi[i][db].y;
                O[db] = __builtin_amdgcn_mfma_f32_16x16x32_bf16(as_bf16x8(aw), bp, O[db], 0, 0, 0); } }
        __builtin_amdgcn_sched_barrier(0);
    }
}
template <bool CTXLDS>
__device__ __forceinline__ void na_tile(const bf16_t* U, const bf16_t* VT, bf16_t* MIX, const float* rpbL, const bf16_t* Kc, const bf16_t* Vc, bool lat, int b, int r, int c0, int qrow0, int h, int lane) {
    const int fr = lane & 15, fq = lane >> 4;
    const bf16_t* qp = U + (size_t)(qrow0 + fr) * INP + NQ0 + h * 64 + fq * 8;
    const bf16x8 bq0 = as_bf16x8(*(const u32x4*)qp), bq1 = as_bf16x8(*(const u32x4*)(qp + 32));
    float m_run = -1e30f, l_run = 0.f;
    f32x4 O[4];
#pragma unroll
    for (int db = 0; db < 4; ++db) O[db] = (f32x4){0.f, 0.f, 0.f, 0.f};
    const bf16_t* vt = VT + (size_t)((b * 6 + h) * 64 + fr) * VTW;
    const int rs = min(max(r - 4, 0), 120), kc0 = min(max(c0 - 8, 0), 32);
    const int qcol = c0 + fr, cs = min(max(qcol - 8, 0), 48);
    if (lat) na_chunk<0>(U, vt, rpbL, Kc, Vc, b, r, h, rs, kc0, qcol, cs, bq0, bq1, m_run, l_run, O, fr, fq);
    na_chunk<CTXLDS ? 2 : 1>(U, vt, rpbL, Kc, Vc, b, r, h, rs, kc0, qcol, cs, bq0, bq1, m_run, l_run, O, fr, fq);
    const float inv = 1.f / l_run;
    bf16_t* op = MIX + (size_t)(qrow0 + fr) * DM + 640 + h * 64 + fq * 4;
#pragma unroll
    for (int db = 0; db < 4; ++db) { u32x2 w; w.x = pk2(O[db][0] * inv, O[db][1] * inv); w.y = pk2(O[db][2] * inv, O[db][3] * inv); *(u32x2*)(op + db * 16) = w; }
}
__device__ __forceinline__ void na_phase(ParamsK p, int l, unsigned char* smem, bool with_ctx) {
    const int tid = otid(), lane = tid & 63, wave = __builtin_amdgcn_readfirstlane(tid >> 6);
    float* rpbL = (float*)smem;
    bf16_t* Kc = (bf16_t*)(smem + 12288);
    bf16_t* Vc = (bf16_t*)(smem + 12288 + 36864);
    const float* rpb = IN(16) + (size_t)l * 6 * 15 * 31;
    for (int i = tid; i < 6 * 15 * 31; i += 512) rpbL[i] = rpb[i];
    __syncthreads();
    const bf16_t* U = (const bf16_t*)(WSP + WS_U); const bf16_t* VT = (const bf16_t*)(WSP + WS_VT); bf16_t* MIX = (bf16_t*)(WSP + WS_H);
    const int b = blockIdx.x & 7, lw = (blockIdx.x >> 3) * 8 + wave, nlw = (gridDim.x >> 3) * 8;
    const int NL = (SEQ / 16) * 6, NC = with_ctx ? (CTXL / 16) * 6 : 0;
    if (nlw == 256) {
        for (int round = 0; round < NL / 256; ++round) {
            const int w = lw + 256 * round, cq = w & 3, rr = (w >> 2) & 1, h = (w >> 3) % 6, r = (w / 48) * 2 + rr;
            __syncthreads();
#pragma unroll
            for (int i = 0; i < 4; ++i) { const int idx = i * 512 + tid, key = idx >> 3, part = idx & 7;
                *(u32x4*)(Kc + key * 72 + part * 8) = *(const u32x4*)(U + (size_t)(TL + b * CTXL + key) * INP + NK0 + h * 64 + part * 8); }
#pragma unroll
            for (int i = 0; i < 4; ++i) { const int idx = i * 512 + tid, d = idx >> 5, part = idx & 31;
                *(u32x4*)(Vc + d * 264 + part * 8) = *(const u32x4*)(VT + (size_t)((b * 6 + h) * 64 + d) * VTW + SEQ + part * 8); }
            __syncthreads();
            na_tile<true>(U, VT, MIX, rpbL, Kc, Vc, true, b, r, cq * 16, b * SEQ + r * 64 + cq * 16, h, lane);
        }
        for (int w = NL + lw; w < NL + NC; w += nlw) { const int t2 = w - NL, h = t2 % 6, qt = t2 / 6;
            na_tile<false>(U, VT, MIX, rpbL, Kc, Vc, false, b, 0, 0, TL + b * CTXL + qt * 16, h, lane); }
    } else {
        for (int w = lw; w < NL + NC; w += nlw) {
            if (w < NL) { const int cq = w & 3, h = (w >> 2) % 6, r = w / 24;
                na_tile<false>(U, VT, MIX, rpbL, Kc, Vc, true, b, r, cq * 16, b * SEQ + r * 64 + cq * 16, h, lane); }
            else { const int t2 = w - NL, h = t2 % 6, qt = t2 / 6;
                na_tile<false>(U, VT, MIX, rpbL, Kc, Vc, false, b, 0, 0, TL + b * CTXL + qt * 16, h, lane); }
        }
    }
    __syncthreads();
}

__device__ __forceinline__ void convgate_phase(ParamsK p, int l, int hs, int nrows) {
    constexpr int CG_RUN = 96, CG_LA = 6, NCG = FFN / 8;
    const bf16_t* FU = (const bf16_t*)(WSP + WS_FU); bf16_t* ACT = (bf16_t*)(WSP + WS_ACT);
    const float* cw = IN(19) + (size_t)l * 3 * FF2; const float* cb = IN(20) + (size_t)l * FF2;
    const int gt = blockIdx.x * 512 + otid();
    const int cgi = gt % NCG, sl = gt / NCG, c = cgi * 8;
    const int r0 = sl * CG_RUN;
    if (r0 >= nrows) return;
    const int r1 = min(r0 + CG_RUN, nrows);
    float wa[3][8], wb[3][8], ba[8], bb[8];
#pragma unroll
    for (int j = 0; j < 3; ++j)
#pragma unroll
        for (int i = 0; i < 8; ++i) { wa[j][i] = cw[j * FF2 + c + i]; wb[j][i] = cw[j * FF2 + FFN + c + i]; }
#pragma unroll
    for (int i = 0; i < 8; ++i) { ba[i] = cb[c + i]; bb[i] = cb[FFN + c + i]; }
    const bf16_t* ub = FU + c;
    auto seqpos = [&](int lr, int& pos, int& L) { const int Rg = hs + lr; if (Rg < TL) { pos = Rg & (SEQ - 1); L = SEQ; } else { pos = (Rg - TL) & (CTXL - 1); L = CTXL; } };
    float pa[8], pb[8], ca[8], cbv[8];
    { int pos, L; seqpos(r0, pos, L);
      if (pos > 0) { unpack8(*(const u32x4*)(ub + (size_t)(r0 - 1) * FF2), pa); unpack8(*(const u32x4*)(ub + (size_t)(r0 - 1) * FF2 + FFN), pb); }
      else {
#pragma unroll
          for (int i = 0; i < 8; ++i) { pa[i] = 0.f; pb[i] = 0.f; } }
      unpack8(*(const u32x4*)(ub + (size_t)r0 * FF2), ca); unpack8(*(const u32x4*)(ub + (size_t)r0 * FF2 + FFN), cbv); }
    u32x4 ra[CG_LA], rb[CG_LA];
#pragma unroll
    for (int i = 0; i < CG_LA; ++i) { const int lr = min(r0 + 1 + i, nrows - 1); ra[i] = __builtin_nontemporal_load((const u32x4*)(ub + (size_t)lr * FF2)); rb[i] = __builtin_nontemporal_load((const u32x4*)(ub + (size_t)lr * FF2 + FFN)); }
    for (int t = r0; t < r1; t += CG_LA) {
#pragma unroll
        for (int i = 0; i < CG_LA; ++i) {
            const int row = t + i;
            const u32x4 xa = ra[i], xb = rb[i];
            { const int lr = min(row + 1 + CG_LA, nrows - 1); ra[i] = __builtin_nontemporal_load((const u32x4*)(ub + (size_t)lr * FF2)); rb[i] = __builtin_nontemporal_load((const u32x4*)(ub + (size_t)lr * FF2 + FFN)); }
            int pos, L; seqpos(row, pos, L);
            float na[8], nb[8];
            if (pos < L - 1 && row + 1 < nrows) { unpack8(xa, na); unpack8(xb, nb); }
            else {
#pragma unroll
                for (int k = 0; k < 8; ++k) { na[k] = 0.f; nb[k] = 0.f; } }
            if (row < r1) {
                float o[8];
#pragma unroll
                for (int k = 0; k < 8; ++k) { const float a = wa[0][k] * pa[k] + wa[1][k] * ca[k] + wa[2][k] * na[k] + ba[k];
                    const float g = wb[0][k] * pb[k] + wb[1][k] * cbv[k] + wb[2][k] * nb[k] + bb[k];
                    o[k] = silu_f(a) * g; }
                u32x4 w; w.x = pk2(o[0], o[1]); w.y = pk2(o[2], o[3]); w.z = pk2(o[4], o[5]); w.w = pk2(o[6], o[7]);
                *(u32x4*)(ACT + (size_t)row * FFN + c) = w;
            }
            const bool lastOfSeq = (pos == L - 1);
#pragma unroll
            for (int k = 0; k < 8; ++k) { pa[k] = lastOfSeq ? 0.f : ca[k]; pb[k] = lastOfSeq ? 0.f : cbv[k]; }
            if (lastOfSeq && row + 1 < nrows) { unpack8(xa, ca); unpack8(xb, cbv); }
            else {
#pragma unroll
                for (int k = 0; k < 8; ++k) { ca[k] = na[k]; cbv[k] = nb[k]; } }
        }
    }
}

__global__ void __launch_bounds__(512, 2) fwd_megakernel(Params p_unused) {
    extern __shared__ __attribute__((aligned(16))) unsigned char smem[];
    cg::grid_group grid = cg::this_grid();
    __shared__ uint4 xb_words;
    if (threadIdx.x == 0) xb_words = make_uint4(0u, 0u, 0u, 0u);
    __syncthreads();
    XcdBarrier xb; { ParamsK p = getpk(); xb = xcd_barrier_post((unsigned*)(WSP + WS_CTL), (volatile LAS unsigned*)&xb_words); }
    { ParamsK p = getpk(); ada_phase(p, smem); }
    { ParamsK p = getpk(); weights_phase(p, smem); }
    GSYNC();
    { ParamsK p = getpk(); if (OUTP == nullptr) grid.sync(); }
    { ParamsK p = getpk(); prep_phase(p); }
    for (int l = 0; l < DEPTH; ++l) {
        const bool upd = l < DEPTH - 1;
        const int Mout = upd ? TT : TL;
        if (l == 0) {
            { ParamsK p = getpk(); const float* ml = (const float*)(WSP + WS_MOD);
              norm_phase(IN(0), IN(2), IN(6), ml, ml + DM, (bf16_t*)(WSP + WS_H), TT); }
            GSYNC();
            { ParamsK p = getpk(); EpiStore E; E.O = (bf16_t*)(WSP + WS_U); E.ldc = INP;
              run_gemm(smem, (const bf16_t*)(WSP + WS_H), (const bf16_t*)(WSP + WS_WIN), TT, INP, DM, E); }
        } else {
            ParamsK p = getpk(); EpiStoreN E; E.O = (bf16_t*)(WSP + WS_U) + (size_t)HALF0 * INP; E.ldc = INP; E.stat = (const float*)(WSP + WS_STAT); E.bias = (const float*)(WSP + WS_BIAS) + (size_t)(l * 2) * 9 * FF2; E.rowbase = HALF0;
            run_gemm(smem, (const bf16_t*)(WSP + WS_H) + (size_t)HALF0 * DM, (const bf16_t*)(WSP + WS_WIN) + (size_t)l * INP * DM, TT - HALF0, INP, DM, E);
        }
        GSYNC();
        for (int rep = 0; rep < REP_VT; ++rep) { ParamsK p = getpk(); vt_phase(p, smem); }
        GSYNC();
        for (int rep = 0; rep < REP_GLA; ++rep) { ParamsK p = getpk(); gla_step1(p, l, smem); }
        __syncthreads();
        for (int rep = 0; rep < REP_NA; ++rep) { ParamsK p = getpk(); na_phase(p, l, smem, upd); }
        GSYNC();
        { ParamsK p = getpk(); gla_step2(p); }
        GSYNC();
        for (int rep = 0; rep < REP_GLA; ++rep) { ParamsK p = getpk(); gla_step3(p, l, smem); }
        { ParamsK p = getpk(); shortconv_phase(p, l); }
        GSYNC();
        { ParamsK p = getpk(); const float* ml = (const float*)(WSP + WS_MOD) + (size_t)l * 9 * MODW;
          EpiResidN E; E.rin_l = l == 0 ? IN(0) : OUTP; E.rin_c = l == 0 ? IN(2) : (const float*)(WSP + WS_XC); E.rout_l = OUTP; E.rout_c = (float*)(WSP + WS_XC); E.gate = ml + 2 * DM; E.rowbase = 0;
          E.Hn = (bf16_t*)(WSP + WS_H2); E.gs = (const float*)(WSP + WS_GSV) + (size_t)(l * 2 + 1) * 9 * DM; E.stat = (float*)(WSP + WS_STAT) + (size_t)TT * 16;
          run_gemm(smem, (const bf16_t*)(WSP + WS_H), (const bf16_t*)(WSP + WS_WOUT) + (size_t)l * DM * DM, Mout, DM, DM, E); }
        GSYNC();
        for (int half = 0; half < 2; ++half) {
            const int hs = half * HALF0, nr = half == 0 ? HALF0 : Mout - HALF0;
            { ParamsK p = getpk(); EpiStoreN E; E.O = (bf16_t*)(WSP + WS_FU); E.ldc = FF2; E.stat = (const float*)(WSP + WS_STAT) + (size_t)TT * 16; E.bias = (const float*)(WSP + WS_BIAS) + (size_t)(l * 2 + 1) * 9 * FF2; E.rowbase = hs;
              run_gemm(smem, (const bf16_t*)(WSP + WS_H2) + (size_t)hs * DM, (const bf16_t*)(WSP + WS_WUP) + (size_t)l * FF2 * DM, nr, FF2, DM, E); }
            GSYNC();
            for (int rep = 0; rep < REP_CG; ++rep) { ParamsK p = getpk(); convgate_phase(p, l, hs, nr); }
            GSYNC();
            if (upd) { ParamsK p = getpk(); const float* ml = (const float*)(WSP + WS_MOD) + (size_t)l * 9 * MODW;
              EpiResidN E; E.rin_l = OUTP; E.rin_c = (const float*)(WSP + WS_XC); E.rout_l = OUTP; E.rout_c = (float*)(WSP + WS_XC); E.gate = ml + 5 * DM; E.rowbase = hs;
              E.Hn = (bf16_t*)(WSP + WS_H); E.gs = (const float*)(WSP + WS_GSV) + (size_t)((l + 1) * 2) * 9 * DM; E.stat = (float*)(WSP + WS_STAT);
              run_gemm(smem, (const bf16_t*)(WSP + WS_ACT), (const bf16_t*)(WSP + WS_WDN) + (size_t)l * DM * FFN, nr, DM, FFN, E);
              if (half == 1) {
                  EpiStoreN E2; E2.O = (bf16_t*)(WSP + WS_U); E2.ldc = INP; E2.stat = (const float*)(WSP + WS_STAT); E2.bias = (const float*)(WSP + WS_BIAS) + (size_t)((l + 1) * 2) * 9 * FF2; E2.rowbase = 0;
                  run_gemm(smem, (const bf16_t*)(WSP + WS_H), (const bf16_t*)(WSP + WS_WIN) + (size_t)(l + 1) * INP * DM, HALF0, INP, DM, E2, 224); } }
            else { ParamsK p = getpk(); const float* ml = (const float*)(WSP + WS_MOD) + (size_t)l * 9 * MODW;
              EpiResid E; E.rin_l = OUTP; E.rin_c = (const float*)(WSP + WS_XC); E.rout_l = OUTP; E.rout_c = (float*)(WSP + WS_XC); E.gate = ml + 5 * DM; E.rowbase = hs;
              run_gemm(smem, (const bf16_t*)(WSP + WS_ACT), (const bf16_t*)(WSP + WS_WDN) + (size_t)l * DM * FFN, nr, DM, FFN, E); }
        }
        GSYNC();
    }
    { ParamsK p = getpk(); final_norm_phase(OUTP, IN(22)); }
}

extern "C" void kernel_launch(void* const* d_in, const int* in_sizes, int n_in, void* d_out, int out_size, void* d_ws, size_t ws_size, hipStream_t stream) {
    static int grid_blocks = 0;
    if (grid_blocks == 0) {
        if (n_in != 23 || ws_size < WS_NEED) { fprintf(stderr, "kernel_launch: unexpected n_in %d or ws %zu < %zu\n", n_in, ws_size, (size_t)WS_NEED); grid_blocks = -1; return; }
        int dev = 0, cus = 0, per_cu = 0;
        hipGetDevice(&dev);
        hipDeviceGetAttribute(&cus, hipDeviceAttributeMultiprocessorCount, dev);
        if (hipFuncSetAttribute((const void*)fwd_megakernel, hipFuncAttributeMaxDynamicSharedMemorySize, LDS_BYTES) != hipSuccess) { fprintf(stderr, "kernel_launch: hipFuncSetAttribute failed\n"); }
        if (hipOccupancyMaxActiveBlocksPerMultiprocessor(&per_cu, (const void*)fwd_megakernel, 512, LDS_BYTES) != hipSuccess || per_cu < 1) { fprintf(stderr, "kernel_launch: occupancy query gave %d\n", per_cu); per_cu = 1; }
        (void)hipGetLastError();
        grid_blocks = cus * 1;
        if (grid_blocks <= 0) grid_blocks = 256;
    }
    if (grid_blocks < 0) return;
    if (hipMemsetAsync((char*)d_ws + WS_CTL, 0, 16384, stream) != hipSuccess) { fprintf(stderr, "kernel_launch: hipMemsetAsync of the barrier word failed\n"); return; }
    Params p{};
    for (int i = 0; i < 23; ++i) p.in[i] = (const float*)d_in[i];
    p.out = (float*)d_out; p.ws = (unsigned char*)d_ws;
    void* args[] = {&p};
    hipError_t e = hipLaunchCooperativeKernel((const void*)fwd_megakernel, dim3(grid_blocks), dim3(512), args, LDS_BYTES, stream);
    if (e != hipSuccess) fprintf(stderr, "cooperative launch failed: %s (grid %d)\n", hipGetErrorString(e), grid_blocks);
}
```
